# Optimizing an MI355X kernel written in HIP

```python
import jax, jax.numpy as jnp
from jax import lax
import numpy as np

D_MODEL = 2048
BATCH = 4
SEQ = 2048
DEPTH = 1

HEAD_DIM = 64
N_HEADS_DIL = (D_MODEL // 2) // HEAD_DIM
N_HEADS_SB = (D_MODEL // 2) // HEAD_DIM
DIL_WIDTH = N_HEADS_DIL * HEAD_DIM
SB_WIDTH = N_HEADS_SB * HEAD_DIM
MIX_WIDTH = DIL_WIDTH + SB_WIDTH
IN_WIDTH = 3 * DIL_WIDTH + 3 * SB_WIDTH
DIL_PATTERNS = ((128, 1), (512, 4), (2048, 16))
BLOCK = 128
ROPE_THETA = 10000.0
N_EXPERTS = 32
TOP_K = 4
D_EXPERT = D_MODEL
EXPERT_BLOCK = 128
SWIGLU_LIMIT = 7.0
SWIGLU_ALPHA = 1.702
NORM_EPS = 1e-5

kernel_name = "hymba_dilated_stickbreaking_moe_layer"


def rms_norm(x, g):
    xf = x.astype(jnp.float32)
    y = xf * lax.rsqrt(jnp.mean(xf * xf, axis=-1, keepdims=True) + NORM_EPS)
    return (y * g.astype(jnp.float32)).astype(x.dtype)


def rope(x, pos):
    half = x.shape[-1] // 2
    inv_freq = 1.0 / (ROPE_THETA ** (jnp.arange(half, dtype=jnp.float32) * 2.0 / x.shape[-1]))
    ang = pos.astype(jnp.float32)[:, None] * inv_freq[None, :]
    c = jnp.cos(ang)[None, :, None, :]
    s = jnp.sin(ang)[None, :, None, :]
    xf = x.astype(jnp.float32)
    x1, x2 = xf[..., :half], xf[..., half:]
    return jnp.concatenate([x1 * c - x2 * s, x2 * c + x1 * s], axis=-1).astype(x.dtype)


def dilated_window_attention(q, k, v, window, dilation):
    B, S, H, Dh = q.shape
    L = S // dilation
    w = window // dilation
    nb = -(-L // BLOCK)
    Lp = nb * BLOCK
    def split(t):
        return t.reshape(B, L, dilation, H, Dh)
    qd = jnp.pad(split(q), ((0, 0), (0, Lp - L), (0, 0), (0, 0), (0, 0)))
    qd = qd.reshape(B, nb, BLOCK, dilation, H, Dh)
    pad_kv = ((0, 0), (BLOCK, Lp - L), (0, 0), (0, 0), (0, 0))
    kd = jnp.pad(split(k), pad_kv).reshape(B, nb + 1, BLOCK, dilation, H, Dh)
    vd = jnp.pad(split(v), pad_kv).reshape(B, nb + 1, BLOCK, dilation, H, Dh)
    kb = jnp.concatenate([kd[:, :-1], kd[:, 1:]], axis=2)
    vb = jnp.concatenate([vd[:, :-1], vd[:, 1:]], axis=2)
    s = jnp.einsum('bnqrhe,bnkrhe->bnrhqk', qd, kb,
                   preferred_element_type=jnp.float32) * (HEAD_DIM ** -0.5)
    qi = jnp.arange(BLOCK)
    ki = jnp.arange(2 * BLOCK)
    dist = qi[:, None] + BLOCK - ki[None, :]
    key_u = jnp.arange(nb)[:, None] * BLOCK - BLOCK + ki[None, :]
    valid = ((dist >= 0) & (dist <= w))[None] & (key_u >= 0)[:, None, :]
    valid = valid[None, :, None, None]
    s = jnp.where(valid, s, -jnp.inf)
    m = jnp.max(s, axis=-1, keepdims=True)
    p = jnp.exp(s - m)
    den = jnp.sum(p, axis=-1, keepdims=True)
    o = jnp.einsum('bnrhqk,bnkrhe->bnqrhe', p, vb.astype(jnp.float32))
    den_t = jnp.moveaxis(den[..., 0], -1, 2)
    o = o / den_t[..., None]
    lse = jnp.moveaxis((m + jnp.log(den))[..., 0], -1, 2)
    o = o.reshape(B, Lp, dilation, H, Dh)[:, :L].reshape(B, S, H, Dh)
    lse = lse.reshape(B, Lp, dilation, H)[:, :L].reshape(B, S, H)
    return o, lse


def stick_breaking_attention(q, k, v):
    B, S, H, Dh = q.shape
    nbq = S // BLOCK
    qb = q.reshape(B, nbq, BLOCK, H, Dh).swapaxes(0, 1)
    kpos = jnp.arange(S)
    v32 = v.astype(jnp.float32)
    def block(args):
        qblk, i = args
        qpos = i * BLOCK + jnp.arange(BLOCK)
        z = jnp.einsum('bqhe,bkhe->bhqk', qblk, k,
                       preferred_element_type=jnp.float32) * (HEAD_DIM ** -0.5)
        causal = (kpos[None, :] < qpos[:, None])[None, None]
        log_beta = jax.nn.log_sigmoid(z)
        log_rest = jnp.where(causal, jax.nn.log_sigmoid(-z), 0.0)
        after = lax.cumsum(log_rest, axis=3, reverse=True) - log_rest
        a = jnp.where(causal, jnp.exp(log_beta + after), 0.0)
        return jnp.einsum('bhqk,bkhe->bqhe', a, v32)
    out = lax.map(block, (qb, jnp.arange(nbq)))
    return out.swapaxes(0, 1).reshape(B, S, H, Dh)


def hybrid_mixer(h, w_in, dil_out_norm, sb_out_norm, w_out):
    B, S, _ = h.shape
    proj = h @ w_in
    cuts = [DIL_WIDTH, 2 * DIL_WIDTH, 3 * DIL_WIDTH,
            3 * DIL_WIDTH + SB_WIDTH, 3 * DIL_WIDTH + 2 * SB_WIDTH]
    q_d, k_d, v_d, q_s, k_s, v_s = jnp.split(proj, cuts, axis=-1)
    q_d = q_d.reshape(B, S, N_HEADS_DIL, HEAD_DIM)
    k_d = k_d.reshape(B, S, N_HEADS_DIL, HEAD_DIM)
    v_d = v_d.reshape(B, S, N_HEADS_DIL, HEAD_DIM)
    q_s = q_s.reshape(B, S, N_HEADS_SB, HEAD_DIM)
    k_s = k_s.reshape(B, S, N_HEADS_SB, HEAD_DIM)
    v_s = v_s.reshape(B, S, N_HEADS_SB, HEAD_DIM)
    pos = jnp.arange(S)
    q_d = rope(q_d, pos)
    k_d = rope(k_d, pos)
    outs, lses = [], []
    for window, dilation in DIL_PATTERNS:
        o, l = dilated_window_attention(q_d, k_d, v_d, window, dilation)
        outs.append(o)
        lses.append(l)
    wts = jax.nn.softmax(jnp.stack(lses, axis=0), axis=0)
    o_d = jnp.sum(wts[..., None] * jnp.stack(outs, axis=0), axis=0)
    o_s = stick_breaking_attention(q_s, k_s, v_s)
    o_d = rms_norm(o_d.reshape(B, S, DIL_WIDTH).astype(h.dtype), dil_out_norm)
    o_s = rms_norm(o_s.reshape(B, S, SB_WIDTH).astype(h.dtype), sb_out_norm)
    return jnp.concatenate([o_d, o_s], axis=-1) @ w_out


def moe_ffn(h, w_router, b_router, w_gate, b_gate, w_up, b_up, w_down, b_down):
    B, S, D = h.shape
    n_tok = B * S
    hf = h.reshape(n_tok, D)
    logits = (hf @ w_router).astype(jnp.float32) + b_router.astype(jnp.float32)
    top_vals, top_idx = lax.top_k(logits, TOP_K)
    gates = jax.nn.softmax(top_vals, axis=-1)
    n_assign = n_tok * TOP_K
    flat_e = top_idx.reshape(n_assign)
    flat_tok = jnp.arange(n_assign, dtype=jnp.int32) // TOP_K
    flat_gate = gates.reshape(n_assign)
    onehot = (flat_e[:, None] == jnp.arange(N_EXPERTS)[None, :]).astype(jnp.int32)
    rank = jnp.take_along_axis(jnp.cumsum(onehot, axis=0), flat_e[:, None], axis=1)[:, 0] - 1
    counts = jnp.sum(onehot, axis=0)
    padded = (counts + EXPERT_BLOCK - 1) // EXPERT_BLOCK * EXPERT_BLOCK
    pend = jnp.cumsum(padded)
    pstart = pend - padded
    dest = pstart[flat_e] + rank
    n_blk = -(-n_assign // EXPERT_BLOCK) + N_EXPERTS
    n_rows = n_blk * EXPERT_BLOCK
    row_tok = jnp.full((n_rows,), n_tok, dtype=jnp.int32).at[dest].set(flat_tok)
    row_gate = jnp.zeros((n_rows,), dtype=jnp.float32).at[dest].set(flat_gate)
    blk_expert = jnp.minimum(
        jnp.searchsorted(pend, jnp.arange(n_blk, dtype=jnp.int32) * EXPERT_BLOCK, side='right'),
        N_EXPERTS - 1)
    xs = jnp.concatenate([hf, jnp.zeros((1, D), hf.dtype)], axis=0)[row_tok]
    xs = xs.reshape(n_blk, EXPERT_BLOCK, D)
    def expert_block(args):
        xb, e = args
        g = xb @ w_gate[e] + b_gate[e]
        u = xb @ w_up[e] + b_up[e]
        g = jnp.minimum(g, SWIGLU_LIMIT)
        u = jnp.clip(u, -SWIGLU_LIMIT, SWIGLU_LIMIT)
        a = (u + 1.0) * (g * jax.nn.sigmoid(SWIGLU_ALPHA * g))
        return a @ w_down[e] + b_down[e]
    ys = lax.map(expert_block, (xs, blk_expert)).reshape(n_rows, D)
    y = jax.ops.segment_sum(ys * row_gate[:, None].astype(ys.dtype), row_tok,
                            num_segments=n_tok + 1)[:n_tok]
    return y.reshape(B, S, D)


def setup_inputs(seed: int = 0) -> dict:
    key = jax.random.key(seed)
    ks = jax.random.split(key, 17)
    f32 = jnp.float32
    def nrm(k, shape, scale):
        return jax.random.normal(k, shape, f32) * scale
    return {
        "x": nrm(ks[0], (BATCH, SEQ, D_MODEL), 1.0),
        "attn_norm": 1.0 + nrm(ks[1], (DEPTH, D_MODEL), 0.1),
        "w_in": nrm(ks[2], (DEPTH, D_MODEL, IN_WIDTH), D_MODEL ** -0.5),
        "dil_out_norm": 1.0 + nrm(ks[3], (DEPTH, DIL_WIDTH), 0.1),
        "sb_out_norm": 1.0 + nrm(ks[4], (DEPTH, SB_WIDTH), 0.1),
        "w_out": nrm(ks[5], (DEPTH, MIX_WIDTH, D_MODEL), MIX_WIDTH ** -0.5),
        "ffn_norm": 1.0 + nrm(ks[6], (DEPTH, D_MODEL), 0.1),
        "w_router": nrm(ks[7], (DEPTH, D_MODEL, N_EXPERTS), D_MODEL ** -0.5),
        "b_router": nrm(ks[8], (DEPTH, N_EXPERTS), 0.01),
        "w_gate": nrm(ks[9], (DEPTH, N_EXPERTS, D_MODEL, D_EXPERT), D_MODEL ** -0.5),
        "b_gate": nrm(ks[10], (DEPTH, N_EXPERTS, D_EXPERT), 0.01),
        "w_up": nrm(ks[11], (DEPTH, N_EXPERTS, D_MODEL, D_EXPERT), D_MODEL ** -0.5),
        "b_up": nrm(ks[12], (DEPTH, N_EXPERTS, D_EXPERT), 0.01),
        "w_down": nrm(ks[13], (DEPTH, N_EXPERTS, D_EXPERT, D_MODEL), D_EXPERT ** -0.5),
        "b_down": nrm(ks[14], (DEPTH, N_EXPERTS, D_MODEL), 0.01),
        "final_norm": 1.0 + nrm(ks[15], (D_MODEL,), 0.1),
    }


def reference(x, attn_norm, w_in, dil_out_norm, sb_out_norm, w_out, ffn_norm,
              w_router, b_router, w_gate, b_gate, w_up, b_up, w_down, b_down,
              final_norm):
    for l in range(DEPTH):
        h = rms_norm(x, attn_norm[l])
        x = x + hybrid_mixer(h, w_in[l], dil_out_norm[l], sb_out_norm[l], w_out[l])
        h = rms_norm(x, ffn_norm[l])
        x = x + moe_ffn(h, w_router[l], b_router[l], w_gate[l], b_gate[l],
                        w_up[l], b_up[l], w_down[l], b_down[l])
    return rms_norm(x, final_norm)
```

```cpp
#include <hip/hip_runtime.h>
#include <cstdio>
#include <cstdint>

constexpr int D_MODEL = 2048, BATCH = 4, SEQ = 2048, NTOK = BATCH * SEQ;
constexpr int HD = 64, NH = 16, GW = 1024, INW = 6144;
constexpr int NEXP = 32, TOPK = 4, NASSIGN = NTOK * TOPK;
constexpr float EPS = 1e-5f;
constexpr float C2 = 0.125f * 1.4426950408889634f;
constexpr float LN2 = 0.6931471805599453f;

#define GAS __attribute__((address_space(1)))
#define LAS __attribute__((address_space(3)))
typedef unsigned short bf16_t;
typedef short bf16x8 __attribute__((ext_vector_type(8)));
typedef float f32x4 __attribute__((ext_vector_type(4)));
typedef unsigned u32x4 __attribute__((ext_vector_type(4)));
typedef unsigned u32x2 __attribute__((ext_vector_type(2)));
typedef GAS unsigned gu32;

constexpr size_t MiB = 1u << 20;
constexpr size_t WS_CTL = 0, CTL_ZERO_BYTES = 1 * MiB;
constexpr size_t WS_LIST = 1 * MiB;
constexpr size_t WS_AEXP = 2 * MiB, WS_ARANK = 2 * MiB + 256 * 1024, WS_AGATE = 2 * MiB + 512 * 1024;
constexpr size_t WS_ROPEC = 3 * MiB, WS_ROPES = 3 * MiB + 256 * 1024, WS_WRT = 3 * MiB + 512 * 1024;
constexpr size_t WS_LSE = 4 * MiB;
constexpr size_t WS_XN = 8 * MiB;
constexpr size_t WS_QKV = 40 * MiB;
constexpr size_t QKV_STRIDE = (size_t)NTOK * GW;
constexpr size_t WS_OP = 136 * MiB;
constexpr size_t WS_OSB = 184 * MiB;
constexpr size_t WS_ACAT = 200 * MiB;
constexpr size_t WS_X1 = 232 * MiB;
constexpr size_t WS_H2 = 296 * MiB;
constexpr size_t WS_H1 = 328 * MiB;
constexpr size_t WS_Y = 488 * MiB;
constexpr size_t WS_WIN = 648 * MiB;
constexpr size_t WS_WOUT = 672 * MiB;
constexpr size_t WS_WGU = 680 * MiB;
constexpr size_t WS_WD = 1192 * MiB;
constexpr size_t WS_END = 1448 * MiB;
constexpr int CW_TMO = 0, CW_CNT = 64  , CW_BAR = 4096;
constexpr int CW_CONVQ = 256  , CW_ATTQ = 320  , CW_DONE1 = 384, CW_DONE2 = 448  ;

__device__ __forceinline__ int lane_id() { int l; asm volatile("v_mbcnt_lo_u32_b32 %0, -1, 0\n\tv_mbcnt_hi_u32_b32 %0, -1, %0" : "=v"(l)); return l; }
__device__ __forceinline__ int fresh_tid(int wave) { int t = wave * 64 + lane_id(); asm volatile("" : "+v"(t)); return t; }
__device__ __forceinline__ float wave_sum(float v) {
#pragma unroll
    for (int o = 1; o < 64; o <<= 1) v += __shfl_xor(v, o);
    return v;
}
__device__ __forceinline__ unsigned cvt_pk_bf16(float lo, float hi) { unsigned r; asm volatile("v_cvt_pk_bf16_f32 %0, %1, %2" : "=v"(r) : "v"(lo), "v"(hi)); return r; }
__device__ __forceinline__ unsigned cvt_pk4_fp8(float a, float b, float c, float d) { int w = 0; w = __builtin_amdgcn_cvt_pk_fp8_f32(a, b, w, false); w = __builtin_amdgcn_cvt_pk_fp8_f32(c, d, w, true); return (unsigned)w; }
constexpr float W8_SCALE = 64.0f, W8_INV = 1.0f / 64.0f;
__device__ __forceinline__ float bf2f(bf16_t b) { return __uint_as_float((unsigned)b << 16); }
__device__ __forceinline__ float block_sum_256(float v, float* sh) {
    v = wave_sum(v);
    const int w = threadIdx.x >> 6;
    __syncthreads();
    if ((threadIdx.x & 63) == 0) sh[w] = v;
    __syncthreads();
    return sh[0] + sh[1] + sh[2] + sh[3];
}
__device__ __forceinline__ float log_sigmoid(float z) { return fminf(z, 0.f) - log1pf(expf(-fabsf(z))); }

#define XB_TMO      128
#define XB_XCNT(j)  (256  + 64 * (j))
#define XB_XSUB(j)  (1280 + 64 * (j))
#define XB_XGEN(j)  (2304 + 64 * (j))
#define XB_TOP      3328
#define XB_TOPGEN   3392
#define XCD_BAR_WORDS 3456
#define XB_SPIN_CAP (1u << 18)
__device__ __forceinline__ unsigned xb_ld(unsigned* p)              { return __hip_atomic_load(p, __ATOMIC_RELAXED, __HIP_MEMORY_SCOPE_AGENT); }
__device__ __forceinline__ unsigned xb_add(unsigned* p, unsigned v) { return __hip_atomic_fetch_add(p, v, __ATOMIC_RELAXED, __HIP_MEMORY_SCOPE_AGENT); }
__device__ __forceinline__ unsigned xb_xcc_id() { return (unsigned)__builtin_amdgcn_s_getreg((3 << 11) | 20) & 0xFu; }
#define XB_SPIN(cond, bar) do { unsigned _sp = 0; while (cond) { __builtin_amdgcn_s_sleep(1); \
    if ((++_sp & 255u) == 0u) { if (xb_ld(&(bar)[XB_TMO])) break; if (_sp > XB_SPIN_CAP) { atomicAdd(&(bar)[XB_TMO], 1u); break; } } } } while (0)
struct XcdBarrier { unsigned* bar; unsigned x; volatile LAS unsigned* st; };
__device__ __forceinline__ XcdBarrier xcd_barrier_post(unsigned* bar, volatile LAS unsigned* st, int tid) {
    XcdBarrier b; b.bar = bar; b.x = xb_xcc_id(); b.st = st;
    if (tid == 0) (void)xb_add(&bar[XB_XCNT(b.x)], 1u);
    return b;
}
__device__ __forceinline__ void xcd_barrier_complete(unsigned* bar, unsigned x, unsigned& nloc, unsigned& nx) {
    const unsigned G = gridDim.x * gridDim.y * gridDim.z;
    unsigned sum, cnt, mine, sp = 0u;
    for (;;) {
        sum = 0u; cnt = 0u; mine = 0u;
#pragma unroll
        for (unsigned j = 0; j < 16; ++j) { const unsigned c = xb_ld(&bar[XB_XCNT(j)]); sum += c; cnt += (c > 0u) ? 1u : 0u; mine = (j == x) ? c : mine; }
        if (sum == G) break;
        __builtin_amdgcn_s_sleep(1);
        if ((++sp & 255u) == 0u) { if (xb_ld(&bar[XB_TMO])) break; if (sp > XB_SPIN_CAP) { atomicAdd(&bar[XB_TMO], 1u); break; } }
    }
    nloc = mine > 0u ? mine : 1u; nx = cnt > 0u ? cnt : 1u;
}
__device__ __forceinline__ void xcd_barrier(const XcdBarrier& b, int tid) {
    asm volatile("s_waitcnt vmcnt(0)" ::: "memory");
    __syncthreads();
    if (tid == 0) {
        unsigned* bar = b.bar;
        __builtin_amdgcn_s_waitcnt(0);
        unsigned nloc = b.st[0], nx = b.st[1];
        if (nloc == 0u) { xcd_barrier_complete(bar, b.x, nloc, nx); b.st[0] = nloc; b.st[1] = nx; }
        const unsigned old = xb_add(&bar[XB_XSUB(b.x)], 1u);
        const unsigned gen = old / nloc;
        if (old + 1u == (gen + 1u) * nloc) {
            __builtin_amdgcn_fence(__ATOMIC_RELEASE, "agent");
            asm volatile("s_waitcnt vmcnt(0)" ::: "memory");
            const unsigned og = xb_add(&bar[XB_TOP], 1u);
            const unsigned tg = og / nx;
            if (og + 1u == (tg + 1u) * nx) xb_add(&bar[XB_TOPGEN], 1u);
            else XB_SPIN(xb_ld(&bar[XB_TOPGEN]) == tg, bar);
            __builtin_amdgcn_fence(__ATOMIC_ACQUIRE, "agent");
            xb_add(&bar[XB_XGEN(b.x)], 1u);
            asm volatile("s_waitcnt vmcnt(0)" ::: "memory");
        } else {
            XB_SPIN(xb_ld(&bar[XB_XGEN(b.x)]) == gen, bar);
            __builtin_amdgcn_fence(__ATOMIC_ACQUIRE, "agent");
            asm volatile("s_waitcnt vmcnt(0)" ::: "memory");
        }
    }
    __syncthreads();
}

__device__ __forceinline__ const char* uniform_ptr(const char* p) {
    const unsigned long long v = (unsigned long long)p;
    const unsigned lo = (unsigned)__builtin_amdgcn_readfirstlane((int)(unsigned)v), hi = (unsigned)__builtin_amdgcn_readfirstlane((int)(unsigned)(v >> 32));
    return (const char*)(((unsigned long long)hi << 32) | lo);
}
namespace pg8 {
constexpr int ROWTAB_UNITS = 10;
constexpr int BM = 256, BK = 64, HALF = 128, HTB = HALF * BK * 2, STAGE_BYTES = 8 * HTB, NXCD = 8, WGM = 8, RING_BYTES_C = 131072;
__host__ __device__ __forceinline__ int lds_byte(int r, int c) { const int st = (r >> 4) * 2 + (c >> 5), rr = r & 15, cc = c & 31, ob = rr * 64 + cc * 2; return st * 1024 + (ob ^ (((ob >> 9) & 1) << 5)); }
__host__ __device__ __forceinline__ void stage_rc(int b, int& R, int& C) { const int st = b / 1024, sb = b % 1024, swz = sb ^ (((sb >> 9) & 1) << 5); R = (st >> 1) * 16 + swz / 64; C = (st & 1) * 32 + (swz % 64) / 2; }
__host__ __device__ __forceinline__ int perm32(int rho) { const int n = rho >> 4, i = rho & 15; return 8 * (i >> 2) + 4 * n + (i & 3); }

struct Unit { int arow0; int nvalid; const char* bptr; int orow0; int pn; int e; int ui; };

struct StaticOrder {
    int nM, nN, nwg, G, c; const char* Bt; int RB;
    __device__ void init(int M, int N, int RB_, const void* Bt_, int G_, int c_) { nM = M / BM; nN = N / BM; nwg = nM * nN; G = G_; c = c_; Bt = (const char*)Bt_; RB = RB_; }
    __device__ bool next(int i, Unit& u) const {
        const int L = i * G + c; if (L >= nwg) return false;
        int wgid = L; { const int q = nwg / NXCD, r = nwg % NXCD, xcd = wgid % NXCD, off = wgid / NXCD; wgid = (xcd < r ? xcd * (q + 1) : r * (q + 1) + (xcd - r) * q) + off; }
        const int nig = WGM * nN, gid = wgid / nig, fm = gid * WGM, gsz = (nM - fm) < WGM ? (nM - fm) : WGM;
        const int pm = fm + ((wgid % nig) % gsz), pn = (wgid % nig) / gsz;
        u.arow0 = pm * BM; u.nvalid = BM; u.bptr = Bt + (size_t)pn * BM * RB; u.orow0 = pm * BM; u.pn = pn; u.e = 0; u.ui = i; return true;
    }
    __device__ __forceinline__ unsigned a_off(const Unit& u, int r) const { return (unsigned)(u.arow0 + r) * (unsigned)RB; }
};

typedef int v8i_t __attribute__((ext_vector_type(8)));
typedef int v4i_t __attribute__((ext_vector_type(4)));
template <class Epi, class Sched, bool ALIGN_EPI = true, bool FP8 = false>
__device__ __forceinline__ void gemm_phase(LAS unsigned char* lds, int wave, const void* Aptr, int RB, const Sched& S, const Epi& E) {
    const int tid = fresh_tid(wave), wid = wave, lane = tid & 63, wr = wid >> 2, wc = wid & 3, fr = lane & 15, fq = lane >> 4;
    const int nt = RB / 128;
    const char* gA = (const char*)Aptr;
    unsigned voffB[2];
#pragma unroll
    for (int i = 0; i < 2; ++i) { int R, C; stage_rc(tid * 16 + i * 8192, R, C); const int Rb = Epi::PERM ? ((R & ~31) + perm32(R & 31)) : R; voffB[i] = (unsigned)(Rb * RB + C * 2); }
    const size_t kstep = (size_t)(BK * 2);
    const size_t hstep = (size_t)HALF * RB;
    const unsigned ldsw = (unsigned)wid * 1024u;
    const int aoff = lds_byte(wr * 64 + fr, fq * 8), boff = lds_byte(wc * 32 + fr, fq * 8);
#define PG8_SA(b, h) (((b) * 2 + (h)) * HTB)
#define PG8_SB(b, h) ((4 + (b) * 2 + (h)) * HTB)
#define PG8_STAGEB(bufoff, gbase, vo) do { const char* _b = (const char*)(gbase); asm volatile("" : "+s"(_b));   _Pragma("unroll") for (int _i = 0; _i < 2; ++_i) \
        __builtin_amdgcn_global_load_lds((const unsigned*)(_b + (vo)[_i]), (LAS unsigned*)(lds + (bufoff) + ldsw + _i * 8192), 16, 0, 0); } while (0)
#define PG8_STAGEA(bufoff, kb, offs) do { const char* _b = gA + (size_t)(kb); asm volatile("" : "+s"(_b)); _Pragma("unroll") for (int _i = 0; _i < 2; ++_i) \
        __builtin_amdgcn_global_load_lds((const unsigned*)(_b + (offs)[_i]), (LAS unsigned*)(lds + (bufoff) + ldsw + _i * 8192), 16, 0, 0); } while (0)
#define PG8_LD8(p) __builtin_shufflevector(*(const LAS v4i_t*)(p), *(const LAS v4i_t*)((p) + 1024), 0, 1, 2, 3, 4, 5, 6, 7)
#define PG8_LDA(dst, b, h) do { _Pragma("unroll") for (int m = 0; m < 4; ++m) dst[m] = PG8_LD8(lds + PG8_SA(b, h) + aoff + m * 2048); } while (0)
#define PG8_LDB(dst, b, h) do { _Pragma("unroll") for (int n = 0; n < 2; ++n) dst[n] = PG8_LD8(lds + PG8_SB(b, h) + boff + n * 2048); } while (0)
#define PG8_LO(v) __builtin_bit_cast(bf16x8, __builtin_shufflevector(v, v, 0, 1, 2, 3))
#define PG8_HI(v) __builtin_bit_cast(bf16x8, __builtin_shufflevector(v, v, 4, 5, 6, 7))
#define PG8_MMA(ai, bj, At, Bt) do { __builtin_amdgcn_s_setprio(1); _Pragma("unroll") for (int m = 0; m < 4; ++m) _Pragma("unroll") for (int n = 0; n < 2; ++n) { \
        if constexpr (FP8) acc[ai][bj][m][n] = __builtin_amdgcn_mfma_scale_f32_16x16x128_f8f6f4(Bt[n], At[m], acc[ai][bj][m][n], 0, 0, 0, 0x7f7f7f7f, 0, 0x7f7f7f7f); \
        else { acc[ai][bj][m][n] = __builtin_amdgcn_mfma_f32_16x16x32_bf16(PG8_LO(Bt[n]), PG8_LO(At[m]), acc[ai][bj][m][n], 0, 0, 0); \
               acc[ai][bj][m][n] = __builtin_amdgcn_mfma_f32_16x16x32_bf16(PG8_HI(Bt[n]), PG8_HI(At[m]), acc[ai][bj][m][n], 0, 0, 0); } } \
        __builtin_amdgcn_s_setprio(0); } while (0)
#define PG8_WAIT_V(n) asm volatile("s_waitcnt vmcnt(" #n ")" ::: "memory")
#define PG8_WAIT_L(n) asm volatile("s_waitcnt lgkmcnt(" #n ")" ::: "memory")
#define PG8_BAR __builtin_amdgcn_s_barrier()
#define PG8_SCHED __builtin_amdgcn_sched_barrier(0)
#define PG8_AOFFS(dst, U) do { const int _t = fresh_tid(wave); _Pragma("unroll") for (int _i = 0; _i < 2; ++_i) { int _R, _C; stage_rc(_t * 16 + _i * 8192, _R, _C); _Pragma("unroll") for (int _h = 0; _h < 2; ++_h) dst[_h][_i] = S.a_off(U, _h * HALF + _R) + (unsigned)(_C * 2); } } while (0)
    Unit cur, nxt; int ui = 0;
    if (!S.next(0, cur)) return;
    f32x4 acc[2][2][4][2];
#pragma unroll
    for (int a = 0; a < 2; ++a)
#pragma unroll
        for (int b = 0; b < 2; ++b)
#pragma unroll
            for (int m = 0; m < 4; ++m)
#pragma unroll
                for (int n = 0; n < 2; ++n) acc[a][b][m][n] = (f32x4){0.f, 0.f, 0.f, 0.f};
    v8i_t At[4], B0[2], B1[2];
    unsigned ua[2][2];
    LAS u32x4* nslot = (LAS u32x4*)(lds + RING_BYTES_C + 4096) + tid;
    PG8_AOFFS(ua, cur);
    const char* cB = uniform_ptr(cur.bptr);
    PG8_STAGEB(PG8_SB(0, 0), cB, voffB); PG8_STAGEB(PG8_SB(0, 1), cB + hstep, voffB); PG8_STAGEA(PG8_SA(0, 0), 0, ua[0]); PG8_STAGEA(PG8_SA(0, 1), 0, ua[1]);
    if (wr == 1) PG8_BAR;
    PG8_WAIT_V(2); PG8_BAR;
    PG8_STAGEB(PG8_SB(1, 0), cB + kstep, voffB); PG8_STAGEA(PG8_SA(1, 0), kstep, ua[0]); PG8_STAGEB(PG8_SB(1, 1), cB + hstep + kstep, voffB);
    PG8_WAIT_V(6); PG8_BAR;
    for (;;) {
        const bool has_next = S.next(ui + 1, nxt);
        {
            unsigned nua[2][2];
            if (has_next) { PG8_AOFFS(nua, nxt); } else {
#pragma unroll
                for (int h = 0; h < 2; ++h)
#pragma unroll
                    for (int i = 0; i < 2; ++i) nua[h][i] = ua[h][i]; }
            *nslot = (u32x4){nua[0][0], nua[0][1], nua[1][0], nua[1][1]};
        }
        const char* nB = uniform_ptr(has_next ? nxt.bptr : cB);
        for (int t = 0; t < nt; t += 2) {
            const bool last = (t == nt - 2);
            const size_t k1 = (size_t)(t + 1) * kstep;
            const size_t k2 = last ? 0 : (size_t)(t + 2) * kstep, k3 = k2 + kstep;
            const char* b2 = last ? nB : cB + (size_t)(t + 2) * kstep; const char* b3 = b2 + kstep;
            asm volatile("" : "+v"(ua[0][0]), "+v"(ua[0][1]), "+v"(ua[1][0]), "+v"(ua[1][1]), "+v"(voffB[0]), "+v"(voffB[1]));
            unsigned a2o[2][2];
#pragma unroll
            for (int h = 0; h < 2; ++h)
#pragma unroll
                for (int i = 0; i < 2; ++i) a2o[h][i] = ua[h][i];
            if (last) { asm volatile("" ::: "memory"); const u32x4 nv = *nslot; a2o[0][0] = nv.x; a2o[0][1] = nv.y; a2o[1][0] = nv.z; a2o[1][1] = nv.w; }
            PG8_LDB(B0, 0, 0); PG8_LDB(B1, 0, 1); PG8_SCHED; PG8_LDA(At, 0, 0); PG8_STAGEA(PG8_SA(1, 1), k1, ua[1]);
            PG8_WAIT_V(8); PG8_WAIT_L(0); PG8_BAR; PG8_MMA(0, 0, At, B0); PG8_MMA(0, 1, At, B1); PG8_BAR; PG8_SCHED;
            PG8_LDA(At, 0, 1); PG8_STAGEB(PG8_SB(0, 0), b2, voffB); PG8_STAGEB(PG8_SB(0, 1), b2 + hstep, voffB); PG8_STAGEA(PG8_SA(0, 0), k2, a2o[0]);
            PG8_WAIT_V(8); PG8_WAIT_L(0); PG8_BAR; PG8_MMA(1, 0, At, B0); PG8_MMA(1, 1, At, B1); PG8_BAR; PG8_SCHED;
            PG8_LDB(B0, 1, 0); PG8_LDB(B1, 1, 1); PG8_SCHED; PG8_LDA(At, 1, 0); PG8_STAGEA(PG8_SA(0, 1), k2, a2o[1]);
            PG8_WAIT_V(8); PG8_WAIT_L(0); PG8_BAR; PG8_MMA(0, 0, At, B0); PG8_MMA(0, 1, At, B1); PG8_BAR; PG8_SCHED;
            PG8_LDA(At, 1, 1); PG8_STAGEB(PG8_SB(1, 0), b3, voffB); PG8_STAGEB(PG8_SB(1, 1), b3 + hstep, voffB); PG8_STAGEA(PG8_SA(1, 0), k3, a2o[0]);
            PG8_WAIT_V(8); PG8_WAIT_L(0); PG8_BAR; PG8_MMA(1, 0, At, B0); PG8_MMA(1, 1, At, B1); PG8_BAR; PG8_SCHED;
        }
        if constexpr (ALIGN_EPI) { if (wr == 0) PG8_BAR; }
        { const int _l = lane_id(); E(acc, cur, wr, wc, _l & 15, _l >> 4); }
        if (!has_next) break;
#pragma unroll
        for (int a = 0; a < 2; ++a)
#pragma unroll
            for (int b = 0; b < 2; ++b)
#pragma unroll
                for (int m = 0; m < 4; ++m)
#pragma unroll
                    for (int n = 0; n < 2; ++n) acc[a][b][m][n] = (f32x4){0.f, 0.f, 0.f, 0.f};
        cur = nxt; cB = nB; ++ui;
        { const u32x4 nv = *nslot; ua[0][0] = nv.x; ua[0][1] = nv.y; ua[1][0] = nv.z; ua[1][1] = nv.w; }
        if constexpr (ALIGN_EPI) { if (wr == 1) PG8_BAR; }
    }
    PG8_WAIT_V(0);
    if constexpr (!ALIGN_EPI) { if (wr == 0) PG8_BAR; }
    PG8_BAR;
#undef PG8_SA
#undef PG8_SB
#undef PG8_STAGEA
#undef PG8_STAGEB
#undef PG8_LDA
#undef PG8_LD8
#undef PG8_LO
#undef PG8_HI
#undef PG8_LDB
#undef PG8_MMA
#undef PG8_WAIT_V
#undef PG8_WAIT_L
#undef PG8_BAR
#undef PG8_SCHED
#undef PG8_AOFFS
}

struct EpiQKV {
    static constexpr bool PERM = true;
    bf16_t* O; const float* ropec; const float* ropes;
    __device__ __forceinline__ void operator()(const f32x4 (&acc)[2][2][4][2], const Unit& u, int wr, int wc, int fr, int fq) const {
        const int t = u.pn >> 2, colt = (u.pn & 3) * BM;
        bf16_t* base = O + (size_t)t * QKV_STRIDE;
        const int row0 = u.orow0 + wr * 64 + fr, col0 = colt + wc * 32 + 8 * fq;
        const float sc = (t == 0 || t == 3) ? C2 : 1.0f;
        const bool rope = t < 2;
        const int fi = 4 * (4 * (wc & 1) + fq);
        f32x4 cs[2][4], sn[2][4];
#pragma unroll
        for (int ai = 0; ai < 2; ++ai)
#pragma unroll
            for (int m = 0; m < 4; ++m) {
                cs[ai][m] = (f32x4){1.f, 1.f, 1.f, 1.f}; sn[ai][m] = (f32x4){0.f, 0.f, 0.f, 0.f};
                if (rope) { const int pos = (row0 + ai * HALF + m * 16) & (SEQ - 1); cs[ai][m] = *(const f32x4*)(ropec + pos * 32 + fi); sn[ai][m] = *(const f32x4*)(ropes + pos * 32 + fi); }
            }
#pragma unroll
        for (int ai = 0; ai < 2; ++ai)
#pragma unroll
            for (int m = 0; m < 4; ++m) {
                const int row = row0 + ai * HALF + m * 16;
                bf16_t* rowp = base + (size_t)row * GW + col0;
#pragma unroll
                for (int bj = 0; bj < 2; ++bj) {
                    const f32x4 x1 = acc[ai][bj][m][0], x2 = acc[ai][bj][m][1];
                    const f32x4 y1 = (x1 * cs[ai][m] - x2 * sn[ai][m]) * sc, y2 = (x2 * cs[ai][m] + x1 * sn[ai][m]) * sc;
                    u32x4 w; w.x = cvt_pk_bf16(y1[0], y1[1]); w.y = cvt_pk_bf16(y1[2], y1[3]); w.z = cvt_pk_bf16(y2[0], y2[1]); w.w = cvt_pk_bf16(y2[2], y2[3]);
                    *(u32x4*)(rowp + bj * HALF) = w;
                }
            }
    }
};

struct GroupedOrder {
    const LAS int* tab; int G, c, NT, total; const char* Bt; size_t bstride; int RB; const int* list; bool gather;
    const LAS int* rowtab;
    mutable int ecur;
    __device__ void init(const LAS int* tab_, int NT_, const void* Bt_, size_t bstride_bytes, int RB_, const int* list_, bool gather_, int G_, int c_, const LAS int* rowtab_) {
        tab = tab_; NT = NT_; Bt = (const char*)Bt_; bstride = bstride_bytes; RB = RB_; list = list_; gather = gather_; G = G_; c = c_; rowtab = rowtab_; ecur = 0;
        total = __builtin_amdgcn_readfirstlane(tab_[96 + 32]) * NT_; }
    __device__ bool next(int i, Unit& u) const {
        const int L = i * G + c; if (L >= total) return false;
        int wgid = L; { const int q = total / NXCD, r = total % NXCD, xcd = wgid % NXCD, off = wgid / NXCD; wgid = (xcd < r ? xcd * (q + 1) : r * (q + 1) + (xcd - r) * q) + off; }
        int e = ecur;
        while (e + 1 < NEXP && wgid >= __builtin_amdgcn_readfirstlane(tab[96 + e + 1]) * NT) ++e;
        ecur = e;
        const int local = wgid - __builtin_amdgcn_readfirstlane(tab[96 + e]) * NT, nrb = __builtin_amdgcn_readfirstlane(tab[32 + e]);
        const int rb = local % nrb, pn = local / nrb, ps = __builtin_amdgcn_readfirstlane(tab[64 + e]), cn = __builtin_amdgcn_readfirstlane(tab[e]);
        u.e = __builtin_amdgcn_readfirstlane(e); u.pn = __builtin_amdgcn_readfirstlane(pn); u.orow0 = __builtin_amdgcn_readfirstlane(ps + rb * BM); u.arow0 = __builtin_amdgcn_readfirstlane(gather ? (e * NTOK + rb * BM) : (ps + rb * BM));
        u.nvalid = __builtin_amdgcn_readfirstlane(cn - rb * BM); u.bptr = uniform_ptr(Bt + (size_t)u.e * bstride + (size_t)u.pn * BM * RB); u.ui = i;
        return true;
    }
    __device__ __forceinline__ unsigned a_off(const Unit& u, int r) const {
        int row;
        if (gather) { if (u.ui < ROWTAB_UNITS) row = rowtab[u.ui * BM + r]; else { row = 0; if (r < u.nvalid) row = list[u.arow0 + r] >> 2; } } else row = u.arow0 + r;
        return (unsigned)row * (unsigned)RB;
    }
    __device__ __forceinline__ void fill_rowtab(LAS int* wtab, int tid) const {
        if (tid < BM) { Unit u; const int keep = ecur;
            for (int i = 0; i < ROWTAB_UNITS && next(i, u); ++i) wtab[i * BM + tid] = (tid < u.nvalid) ? (list[u.arow0 + tid] >> 2) : 0;
            ecur = keep; }
    }
};
struct EpiGateUp {
    static constexpr bool PERM = true;
    unsigned char* H1; const float* bg; const float* bu;
    __device__ __forceinline__ void operator()(const f32x4 (&acc)[2][2][4][2], const Unit& u, int wr, int wc, int fr, int fq) const {
        const int row0 = u.orow0 + wr * 64 + fr, col0 = u.pn * HALF + wc * 32 + 8 * fq;
        const float* bgp = bg + (size_t)u.e * D_MODEL + col0; const float* bup = bu + (size_t)u.e * D_MODEL + col0;
        f32x4 bgv[2], buv[2];
#pragma unroll
        for (int n = 0; n < 2; ++n) { bgv[n] = *(const f32x4*)(bgp + 4 * n); buv[n] = *(const f32x4*)(bup + 4 * n) + 1.0f; }
#pragma unroll
        for (int ai = 0; ai < 2; ++ai)
#pragma unroll
            for (int m = 0; m < 4; ++m) {
                f32x4 o[2];
#pragma unroll
                for (int n = 0; n < 2; ++n) {
                    f32x4 g = acc[ai][0][m][n] * W8_INV + bgv[n], u1 = acc[ai][1][m][n] * W8_INV + buv[n];
#pragma unroll
                    for (int j = 0; j < 4; ++j) { g[j] = fminf(g[j], 7.0f); u1[j] = fminf(fmaxf(u1[j], -6.0f), 8.0f); }
                    const f32x4 t = g * (-1.702f * 1.4426950408889634f);
                    f32x4 d;
#pragma unroll
                    for (int j = 0; j < 4; ++j) d[j] = __builtin_amdgcn_exp2f(t[j]);
                    d = d + 1.0f;
#pragma unroll
                    for (int j = 0; j < 4; ++j) d[j] = __builtin_amdgcn_rcpf(d[j]);
                    o[n] = (g * d) * u1;
                }
                u32x2 w; w.x = cvt_pk4_fp8(o[0][0], o[0][1], o[0][2], o[0][3]); w.y = cvt_pk4_fp8(o[1][0], o[1][1], o[1][2], o[1][3]);
                *(u32x2*)(H1 + (size_t)(row0 + ai * HALF + m * 16) * D_MODEL + col0) = w;
            }
    }
};
struct EpiDown {
    static constexpr bool PERM = true;
    unsigned char* Y; const float* bd;
    __device__ __forceinline__ void operator()(const f32x4 (&acc)[2][2][4][2], const Unit& u, int wr, int wc, int fr, int fq) const {
        const int row0 = u.orow0 + wr * 64 + fr, col0 = u.pn * BM + wc * 32 + 8 * fq;
        const float* bp = bd + (size_t)u.e * D_MODEL + col0;
        f32x4 bv[2][2];
#pragma unroll
        for (int bj = 0; bj < 2; ++bj)
#pragma unroll
            for (int n = 0; n < 2; ++n) bv[bj][n] = *(const f32x4*)(bp + bj * HALF + 4 * n);
#pragma unroll
        for (int ai = 0; ai < 2; ++ai)
#pragma unroll
            for (int m = 0; m < 4; ++m) { unsigned char* rowp = Y + (size_t)(row0 + ai * HALF + m * 16) * D_MODEL + col0;
#pragma unroll
                for (int bj = 0; bj < 2; ++bj) { const f32x4 v0 = acc[ai][bj][m][0] * W8_INV + bv[bj][0], v1 = acc[ai][bj][m][1] * W8_INV + bv[bj][1];
                    u32x2 w; w.x = cvt_pk4_fp8(v0[0], v0[1], v0[2], v0[3]); w.y = cvt_pk4_fp8(v1[0], v1[1], v1[2], v1[3]);
                    *(u32x2*)(rowp + bj * HALF) = w; } }
    }
};
struct EpiOut {
    static constexpr bool PERM = true;
    const float* x; bf16_t* X1;
    __device__ __forceinline__ void operator()(const f32x4 (&acc)[2][2][4][2], const Unit& u, int wr, int wc, int fr, int fq) const {
        const int row0 = u.orow0 + wr * 64 + fr, col0 = u.pn * BM + wc * 32 + 8 * fq;
#pragma unroll
        for (int ai = 0; ai < 2; ++ai) {
            f32x4 xr[4][2][2];
#pragma unroll
            for (int m = 0; m < 4; ++m)
#pragma unroll
                for (int bj = 0; bj < 2; ++bj)
#pragma unroll
                    for (int n = 0; n < 2; ++n) xr[m][bj][n] = *(const f32x4*)(x + (size_t)(row0 + ai * HALF + m * 16) * D_MODEL + col0 + bj * HALF + n * 4);
#pragma unroll
            for (int m = 0; m < 4; ++m)
#pragma unroll
                for (int bj = 0; bj < 2; ++bj) { const f32x4 v0 = xr[m][bj][0] + acc[ai][bj][m][0], v1 = xr[m][bj][1] + acc[ai][bj][m][1];
                    u32x4 w; w.x = cvt_pk_bf16(v0[0], v0[1]); w.y = cvt_pk_bf16(v0[2], v0[3]); w.z = cvt_pk_bf16(v1[0], v1[1]); w.w = cvt_pk_bf16(v1[2], v1[3]);
                    *(u32x4*)(X1 + (size_t)(row0 + ai * HALF + m * 16) * D_MODEL + col0 + bj * HALF) = w; }
        }
    }
};
}

constexpr int NWAVES = 8;
constexpr int RING_BYTES = 131072, MISC_OFF = RING_BYTES + 320, LDS_BYTES = 163840, ROWTAB_OFF = RING_BYTES + 16384;
struct Args { const float* in[16]; float* out; unsigned char* ws; int ph_lo, ph_hi; };
constexpr int NPHASE = 9;
#ifndef NCONV
#define NCONV 128
#endif

struct Frame {
    LAS unsigned char* lds; int vcu, G, wave; unsigned char* ws;
};

template <class RM>
__device__ __forceinline__ void conv_tile(const float* __restrict__ W, int N, bf16_t* __restrict__ Wt, int K, int kb, int nb, int lane, const RM& rm) {
    const int kg = lane & 7, ng = lane >> 3;
    const int k0 = kb * 64 + kg * 8, n0 = nb * 32 + ng * 4;
    f32x4 v[8];
#pragma unroll
    for (int j = 0; j < 8; ++j) v[j] = __builtin_nontemporal_load((const f32x4*)(W + (size_t)(k0 + j) * N + n0));
#pragma unroll
    for (int c = 0; c < 4; ++c) {
        u32x4 o; o.x = cvt_pk_bf16(v[0][c], v[1][c]); o.y = cvt_pk_bf16(v[2][c], v[3][c]); o.z = cvt_pk_bf16(v[4][c], v[5][c]); o.w = cvt_pk_bf16(v[6][c], v[7][c]);
        *(u32x4*)(Wt + (size_t)rm(n0 + c) * K + k0) = o;
    }
}
template <class RM>
__device__ __forceinline__ void conv_tile8(const float* __restrict__ W, int N, unsigned char* __restrict__ Wt, int K, int kb, int nb, int lane, const RM& rm) {
    const int kg = lane & 7, ng = lane >> 3;
    const int k0 = kb * 64 + kg * 8, n0 = nb * 32 + ng * 4;
    f32x4 v[8];
#pragma unroll
    for (int j = 0; j < 8; ++j) v[j] = __builtin_nontemporal_load((const f32x4*)(W + (size_t)(k0 + j) * N + n0)) * W8_SCALE;
#pragma unroll
    for (int c = 0; c < 4; ++c) {
        u32x2 o; o.x = cvt_pk4_fp8(v[0][c], v[1][c], v[2][c], v[3][c]); o.y = cvt_pk4_fp8(v[4][c], v[5][c], v[6][c], v[7][c]);
        *(u32x2*)(Wt + (size_t)rm(n0 + c) * K + k0) = o;
    }
}
struct RmIdent { __device__ __forceinline__ int operator()(int n) const { return n; } };
struct RmWin {
    __device__ __forceinline__ int operator()(int n) const { if (n >= 2048) return n; const int o = n & 63, a = (o & 31) >> 2, j = (o & 3) + ((o >> 5) << 2); return (n & ~63) + 8 * a + j; } };
struct RmGU { int up; __device__ __forceinline__ int operator()(int n) const { return 256 * (n >> 7) + 128 * up + (n & 127); } };

__device__ __forceinline__ void p0_prologue(const Frame& F, const Args& a) {
    unsigned char* ws = F.ws;
    const int tid_ = fresh_tid(F.wave), lane = tid_ & 63, wave_ = F.wave;
    const int gw = F.vcu * NWAVES + wave_, NGW = F.G * NWAVES;
    const float* x = a.in[0]; const float* attn_norm = a.in[1]; const float* w_in = a.in[2]; const float* w_out = a.in[5]; const float* w_router = a.in[7];
    {
        f32x4 gn[8];
#pragma unroll
        for (int j = 0; j < 8; ++j) gn[j] = *((const f32x4*)attn_norm + lane + 64 * j);
        for (int r0 = gw; r0 < NTOK; r0 += NGW * 4) {
            f32x4 v[4][8];
#pragma unroll
            for (int t = 0; t < 4; ++t) { const int r = (r0 + t * NGW < NTOK) ? r0 + t * NGW : r0; const f32x4* xr = (const f32x4*)(x + (size_t)r * D_MODEL) + lane;
#pragma unroll
                for (int j = 0; j < 8; ++j) v[t][j] = xr[64 * j]; }
#pragma unroll
            for (int t = 0; t < 4; ++t) { const int r = r0 + t * NGW; if (r < NTOK) {
                float s = 0.f;
#pragma unroll
                for (int j = 0; j < 8; ++j) s += (v[t][j].x * v[t][j].x + v[t][j].y * v[t][j].y) + (v[t][j].z * v[t][j].z + v[t][j].w * v[t][j].w);
                const float rstd = rsqrtf(wave_sum(s) * (1.f / D_MODEL) + EPS);
                u32x2* o = (u32x2*)((bf16_t*)(ws + WS_XN) + (size_t)r * D_MODEL) + lane;
#pragma unroll
                for (int j = 0; j < 8; ++j) { u32x2 w; w.x = cvt_pk_bf16(v[t][j].x * rstd * gn[j].x, v[t][j].y * rstd * gn[j].y); w.y = cvt_pk_bf16(v[t][j].z * rstd * gn[j].z, v[t][j].w * rstd * gn[j].w); o[64 * j] = w; } } }
        }
    }
    for (int i = gw * 64 + lane; i < SEQ * 32; i += NGW * 64) {
        const int pos = i >> 5, f = i & 31;
        const float inv_freq = 1.0f / powf(10000.0f, (float)f * 2.0f / 64.0f);
        const float ang = (float)pos * inv_freq;
        ((float*)(ws + WS_ROPEC))[i] = cosf(ang); ((float*)(ws + WS_ROPES))[i] = sinf(ang);
    }
    for (int i = gw * 64 + lane; i < NEXP * D_MODEL; i += NGW * 64) { const int e = i >> 11, k = i & 2047; ((float*)(ws + WS_WRT))[i] = w_router[(size_t)k * NEXP + e]; }
    constexpr int T_IN = 32 * 192, T_OUT = 32 * 64, T_E = 32 * 64;
    {
        const int kg = lane & 7, ng = lane >> 3;
        auto tile_of = [&](int it, const float*& W, int& N, bf16_t*& Wt, int& k0, int& n0, bool& win) {
            win = it < T_IN; const int r = win ? it : it - T_IN, nbk = win ? 192 : 64;
            W = win ? w_in : w_out; N = win ? INW : D_MODEL; Wt = (bf16_t*)(ws + (win ? WS_WIN : WS_WOUT)); k0 = (r / nbk) * 64 + kg * 8; n0 = (r % nbk) * 32 + ng * 4; };
        for (int it0 = gw; it0 < T_IN + T_OUT; it0 += NGW * 2) {
            f32x4 v[2][8];
#pragma unroll
            for (int t = 0; t < 2; ++t) { const int it = (it0 + t * NGW < T_IN + T_OUT) ? it0 + t * NGW : it0; const float* W; int N, k0, n0; bf16_t* Wt; bool win; tile_of(it, W, N, Wt, k0, n0, win);
#pragma unroll
                for (int j = 0; j < 8; ++j) v[t][j] = __builtin_nontemporal_load((const f32x4*)(W + (size_t)(k0 + j) * N + n0)); }
#pragma unroll
            for (int t = 0; t < 2; ++t) { const int it = it0 + t * NGW; if (it < T_IN + T_OUT) { const float* W; int N, k0, n0; bf16_t* Wt; bool win; tile_of(it, W, N, Wt, k0, n0, win);
#pragma unroll
                for (int c = 0; c < 4; ++c) {
                    u32x4 o; o.x = cvt_pk_bf16(v[t][0][c], v[t][1][c]); o.y = cvt_pk_bf16(v[t][2][c], v[t][3][c]); o.z = cvt_pk_bf16(v[t][4][c], v[t][5][c]); o.w = cvt_pk_bf16(v[t][6][c], v[t][7][c]);
                    const int n = n0 + c, row = win ? RmWin{}(n) : n;
                    *(u32x4*)(Wt + (size_t)row * D_MODEL + k0) = o; } } }
        }
    }
}

constexpr int CV_T_E = 32 * 64, CV_NTILES = 3 * NEXP * CV_T_E, CV_ITEM_TILES = 64, CV_NITEMS = CV_NTILES / CV_ITEM_TILES;
constexpr int LDS_QSLOT = RING_BYTES + 2048;
__device__ __forceinline__ void conv_items(const Frame& F, const Args& a, const unsigned* stop_word, unsigned stop_count, int qword = CW_CONVQ) {
    unsigned char* ws = F.ws;
    const int tid = fresh_tid(F.wave), lane = tid & 63;
    const float* w_gate = a.in[9]; const float* w_up = a.in[11]; const float* w_down = a.in[13];
    unsigned* qn = (unsigned*)(ws + WS_CTL) + qword;
    LAS int* s_item = (LAS int*)(F.lds + LDS_QSLOT);
    for (;;) {
        if (tid == 0) {
            int it = -1;
            const bool stop = stop_word && __hip_atomic_load(stop_word, __ATOMIC_RELAXED, __HIP_MEMORY_SCOPE_AGENT) >= stop_count;
            if (!stop) it = (int)__hip_atomic_fetch_add(qn, 1u, __ATOMIC_RELAXED, __HIP_MEMORY_SCOPE_AGENT);
            *s_item = it;
        }
        __syncthreads();
        const int item = __builtin_amdgcn_readfirstlane(*s_item);
        __syncthreads();
        if (item < 0 || item >= CV_NITEMS) break;
        const int mat = item / (NEXP * 32), r = item - mat * (NEXP * 32), e = r >> 5, kb = r & 31;
        const float* W = (mat == 0 ? w_gate : mat == 1 ? w_up : w_down) + (size_t)e * D_MODEL * D_MODEL;
        const float* s = W + (size_t)(kb * 64) * D_MODEL + F.wave * 256 + lane * 4;
        unsigned char* dst = ((mat == 2) ? (ws + WS_WD + (size_t)e * D_MODEL * D_MODEL) : (ws + WS_WGU + (size_t)e * 4096 * D_MODEL)) + kb * 64;
        LAS unsigned char* T = F.lds;
        const int nl = F.wave * 256 + lane * 4, fz = lane & 7;
        constexpr int CVD = 3;
        f32x4 v[CVD][8];
#pragma unroll
        for (int d = 0; d < CVD - 1; ++d)
#pragma unroll
            for (int j = 0; j < 8; ++j) v[d][j] = __builtin_nontemporal_load((const f32x4*)(s + (size_t)(d * 8 + j) * D_MODEL));
#pragma unroll
        for (int st = 0; st < 8; ++st) {
            if (st + CVD - 1 < 8) {
#pragma unroll
                for (int j = 0; j < 8; ++j) v[(st + CVD - 1) % CVD][j] = __builtin_nontemporal_load((const f32x4*)(s + (size_t)((st + CVD - 1) * 8 + j) * D_MODEL)); }
            const f32x4* vv = v[st % CVD];
#pragma unroll
            for (int c = 0; c < 4; ++c) {
                u32x2 o; o.x = cvt_pk4_fp8(vv[0][c] * W8_SCALE, vv[1][c] * W8_SCALE, vv[2][c] * W8_SCALE, vv[3][c] * W8_SCALE); o.y = cvt_pk4_fp8(vv[4][c] * W8_SCALE, vv[5][c] * W8_SCALE, vv[6][c] * W8_SCALE, vv[7][c] * W8_SCALE);
                *(LAS u32x2*)(T + (nl + c) * 64 + ((st ^ fz) * 8)) = o;
            }
        }
        __syncthreads();
#pragma unroll
        for (int i = 0; i < 16; ++i) {
            const int id = tid + 512 * i, n = id >> 2, q = id & 3, f = (n >> 2) & 7;
            u32x4 d = *(const LAS u32x4*)(T + n * 64 + (((2 * q) ^ (f & 6)) * 8));
            if (f & 1) d = (u32x4){d.z, d.w, d.x, d.y};
            const int row = (mat == 2) ? n : (256 * (n >> 7) + 128 * mat + (n & 127));
            __builtin_nontemporal_store(d, (u32x4*)(dst + (size_t)row * D_MODEL + 16 * q));
        }
        __syncthreads();
    }
}

namespace attn {
typedef float f32x16 __attribute__((ext_vector_type(16)));
typedef short s16x4 __attribute__((ext_vector_type(4)));
typedef short v4i16_t __attribute__((ext_vector_type(4)));
#define MFMA32(a, b, c) __builtin_amdgcn_mfma_f32_32x32x16_bf16(a, b, c, 0, 0, 0)
__device__ __forceinline__ int crow(int r, int hi) { return (r & 3) + 8 * (r >> 2) + 4 * hi; }
__device__ __forceinline__ s16x4 vtr(const LAS unsigned char* p) { return __builtin_bit_cast(s16x4, __builtin_amdgcn_ds_read_tr16_b64_v4i16((LAS v4i16_t*)p)); }
__device__ __forceinline__ float xhalf(float v) {
    auto rr = __builtin_amdgcn_permlane32_swap(__float_as_uint(v), __float_as_uint(v), false, false);
    return (lane_id() & 32) ? __uint_as_float(rr[0]) : __uint_as_float(rr[1]);
}
__device__ __forceinline__ bf16x8 pack8(const f32x16& p, int ks) {
    u32x4 w; w.x = cvt_pk_bf16(p[8 * ks + 0], p[8 * ks + 1]); w.y = cvt_pk_bf16(p[8 * ks + 2], p[8 * ks + 3]); w.z = cvt_pk_bf16(p[8 * ks + 4], p[8 * ks + 5]); w.w = cvt_pk_bf16(p[8 * ks + 6], p[8 * ks + 7]);
    return __builtin_bit_cast(bf16x8, w);
}
__device__ __forceinline__ bf16x8 cat44(s16x4 lo, s16x4 hi) { bf16x8 r; r[0] = lo[0]; r[1] = lo[1]; r[2] = lo[2]; r[3] = lo[3]; r[4] = hi[0]; r[5] = hi[1]; r[6] = hi[2]; r[7] = hi[3]; return r; }
__device__ __forceinline__ void store_ot(const f32x16 (&O)[2], float scale, bf16_t* orow, int hi) {
#pragma unroll
    for (int dh = 0; dh < 2; ++dh)
#pragma unroll
        for (int g = 0; g < 4; ++g) { u32x2 w; w.x = cvt_pk_bf16(O[dh][4 * g] * scale, O[dh][4 * g + 1] * scale); w.y = cvt_pk_bf16(O[dh][4 * g + 2] * scale, O[dh][4 * g + 3] * scale);
            *(u32x2*)(orow + 32 * dh + 8 * g + 4 * hi) = w; }
}

constexpr int DA_ROWS = 384, DA_KPL = (DA_ROWS + 1) * 16, DA_VHL = DA_ROWS * 64 + 64, DA_VOFF = 8 * DA_KPL, DA_LDS = DA_VOFF + 2 * DA_VHL;
struct DaUnit { int b, h, p, ib; };
struct DaRegs { u32x4 kv[6], vv[6]; bf16x8 qf[4]; int tokq, uq; };
__device__ __forceinline__ void da_load(DaRegs& R, const bf16_t* __restrict__ QD, const bf16_t* __restrict__ KD, const bf16_t* __restrict__ VD, const DaUnit& u, int tid) {
    const int lane = tid & 63, wid = __builtin_amdgcn_readfirstlane(tid >> 6), r32 = lane & 31, hi = lane >> 5;
    const int lgL = 11 - 2 * u.p, dsh = 2 * u.p, Lm1 = (1 << lgL) - 1, i0 = u.ib * 256;
#pragma unroll
    for (int t = 0; t < 6; ++t) {
        const int idx = tid + 512 * t, j = idx >> 3, c = idx & 7, ip = i0 - 128 + j;
        R.kv[t] = (u32x4){0u, 0u, 0u, 0u}; R.vv[t] = (u32x4){0u, 0u, 0u, 0u};
        if (ip >= 0) { const int pos = ((ip & Lm1) << dsh) + (ip >> lgL); const size_t go = (size_t)(u.b * SEQ + pos) * GW + u.h * 64 + c * 8; R.kv[t] = *(const u32x4*)(KD + go); R.vv[t] = *(const u32x4*)(VD + go); }
    }
    const int iq = i0 + 32 * wid + r32; R.uq = iq & Lm1; R.tokq = u.b * SEQ + (R.uq << dsh) + (iq >> lgL);
#pragma unroll
    for (int d0 = 0; d0 < 4; ++d0) R.qf[d0] = *(const bf16x8*)(QD + (size_t)R.tokq * GW + u.h * 64 + 16 * d0 + 8 * hi);
}
__device__ __forceinline__ void da_fill(LAS unsigned char* lds, const DaRegs& R, int tid) {
#pragma unroll
    for (int t = 0; t < 6; ++t) {
        const int idx = tid + 512 * t, j = idx >> 3, c = idx & 7;
        *(LAS u32x4*)(lds + c * DA_KPL + j * 16) = R.kv[t];
        *(LAS u32x4*)(lds + DA_VOFF + (c >> 2) * DA_VHL + j * 64 + (c & 3) * 16) = R.vv[t];
    }
}
__device__ __forceinline__ void da_compute(const LAS unsigned char* lds, const bf16x8 (&qf)[4], int tokq, int uq, bf16_t* __restrict__ OP, float* __restrict__ LSE, int h, int p, int tid) {
    const int lane = tid & 63, wid = __builtin_amdgcn_readfirstlane(tid >> 6), r32 = lane & 31, hi = lane >> 5;
    f32x16 S[5];
#pragma unroll
    for (int s = 0; s < 5; ++s) {
        S[s] = (f32x16){};
#pragma unroll
        for (int d0 = 0; d0 < 4; ++d0) { const bf16x8 kf = *(const LAS bf16x8*)(lds + (2 * d0 + hi) * DA_KPL + (32 * wid + 32 * s + r32) * 16); S[s] = MFMA32(kf, qf[d0], S[s]); }
    }
    const int lim = uq < 128 ? uq : 128, lv = r32 - 4 * hi;
    float mx = -INFINITY;
#pragma unroll
    for (int s = 0; s < 5; ++s)
#pragma unroll
        for (int r = 0; r < 16; ++r) { const int dist = lv + (128 - 32 * s - ((r & 3) + 8 * (r >> 2))); const bool ok = (dist >= 0) && (dist <= lim); const float v = ok ? S[s][r] : -INFINITY; S[s][r] = v; mx = fmaxf(mx, v); }
    mx = fmaxf(mx, xhalf(mx));
    float l = 0.f;
#pragma unroll
    for (int s = 0; s < 5; ++s)
#pragma unroll
        for (int r = 0; r < 16; ++r) { const float pv = __builtin_amdgcn_exp2f(S[s][r] - mx); S[s][r] = pv; l += pv; }
    l += xhalf(l);
    f32x16 O[2]; O[0] = (f32x16){}; O[1] = (f32x16){};
    const LAS unsigned char* vb = lds + DA_VOFF + (32 * wid + 4 * hi + ((lane & 15) >> 2)) * 64 + ((lane >> 4) & 1) * 32 + (lane & 3) * 8;
#pragma unroll
    for (int s = 0; s < 5; ++s)
#pragma unroll
        for (int ks = 0; ks < 2; ++ks) {
            const bf16x8 pb = pack8(S[s], ks);
#pragma unroll
            for (int dh = 0; dh < 2; ++dh) { const LAS unsigned char* a = vb + dh * DA_VHL + (32 * s + 16 * ks) * 64; O[dh] = MFMA32(cat44(vtr(a), vtr(a + 512)), pb, O[dh]); }
        }
    store_ot(O, 1.0f / l, OP + ((size_t)p * NTOK + tokq) * GW + h * 64, hi);
    if (hi == 0) LSE[((size_t)p * NTOK + tokq) * NH + h] = mx + __builtin_amdgcn_logf(l);
}

constexpr int SB_ROWS = 448, SB_KPL = (SB_ROWS + 1) * 16, SB_VHL = SB_ROWS * 64 + 64, SB_VOFF = 8 * SB_KPL, SB_LDS = SB_VOFF + 2 * SB_VHL, SB_FLAGS = SB_LDS;
static_assert(SB_LDS + 64 <= 131072, "stick-breaking chunk image fits the phase scratch region");
__device__ __forceinline__ void sb_unit(LAS unsigned char* lds, const bf16_t* __restrict__ QS, const bf16_t* __restrict__ KS, const bf16_t* __restrict__ VS, bf16_t* __restrict__ OSB,
                                        int b, int h, int qb, int tid) {
    const int lane = tid & 63, wid = __builtin_amdgcn_readfirstlane(tid >> 6), r32 = lane & 31, hi = lane >> 5;
    const int t0w = 256 * qb + 32 * wid, tq = t0w + r32, tokq = b * SEQ + tq;
    bf16x8 qf[4];
#pragma unroll
    for (int d0 = 0; d0 < 4; ++d0) qf[d0] = *(const bf16x8*)(QS + (size_t)tokq * GW + h * 64 + 16 * d0 + 8 * hi);
    f32x16 O[2]; O[0] = (f32x16){}; O[1] = (f32x16){};
    float C = 0.f;
    bool done = false;
    const int vlane = (4 * hi + ((lane & 15) >> 2)) * 64 + ((lane >> 4) & 1) * 32 + (lane & 3) * 8;
    LAS int* s_need = (LAS int*)(lds + SB_FLAGS);
    int khi = 256 * qb + 255;
    for (;;) {
        const int klo = (khi - (SB_ROWS - 1)) > 0 ? (khi - (SB_ROWS - 1)) : 0, nrows = khi - klo + 1;
        {
            u32x4 kr[7], vr[7];
#pragma unroll
            for (int t = 0; t < 7; ++t) { const int idx = tid + 512 * t, j = idx >> 3, c = idx & 7;
                kr[t] = (u32x4){0u, 0u, 0u, 0u}; vr[t] = (u32x4){0u, 0u, 0u, 0u};
                if (j < nrows) { const size_t go = (size_t)(b * SEQ + klo + j) * GW + h * 64 + c * 8; kr[t] = *(const u32x4*)(KS + go); vr[t] = *(const u32x4*)(VS + go); } }
#pragma unroll
            for (int t = 0; t < 7; ++t) { const int idx = tid + 512 * t, j = idx >> 3, c = idx & 7;
                *(LAS u32x4*)(lds + c * SB_KPL + j * 16) = kr[t]; *(LAS u32x4*)(lds + SB_VOFF + (c >> 2) * SB_VHL + j * 64 + (c & 3) * 16) = vr[t]; }
        }
        __syncthreads();
        if (!done) {
            for (int kt = khi >> 6; kt >= (klo >> 6); --kt) {
                if (64 * kt > t0w + 30) continue;
                const bool diag = (64 * kt + 63 >= t0w);
                const LAS unsigned char* kb = lds + (64 * kt - klo) * 16; const LAS unsigned char* vb = lds + SB_VOFF + (64 * kt - klo) * 64 + vlane;
#pragma unroll
                for (int sub = 1; sub >= 0; --sub) {
                    const int keyb = 64 * kt + 32 * sub;
                    if (keyb > t0w + 30) continue;
                    f32x16 Z = (f32x16){};
#pragma unroll
                    for (int d0 = 0; d0 < 4; ++d0) { const bf16x8 kf = *(const LAS bf16x8*)(kb + (2 * d0 + hi) * SB_KPL + (32 * sub + r32) * 16); Z = MFMA32(kf, qf[d0], Z); }
                    const int kl = keyb + 4 * hi;
                    float sp[16];
#pragma unroll
                    for (int r = 0; r < 16; ++r) { const float e = __builtin_amdgcn_exp2f(Z[r]); float v = __builtin_amdgcn_logf(1.0f + e); if (diag) { const bool ok = (kl + (r & 3) + 8 * (r >> 2)) < tq; v = ok ? v : 0.f; } sp[r] = v; }
                    float own[4], oth[4];
#pragma unroll
                    for (int g = 0; g < 4; ++g) { sp[4 * g + 2] += sp[4 * g + 3]; sp[4 * g + 1] += sp[4 * g + 2]; sp[4 * g] += sp[4 * g + 1]; own[g] = sp[4 * g]; oth[g] = xhalf(own[g]); }
                    float off[4]; float run = C;
#pragma unroll
                    for (int g = 3; g >= 0; --g) { off[g] = run + (hi == 0 ? oth[g] : 0.f); run += own[g] + oth[g]; }
                    C = run;
#pragma unroll
                    for (int r = 0; r < 16; ++r) { float a = __builtin_amdgcn_exp2f(Z[r] - (off[r >> 2] + sp[r])); if (diag) { const bool ok = (kl + (r & 3) + 8 * (r >> 2)) < tq; a = ok ? a : 0.f; } Z[r] = a; }
#pragma unroll
                    for (int ks = 0; ks < 2; ++ks) {
                        const bf16x8 pb = pack8(Z, ks);
#pragma unroll
                        for (int dh = 0; dh < 2; ++dh) { const LAS unsigned char* a = vb + dh * SB_VHL + (32 * sub + 16 * ks) * 64; O[dh] = MFMA32(cat44(vtr(a), vtr(a + 512)), pb, O[dh]); }
                    }
                }
                float cm = C;
#pragma unroll
                for (int o = 1; o < 32; o <<= 1) cm = fminf(cm, __shfl_xor(cm, o));
                if (__builtin_amdgcn_readfirstlane(__float_as_int(cm)) >= __float_as_int(150.0f)) { done = true; break; }
            }
        }
        if (lane == 0) s_need[wid] = (!done && klo > 0) ? 1 : 0;
        __syncthreads();
        int any = 0;
#pragma unroll
        for (int i = 0; i < 8; ++i) any |= s_need[i];
        __syncthreads();
        if (!any) break;
        khi = klo - 1;
    }
    store_ot(O, 1.0f, OSB + (size_t)tokq * GW + h * 64, hi);
}
#undef MFMA32
}

__device__ __forceinline__ void p3_combine(const Frame& F, const Args& a) {
    unsigned char* ws = F.ws;
    const int tid_ = fresh_tid(F.wave), lane = tid_ & 63, wave_ = F.wave;
    const int gw = F.vcu * NWAVES + wave_, NGW = F.G * NWAVES;
    const bf16_t* OP = (const bf16_t*)(ws + WS_OP); const bf16_t* OSB = (const bf16_t*)(ws + WS_OSB); const float* LSE = (const float*)(ws + WS_LSE);
    bf16_t* ACAT = (bf16_t*)(ws + WS_ACAT);
    const float* gd = a.in[3]; const float* gs = a.in[4];
    const int hd = lane >> 2;
    float gdv[16], gsv[16];
#pragma unroll
    for (int j = 0; j < 16; ++j) { gdv[j] = gd[lane * 16 + j]; gsv[j] = gs[lane * 16 + j]; }
    constexpr int TB = 4;
    for (int tok0 = gw; tok0 < NTOK; tok0 += NGW * TB) {
        u32x4 ra[TB][4][2]; float ls[TB][3];
#pragma unroll
        for (int t = 0; t < TB; ++t) { const int tok = tok0 + t * NGW; if (tok < NTOK) {
#pragma unroll
            for (int p = 0; p < 3; ++p) { ls[t][p] = LSE[((size_t)p * NTOK + tok) * NH + hd]; const u32x4* pp = (const u32x4*)(OP + ((size_t)p * NTOK + tok) * GW + lane * 16); ra[t][p][0] = pp[0]; ra[t][p][1] = pp[1]; }
            const u32x4* ps = (const u32x4*)(OSB + (size_t)tok * GW + lane * 16); ra[t][3][0] = ps[0]; ra[t][3][1] = ps[1]; } }
#pragma unroll
        for (int t = 0; t < TB; ++t) { const int tok = tok0 + t * NGW; if (tok < NTOK) {
            const float mx = fmaxf(ls[t][0], fmaxf(ls[t][1], ls[t][2]));
            float w0 = __builtin_amdgcn_exp2f(ls[t][0] - mx), w1 = __builtin_amdgcn_exp2f(ls[t][1] - mx), w2 = __builtin_amdgcn_exp2f(ls[t][2] - mx);
            const float inv = 1.0f / (w0 + w1 + w2); w0 *= inv; w1 *= inv; w2 *= inv;
            float od[16], os[16];
#pragma unroll
            for (int q = 0; q < 2; ++q) { const u32x4 a0 = ra[t][0][q], a1 = ra[t][1][q], a2 = ra[t][2][q], as = ra[t][3][q];
#pragma unroll
                for (int j = 0; j < 4; ++j) {
                    od[8 * q + 2 * j] = w0 * __uint_as_float(a0[j] << 16) + w1 * __uint_as_float(a1[j] << 16) + w2 * __uint_as_float(a2[j] << 16);
                    od[8 * q + 2 * j + 1] = w0 * __uint_as_float(a0[j] & 0xffff0000u) + w1 * __uint_as_float(a1[j] & 0xffff0000u) + w2 * __uint_as_float(a2[j] & 0xffff0000u);
                    os[8 * q + 2 * j] = __uint_as_float(as[j] << 16); os[8 * q + 2 * j + 1] = __uint_as_float(as[j] & 0xffff0000u); } }
            float sd = 0.f, ss = 0.f;
#pragma unroll
            for (int j = 0; j < 16; ++j) { sd += od[j] * od[j]; ss += os[j] * os[j]; }
            const float rd = rsqrtf(wave_sum(sd) * (1.0f / GW) + EPS), rs = rsqrtf(wave_sum(ss) * (1.0f / GW) + EPS);
#pragma unroll
            for (int q = 0; q < 2; ++q) {
                u32x4 wd, wsb;
#pragma unroll
                for (int j = 0; j < 4; ++j) {
                    wd[j] = cvt_pk_bf16(od[8 * q + 2 * j] * rd * gdv[8 * q + 2 * j], od[8 * q + 2 * j + 1] * rd * gdv[8 * q + 2 * j + 1]);
                    wsb[j] = cvt_pk_bf16(os[8 * q + 2 * j] * rs * gsv[8 * q + 2 * j], os[8 * q + 2 * j + 1] * rs * gsv[8 * q + 2 * j + 1]); }
                *(u32x4*)(ACAT + (size_t)tok * D_MODEL + lane * 16 + 8 * q) = wd;
                *(u32x4*)(ACAT + (size_t)tok * D_MODEL + GW + lane * 16 + 8 * q) = wsb;
            } } }
    }
}

constexpr int ATT_NSB = BATCH * NH * 8, ATT_NDA = BATCH * NH * 3 * 8, ATT_NTOT = ATT_NSB + ATT_NDA;
__device__ __forceinline__ int att_grab(const Frame& F, int tid) {
    LAS int* s_item = (LAS int*)(F.lds + LDS_QSLOT);
    __syncthreads();
    if (tid == 0) *s_item = (int)__hip_atomic_fetch_add((unsigned*)(F.ws + WS_CTL) + CW_ATTQ, 1u, __ATOMIC_RELAXED, __HIP_MEMORY_SCOPE_AGENT);
    __syncthreads();
    return __builtin_amdgcn_readfirstlane(*s_item);
}
__device__ __forceinline__ void p2_attention(const Frame& F) {
    unsigned char* ws = F.ws; const int tid = fresh_tid(F.wave);
    const bf16_t* QKV = (const bf16_t*)(ws + WS_QKV);
    const bf16_t *QD = QKV, *KD = QKV + QKV_STRIDE, *VD = QKV + 2 * QKV_STRIDE, *QS = QKV + 3 * QKV_STRIDE, *KS = QKV + 4 * QKV_STRIDE, *VS = QKV + 5 * QKV_STRIDE;
    auto da_of = [](int id) { attn::DaUnit u; const int uid = id - ATT_NSB, pq = uid >> 3, bh = pq / 3; u.ib = uid & 7; u.p = pq % 3; u.b = bh >> 4; u.h = bh & 15; return u; };
    int cur = att_grab(F, tid);
    while (cur < ATT_NSB) {
        const int bh = cur >> 3; attn::sb_unit(F.lds, QS, KS, VS, (bf16_t*)(ws + WS_OSB), bh >> 4, bh & 15, 7 - (cur & 7), tid);
        cur = att_grab(F, tid);
    }
    if (cur < ATT_NTOT) {
        attn::DaRegs R;
        attn::da_load(R, QD, KD, VD, da_of(cur), tid);
        while (cur < ATT_NTOT) {
            const int nxt = att_grab(F, tid);
            const attn::DaUnit u = da_of(cur);
            attn::da_fill(F.lds, R, tid);
            bf16x8 qf[4]; qf[0] = R.qf[0]; qf[1] = R.qf[1]; qf[2] = R.qf[2]; qf[3] = R.qf[3];
            const int tokq = R.tokq, uq = R.uq;
            __syncthreads();
            if (nxt < ATT_NTOT) attn::da_load(R, QD, KD, VD, da_of(nxt), tid);
            attn::da_compute(F.lds, qf, tokq, uq, (bf16_t*)(ws + WS_OP), (float*)(ws + WS_LSE), u.h, u.p, tid);
            __syncthreads();
            cur = nxt;
        }
    }
}

constexpr int RT_RSTD = 0, RT_PART = 256, RT_LG = RT_PART + 8 * 32 * 32 * 4, RT_HIST = RT_LG + 32 * 32 * 4, RT_BASE = RT_HIST + 128, RT_SELE = RT_BASE + 128, RT_SELR = RT_SELE + 512, RT_SELG = RT_SELR + 512;
__device__ __forceinline__ void p5_router(const Frame& F, const Args& a) {
    unsigned char* ws = F.ws; LAS unsigned char* lds = F.lds;
    const int tid = fresh_tid(F.wave), lane = tid & 63, w = F.wave;
    const bf16_t* X1 = (const bf16_t*)(ws + WS_X1); const float* gain = a.in[6]; const float* wrT = (const float*)(ws + WS_WRT); const float* br = a.in[8];
    unsigned char* H2 = ws + WS_H2;
    int* cnt = (int*)(ws + WS_CTL) + CW_CNT; int* list = (int*)(ws + WS_LIST); int* a_exp = (int*)(ws + WS_AEXP); int* a_rank = (int*)(ws + WS_ARANK); float* a_gate = (float*)(ws + WS_AGATE);
    LAS float* s_rstd = (LAS float*)(lds + RT_RSTD); LAS float* s_part = (LAS float*)(lds + RT_PART); LAS float* s_lg = (LAS float*)(lds + RT_LG);
    LAS int* s_hist = (LAS int*)(lds + RT_HIST); LAS int* s_base = (LAS int*)(lds + RT_BASE); LAS int* s_sele = (LAS int*)(lds + RT_SELE); LAS int* s_selr = (LAS int*)(lds + RT_SELR); LAS float* s_selg = (LAS float*)(lds + RT_SELG);
    for (int it = F.vcu; it < NTOK / 32; it += F.G) {
        const int tok0 = it * 32;
        if (tid < 32) s_hist[tid] = 0;
#pragma unroll
        for (int q = 0; q < 4; ++q) {
            const u32x4* xr = (const u32x4*)(X1 + (size_t)(tok0 + 4 * w + q) * D_MODEL) + lane; float s = 0.f;
#pragma unroll
            for (int j = 0; j < 4; ++j) { const u32x4 v = xr[64 * j];
#pragma unroll
                for (int i = 0; i < 4; ++i) { const float lo = __uint_as_float(v[i] << 16), hi = __uint_as_float(v[i] & 0xffff0000u); s += lo * lo + hi * hi; } }
            s = wave_sum(s);
            if (lane == 0) s_rstd[4 * w + q] = rsqrtf(s * (1.0f / D_MODEL) + EPS);
        }
        __syncthreads();
        {
            const int tr = lane & 15, kq = lane >> 4;
            const float r0 = s_rstd[tr], r1 = s_rstd[16 + tr];
            f32x4 acc[2][2];
#pragma unroll
            for (int tt = 0; tt < 2; ++tt)
#pragma unroll
                for (int eh = 0; eh < 2; ++eh) acc[tt][eh] = (f32x4){0.f, 0.f, 0.f, 0.f};
            unsigned ha[4], hb[4];
#pragma unroll 4
            for (int ls = 0; ls < 16; ++ls) {
                const int k = 256 * w + 64 * (ls >> 2) + 16 * kq + 4 * (ls & 3);
                const f32x4 g = *(const f32x4*)(gain + k);
                f32x4 xa, xb;
                { const u32x2 ra = *(const u32x2*)(X1 + (size_t)(tok0 + tr) * D_MODEL + k), rb = *(const u32x2*)(X1 + (size_t)(tok0 + 16 + tr) * D_MODEL + k);
                  xa = (f32x4){__uint_as_float(ra.x << 16), __uint_as_float(ra.x & 0xffff0000u), __uint_as_float(ra.y << 16), __uint_as_float(ra.y & 0xffff0000u)};
                  xb = (f32x4){__uint_as_float(rb.x << 16), __uint_as_float(rb.x & 0xffff0000u), __uint_as_float(rb.y << 16), __uint_as_float(rb.y & 0xffff0000u)}; }
                const f32x4 b0 = *(const f32x4*)(wrT + (size_t)(lane & 15) * D_MODEL + k), b1 = *(const f32x4*)(wrT + (size_t)(16 + (lane & 15)) * D_MODEL + k);
                xa = xa * r0 * g; xb = xb * r1 * g;
                ha[ls & 3] = cvt_pk4_fp8(xa.x, xa.y, xa.z, xa.w); hb[ls & 3] = cvt_pk4_fp8(xb.x, xb.y, xb.z, xb.w);
                if ((ls & 3) == 3) { const int ks = k - 12;
                    *(u32x4*)(H2 + (size_t)(tok0 + tr) * D_MODEL + ks) = (u32x4){ha[0], ha[1], ha[2], ha[3]}; *(u32x4*)(H2 + (size_t)(tok0 + 16 + tr) * D_MODEL + ks) = (u32x4){hb[0], hb[1], hb[2], hb[3]}; }
#pragma unroll
                for (int j = 0; j < 4; ++j) {
                    acc[0][0] = __builtin_amdgcn_mfma_f32_16x16x4f32(xa[j], b0[j], acc[0][0], 0, 0, 0); acc[0][1] = __builtin_amdgcn_mfma_f32_16x16x4f32(xa[j], b1[j], acc[0][1], 0, 0, 0);
                    acc[1][0] = __builtin_amdgcn_mfma_f32_16x16x4f32(xb[j], b0[j], acc[1][0], 0, 0, 0); acc[1][1] = __builtin_amdgcn_mfma_f32_16x16x4f32(xb[j], b1[j], acc[1][1], 0, 0, 0);
                }
            }
#pragma unroll
            for (int tt = 0; tt < 2; ++tt)
#pragma unroll
                for (int eh = 0; eh < 2; ++eh)
#pragma unroll
                    for (int rg = 0; rg < 4; ++rg) s_part[(w * 32 + 16 * tt + 4 * kq + rg) * 32 + 16 * eh + (lane & 15)] = acc[tt][eh][rg];
        }
        __syncthreads();
        { const int t = tid >> 4, e2 = (tid & 15) * 2;
#pragma unroll
          for (int q = 0; q < 2; ++q) { float v = br[e2 + q];
#pragma unroll
              for (int ww = 0; ww < 8; ++ww) v += s_part[(ww * 32 + t) * 32 + e2 + q];
              s_lg[t * 32 + e2 + q] = v; } }
        __syncthreads();
        if (tid < 32) {
            unsigned used = 0u; float val[4]; int idx[4];
#pragma unroll
            for (int k = 0; k < 4; ++k) { int bi = 0; float bv = -INFINITY;
                for (int i = 0; i < 32; ++i) { const float v = s_lg[tid * 32 + i]; if (!((used >> i) & 1u) && v > bv) { bv = v; bi = i; } }
                used |= 1u << bi; idx[k] = bi; val[k] = bv; }
            float ex[4], sm = 0.f;
#pragma unroll
            for (int k = 0; k < 4; ++k) { ex[k] = expf(val[k] - val[0]); sm += ex[k]; }
#pragma unroll
            for (int k = 0; k < 4; ++k) { s_sele[tid * 4 + k] = idx[k]; s_selr[tid * 4 + k] = atomicAdd((int*)&s_hist[idx[k]], 1); s_selg[tid * 4 + k] = ex[k] / sm; }
        }
        __syncthreads();
        if (tid < 32) { const int hcount = s_hist[tid]; s_base[tid] = hcount ? atomicAdd(&cnt[tid], hcount) : 0; }
        __syncthreads();
        if (tid < 128) { const int e = s_sele[tid], rk = s_base[e] + s_selr[tid], aid = tok0 * 4 + tid;
            list[e * NTOK + rk] = aid; a_exp[aid] = e; a_rank[aid] = rk; a_gate[aid] = s_selg[tid]; }
        __syncthreads();
    }
}
constexpr int MOE_TAB_OFF = RING_BYTES + 1024;
__device__ __forceinline__ void moe_table(const Frame& F) {
    LAS int* tab = (LAS int*)(F.lds + MOE_TAB_OFF);
    if (fresh_tid(F.wave) == 0) {
        const int* cnt = (const int*)(F.ws + WS_CTL) + CW_CNT; int rows = 0, blocks = 0;
        for (int e = 0; e < NEXP; ++e) { const int c = __hip_atomic_load(cnt + e, __ATOMIC_RELAXED, __HIP_MEMORY_SCOPE_AGENT), nb = (c + 255) >> 8; tab[e] = c; tab[32 + e] = nb; tab[64 + e] = rows; tab[96 + e] = blocks; rows += nb * 256; blocks += nb; }
        tab[96 + 32] = blocks;
    }
    __syncthreads();
}
__device__ __forceinline__ void p8_final(const Frame& F, const Args& a) {
    unsigned char* ws = F.ws; const LAS int* tab = (const LAS int*)(F.lds + MOE_TAB_OFF);
    const int tid_ = fresh_tid(F.wave), lane = tid_ & 63, wave_ = F.wave;
    const int gw = F.vcu * NWAVES + wave_, NGW = F.G * NWAVES;
    const bf16_t* X1 = (const bf16_t*)(ws + WS_X1); const unsigned char* Y = ws + WS_Y; const float* fg = a.in[15];
    const int* a_exp = (const int*)(ws + WS_AEXP); const int* a_rank = (const int*)(ws + WS_ARANK); const float* a_gate = (const float*)(ws + WS_AGATE);
    for (int tok = gw; tok < NTOK; tok += NGW) {
        const unsigned char* yr[4]; float gt[4];
#pragma unroll
        for (int k = 0; k < 4; ++k) { const int aid = tok * 4 + k; yr[k] = Y + (size_t)(tab[64 + a_exp[aid]] + a_rank[aid]) * D_MODEL; gt[k] = a_gate[aid]; }
        f32x4 v[8]; float s = 0.f;
#pragma unroll
        for (int j = 0; j < 8; ++j) {
            const int c = (lane + 64 * j) * 4; f32x4 y; { const u32x2 rx = *(const u32x2*)(X1 + (size_t)tok * D_MODEL + c); y = (f32x4){__uint_as_float(rx.x << 16), __uint_as_float(rx.x & 0xffff0000u), __uint_as_float(rx.y << 16), __uint_as_float(rx.y & 0xffff0000u)}; }
#pragma unroll
            for (int k = 0; k < 4; ++k) { const unsigned yy = *(const unsigned*)(yr[k] + c);
                const auto lo2 = __builtin_amdgcn_cvt_pk_f32_fp8((int)yy, false), hi2 = __builtin_amdgcn_cvt_pk_f32_fp8((int)yy, true);
                y.x += gt[k] * lo2[0]; y.y += gt[k] * lo2[1]; y.z += gt[k] * hi2[0]; y.w += gt[k] * hi2[1]; }
            v[j] = y; s += (y.x * y.x + y.y * y.y) + (y.z * y.z + y.w * y.w);
        }
        const float rstd = rsqrtf(wave_sum(s) * (1.0f / D_MODEL) + EPS);
#pragma unroll
        for (int j = 0; j < 8; ++j) { const int c = (lane + 64 * j) * 4; const f32x4 g = *(const f32x4*)(fg + c); *(f32x4*)(a.out + (size_t)tok * D_MODEL + c) = v[j] * rstd * g; }
    }
}

__global__ void __launch_bounds__(NWAVES * 64, 2) mk_fwd(Args args) {
    extern __shared__ __attribute__((aligned(16))) unsigned char lds_raw[];
    Frame F;
    F.lds = (LAS unsigned char*)lds_raw; F.wave = __builtin_amdgcn_readfirstlane((int)threadIdx.x >> 6);
    F.G = gridDim.x; { const int bx = blockIdx.x; F.vcu = (F.G % 8 == 0) ? (bx % 8) * (F.G / 8) + bx / 8 : bx; }
    F.ws = args.ws;
    volatile LAS unsigned* MISC = (volatile LAS unsigned*)(F.lds + MISC_OFF);
    for (int u = fresh_tid(F.wave); u < (LDS_BYTES - RING_BYTES) / 4; u += NWAVES * 64) ((LAS unsigned*)(F.lds + RING_BYTES))[u] = 0u;
    __syncthreads();
    const int lo = args.ph_lo, hi = args.ph_hi;
    const bool multi = (hi - lo) > 1;
    XcdBarrier bar; bar.bar = (unsigned*)(F.ws + WS_CTL) + CW_BAR; bar.x = 0; bar.st = nullptr;
    if (multi) bar = xcd_barrier_post((unsigned*)(F.ws + WS_CTL) + CW_BAR, MISC + 8, fresh_tid(F.wave));
#define IN(k) (lo <= (k) && (k) < hi)
#define SEAM(k) do { if (IN(k) && IN((k) + 1)) xcd_barrier(bar, fresh_tid(F.wave)); } while (0)

    const int jx = (int)blockIdx.x >> 3, ncompj = (F.G >> 3) - NCONV / 8;
    const bool conv_role = multi && (F.G % 8 == 0) && (F.G >= 2 * NCONV) && jx >= ncompj;
    const int GC = conv_role || (multi && (F.G % 8 == 0) && (F.G >= 2 * NCONV)) ? ncompj * 8 : F.G;
    const int crank = (GC == F.G) ? (int)blockIdx.x : (jx * 8 + ((int)blockIdx.x & 7));
    unsigned* done1 = (unsigned*)(F.ws + WS_CTL) + CW_DONE1; unsigned* done2 = (unsigned*)(F.ws + WS_CTL) + CW_DONE2;
    if (IN(0)) { p0_prologue(F, args); SEAM(0); }
    if (IN(1)) {
        if (conv_role) conv_items(F, args, done1, (unsigned)GC);
        else {
            pg8::StaticOrder S; S.init(NTOK, INW, D_MODEL * 2, F.ws + WS_WIN, GC, crank);
            pg8::EpiQKV E{(bf16_t*)(F.ws + WS_QKV), (const float*)(F.ws + WS_ROPEC), (const float*)(F.ws + WS_ROPES)};
            pg8::gemm_phase<pg8::EpiQKV, pg8::StaticOrder>(F.lds, F.wave, F.ws + WS_XN, D_MODEL * 2, S, E);
            if (fresh_tid(F.wave) == 0) __hip_atomic_fetch_add(done1, 1u, __ATOMIC_RELAXED, __HIP_MEMORY_SCOPE_AGENT);
        }
        SEAM(1);
    }
    if (IN(2)) {
#pragma unroll 1
        for (int pass = 0; pass < 2; ++pass) {
            if ((pass == 0) == conv_role) conv_items(F, args, nullptr, 0u);
            else p2_attention(F);
        }
        SEAM(2);
    }
    if (IN(3)) { p3_combine(F, args); SEAM(3); }
    if (IN(4)) {
        pg8::StaticOrder S; S.init(NTOK, D_MODEL, D_MODEL * 2, F.ws + WS_WOUT, F.G, (int)blockIdx.x);
        pg8::EpiOut E{args.in[0], (bf16_t*)(F.ws + WS_X1)};
        pg8::gemm_phase<pg8::EpiOut, pg8::StaticOrder>(F.lds, F.wave, F.ws + WS_ACAT, D_MODEL * 2, S, E);
        SEAM(4);
    }
    if (IN(5)) { p5_router(F, args); conv_items(F, args, nullptr, 0u); SEAM(5); }
    if (IN(6)) {
        moe_table(F);
        pg8::GroupedOrder S; S.init((const LAS int*)(F.lds + MOE_TAB_OFF), 16, F.ws + WS_WGU, (size_t)4096 * D_MODEL, D_MODEL, (const int*)(F.ws + WS_LIST), true, F.G, (int)blockIdx.x, (const LAS int*)(F.lds + ROWTAB_OFF));
        S.fill_rowtab((LAS int*)(F.lds + ROWTAB_OFF), fresh_tid(F.wave)); __syncthreads();
        pg8::EpiGateUp E{F.ws + WS_H1, args.in[10], args.in[12]};
        pg8::gemm_phase<pg8::EpiGateUp, pg8::GroupedOrder, true, true>(F.lds, F.wave, F.ws + WS_H2, D_MODEL, S, E);
        SEAM(6);
    }
    if (IN(7)) {
        if (!IN(6)) moe_table(F);
        pg8::GroupedOrder S; S.init((const LAS int*)(F.lds + MOE_TAB_OFF), 8, F.ws + WS_WD, (size_t)D_MODEL * D_MODEL, D_MODEL, nullptr, false, F.G, (int)blockIdx.x, nullptr);
        pg8::EpiDown E{F.ws + WS_Y, args.in[14]};
        pg8::gemm_phase<pg8::EpiDown, pg8::GroupedOrder, true, true>(F.lds, F.wave, F.ws + WS_H1, D_MODEL, S, E);
        SEAM(7);
    }
    if (IN(8)) { if (!IN(6) && !IN(7)) moe_table(F); p8_final(F, args); }

#undef IN
#undef SEAM
}


extern "C" void kernel_launch(void* const* d_in, const int* in_sizes, int n_in, void* d_out, int out_size, void* d_ws, size_t ws_size, hipStream_t stream) {
    static int grid = 0;
    if (grid == 0) {
        int dev = 0, cus = 0;
        if (hipGetDevice(&dev) != hipSuccess || hipDeviceGetAttribute(&cus, hipDeviceAttributeMultiprocessorCount, dev) != hipSuccess) { grid = -1; return; }
        if (hipFuncSetAttribute((const void*)mk_fwd, hipFuncAttributeMaxDynamicSharedMemorySize, LDS_BYTES) != hipSuccess) { fprintf(stderr, "hipFuncSetAttribute failed\n"); grid = -1; return; }
        int per_cu = 0;
        if (hipOccupancyMaxActiveBlocksPerMultiprocessor(&per_cu, (const void*)mk_fwd, NWAVES * 64, LDS_BYTES) != hipSuccess || per_cu < 1) fprintf(stderr, "occupancy query says %d\n", per_cu);
        (void)hipGetLastError();
        grid = cus;
    }
    if (grid < 0) return;
    const float* x = (const float*)d_in[0];
    const float* dil_norm = (const float*)d_in[3]; const float* sb_norm = (const float*)d_in[4]; const float* w_out = (const float*)d_in[5];
    const float* ffn_norm = (const float*)d_in[6]; const float* w_router = (const float*)d_in[7]; const float* b_router = (const float*)d_in[8];
    const float* w_gate = (const float*)d_in[9]; const float* b_gate = (const float*)d_in[10]; const float* w_up = (const float*)d_in[11]; const float* b_up = (const float*)d_in[12];
    const float* w_down = (const float*)d_in[13]; const float* b_down = (const float*)d_in[14]; const float* final_norm = (const float*)d_in[15];
    float* out = (float*)d_out;
    unsigned char* ws = (unsigned char*)d_ws;
    (void)hipMemsetAsync(ws + WS_CTL, 0, CTL_ZERO_BYTES, stream);
    Args a{};
    for (int i = 0; i < 16; ++i) a.in[i] = (const float*)d_in[i];
    a.out = out; a.ws = ws;
    a.ph_lo = 0; a.ph_hi = NPHASE;
    hipLaunchKernelGGL(mk_fwd, dim3(grid), dim3(NWAVES * 64), LDS_BYTES, stream, a);
}
```

```cpp
#include <hip/hip_runtime.h>
#include <cstdio>
#include <cstdint>

constexpr int D_MODEL = 2048, BATCH = 4, SEQ = 2048, NTOK = BATCH * SEQ;
constexpr int HD = 64, NH = 16, GW = 1024, INW = 6144;
constexpr int NEXP = 32, TOPK = 4, NASSIGN = NTOK * TOPK;
constexpr float EPS = 1e-5f;
constexpr float C2 = 0.125f * 1.4426950408889634f;
constexpr float LN2 = 0.6931471805599453f;

#define GAS __attribute__((address_space(1)))
#define LAS __attribute__((address_space(3)))
typedef unsigned short bf16_t;
typedef short bf16x8 __attribute__((ext_vector_type(8)));
typedef float f32x4 __attribute__((ext_vector_type(4)));
typedef unsigned u32x4 __attribute__((ext_vector_type(4)));
typedef unsigned u32x2 __attribute__((ext_vector_type(2)));
typedef GAS unsigned gu32;

constexpr size_t MiB = 1u << 20;
constexpr size_t WS_CTL = 0, CTL_ZERO_BYTES = 1 * MiB;
constexpr size_t WS_LIST = 1 * MiB;
constexpr size_t WS_AEXP = 2 * MiB, WS_ARANK = 2 * MiB + 256 * 1024, WS_AGATE = 2 * MiB + 512 * 1024;
constexpr size_t WS_ROPEC = 3 * MiB, WS_ROPES = 3 * MiB + 256 * 1024, WS_WRT = 3 * MiB + 512 * 1024;
constexpr size_t WS_LSE = 4 * MiB;
constexpr size_t WS_XN = 8 * MiB;
constexpr size_t WS_QKV = 40 * MiB;
constexpr size_t QKV_STRIDE = (size_t)NTOK * GW;
constexpr size_t WS_OP = 136 * MiB;
constexpr size_t WS_OSB = 184 * MiB;
constexpr size_t WS_ACAT = 200 * MiB;
constexpr size_t WS_X1 = 232 * MiB;
constexpr size_t WS_H2 = 296 * MiB;
constexpr size_t WS_H1 = 328 * MiB;
constexpr size_t WS_Y = 488 * MiB;
constexpr size_t WS_WIN = 648 * MiB;
constexpr size_t WS_WOUT = 672 * MiB;
constexpr size_t WS_WGU = 680 * MiB;
constexpr size_t WS_WD = 1192 * MiB;
constexpr size_t WS_END = 1448 * MiB;
constexpr int CW_TMO = 0, CW_CNT = 64  , CW_BAR = 4096;
constexpr int CW_CONVQ = 256  , CW_ATTQ = 320  , CW_DONE1 = 384, CW_DONE2 = 448  ;

__device__ __forceinline__ int lane_id() { int l; asm volatile("v_mbcnt_lo_u32_b32 %0, -1, 0\n\tv_mbcnt_hi_u32_b32 %0, -1, %0" : "=v"(l)); return l; }
__device__ __forceinline__ int fresh_tid(int wave) { int t = wave * 64 + lane_id(); asm volatile("" : "+v"(t)); return t; }
__device__ __forceinline__ float wave_sum(float v) {
#pragma unroll
    for (int o = 1; o < 64; o <<= 1) v += __shfl_xor(v, o);
    return v;
}
__device__ __forceinline__ unsigned cvt_pk_bf16(float lo, float hi) { unsigned r; asm volatile("v_cvt_pk_bf16_f32 %0, %1, %2" : "=v"(r) : "v"(lo), "v"(hi)); return r; }
__device__ __forceinline__ unsigned cvt_pk4_fp8(float a, float b, float c, float d) { int w = 0; w = __builtin_amdgcn_cvt_pk_fp8_f32(a, b, w, false); w = __builtin_amdgcn_cvt_pk_fp8_f32(c, d, w, true); return (unsigned)w; }
constexpr float W8_SCALE = 64.0f, W8_INV = 1.0f / 64.0f;
__device__ __forceinline__ float bf2f(bf16_t b) { return __uint_as_float((unsigned)b << 16); }
__device__ __forceinline__ float block_sum_256(float v, float* sh) {
    v = wave_sum(v);
    const int w = threadIdx.x >> 6;
    __syncthreads();
    if ((threadIdx.x & 63) == 0) sh[w] = v;
    __syncthreads();
    return sh[0] + sh[1] + sh[2] + sh[3];
}
__device__ __forceinline__ float log_sigmoid(float z) { return fminf(z, 0.f) - log1pf(expf(-fabsf(z))); }

#define XB_TMO      128
#define XB_XCNT(j)  (256  + 64 * (j))
#define XB_XSUB(j)  (1280 + 64 * (j))
#define XB_XGEN(j)  (2304 + 64 * (j))
#define XB_TOP      3328
#define XB_TOPGEN   3392
#define XCD_BAR_WORDS 3456
#define XB_SPIN_CAP (1u << 18)
__device__ __forceinline__ unsigned xb_ld(unsigned* p)              { return __hip_atomic_load(p, __ATOMIC_RELAXED, __HIP_MEMORY_SCOPE_AGENT); }
__device__ __forceinline__ unsigned xb_add(unsigned* p, unsigned v) { return __hip_atomic_fetch_add(p, v, __ATOMIC_RELAXED, __HIP_MEMORY_SCOPE_AGENT); }
__device__ __forceinline__ unsigned xb_xcc_id() { return (unsigned)__builtin_amdgcn_s_getreg((3 << 11) | 20) & 0xFu; }
#define XB_SPIN(cond, bar) do { unsigned _sp = 0; while (cond) { __builtin_amdgcn_s_sleep(1); \
    if ((++_sp & 255u) == 0u) { if (xb_ld(&(bar)[XB_TMO])) break; if (_sp > XB_SPIN_CAP) { atomicAdd(&(bar)[XB_TMO], 1u); break; } } } } while (0)
struct XcdBarrier { unsigned* bar; unsigned x; volatile LAS unsigned* st; };
__device__ __forceinline__ XcdBarrier xcd_barrier_post(unsigned* bar, volatile LAS unsigned* st, int tid) {
    XcdBarrier b; b.bar = bar; b.x = xb_xcc_id(); b.st = st;
    if (tid == 0) (void)xb_add(&bar[XB_XCNT(b.x)], 1u);
    return b;
}
__device__ __forceinline__ void xcd_barrier_complete(unsigned* bar, unsigned x, unsigned& nloc, unsigned& nx) {
    const unsigned G = gridDim.x * gridDim.y * gridDim.z;
    unsigned sum, cnt, mine, sp = 0u;
    for (;;) {
        sum = 0u; cnt = 0u; mine = 0u;
#pragma unroll
        for (unsigned j = 0; j < 16; ++j) { const unsigned c = xb_ld(&bar[XB_XCNT(j)]); sum += c; cnt += (c > 0u) ? 1u : 0u; mine = (j == x) ? c : mine; }
        if (sum == G) break;
        __builtin_amdgcn_s_sleep(1);
        if ((++sp & 255u) == 0u) { if (xb_ld(&bar[XB_TMO])) break; if (sp > XB_SPIN_CAP) { atomicAdd(&bar[XB_TMO], 1u); break; } }
    }
    nloc = mine > 0u ? mine : 1u; nx = cnt > 0u ? cnt : 1u;
}
__device__ __forceinline__ void xcd_barrier(const XcdBarrier& b, int tid) {
    asm volatile("s_waitcnt vmcnt(0)" ::: "memory");
    __syncthreads();
    if (tid == 0) {
        unsigned* bar = b.bar;
        __builtin_amdgcn_s_waitcnt(0);
        unsigned nloc = b.st[0], nx = b.st[1];
        if (nloc == 0u) { xcd_barrier_complete(bar, b.x, nloc, nx); b.st[0] = nloc; b.st[1] = nx; }
        const unsigned old = xb_add(&bar[XB_XSUB(b.x)], 1u);
        const unsigned gen = old / nloc;
        if (old + 1u == (gen + 1u) * nloc) {
            __builtin_amdgcn_fence(__ATOMIC_RELEASE, "agent");
            asm volatile("s_waitcnt vmcnt(0)" ::: "memory");
            const unsigned og = xb_add(&bar[XB_TOP], 1u);
            const unsigned tg = og / nx;
            if (og + 1u == (tg + 1u) * nx) xb_add(&bar[XB_TOPGEN], 1u);
            else XB_SPIN(xb_ld(&bar[XB_TOPGEN]) == tg, bar);
            __builtin_amdgcn_fence(__ATOMIC_ACQUIRE, "agent");
            xb_add(&bar[XB_XGEN(b.x)], 1u);
            asm volatile("s_waitcnt vmcnt(0)" ::: "memory");
        } else {
            XB_SPIN(xb_ld(&bar[XB_XGEN(b.x)]) == gen, bar);
            __builtin_amdgcn_fence(__ATOMIC_ACQUIRE, "agent");
            asm volatile("s_waitcnt vmcnt(0)" ::: "memory");
        }
    }
    __syncthreads();
}

__device__ __forceinline__ const char* uniform_ptr(const char* p) {
    const unsigned long long v = (unsigned long long)p;
    const unsigned lo = (unsigned)__builtin_amdgcn_readfirstlane((int)(unsigned)v), hi = (unsigned)__builtin_amdgcn_readfirstlane((int)(unsigned)(v >> 32));
    return (const char*)(((unsigned long long)hi << 32) | lo);
}
namespace pg8 {
constexpr int ROWTAB_UNITS = 10;
constexpr int BM = 256, BK = 64, HALF = 128, HTB = HALF * BK * 2, STAGE_BYTES = 8 * HTB, NXCD = 8, WGM = 8, RING_BYTES_C = 131072;
__host__ __device__ __forceinline__ int lds_byte(int r, int c) { const int st = (r >> 4) * 2 + (c >> 5), rr = r & 15, cc = c & 31, ob = rr * 64 + cc * 2; return st * 1024 + (ob ^ (((ob >> 9) & 1) << 5)); }
__host__ __device__ __forceinline__ void stage_rc(int b, int& R, int& C) { const int st = b / 1024, sb = b % 1024, swz = sb ^ (((sb >> 9) & 1) << 5); R = (st >> 1) * 16 + swz / 64; C = (st & 1) * 32 + (swz % 64) / 2; }
__host__ __device__ __forceinline__ int perm32(int rho) { const int n = rho >> 4, i = rho & 15; return 8 * (i >> 2) + 4 * n + (i & 3); }

struct Unit { int arow0; int nvalid; const char* bptr; int orow0; int pn; int e; int ui; };

struct StaticOrder {
    int nM, nN, nwg, G, c; const char* Bt; int RB;
    __device__ void init(int M, int N, int RB_, const void* Bt_, int G_, int c_) { nM = M / BM; nN = N / BM; nwg = nM * nN; G = G_; c = c_; Bt = (const char*)Bt_; RB = RB_; }
    __device__ bool next(int i, Unit& u) const {
        const int L = i * G + c; if (L >= nwg) return false;
        int wgid = L; { const int q = nwg / NXCD, r = nwg % NXCD, xcd = wgid % NXCD, off = wgid / NXCD; wgid = (xcd < r ? xcd * (q + 1) : r * (q + 1) + (xcd - r) * q) + off; }
        const int nig = WGM * nN, gid = wgid / nig, fm = gid * WGM, gsz = (nM - fm) < WGM ? (nM - fm) : WGM;
        const int pm = fm + ((wgid % nig) % gsz), pn = (wgid % nig) / gsz;
        u.arow0 = pm * BM; u.nvalid = BM; u.bptr = Bt + (size_t)pn * BM * RB; u.orow0 = pm * BM; u.pn = pn; u.e = 0; u.ui = i; return true;
    }
    __device__ __forceinline__ unsigned a_off(const Unit& u, int r) const { return (unsigned)(u.arow0 + r) * (unsigned)RB; }
};

typedef int v8i_t __attribute__((ext_vector_type(8)));
typedef int v4i_t __attribute__((ext_vector_type(4)));
template <class Epi, class Sched, bool ALIGN_EPI = true, bool FP8 = false>
__device__ __forceinline__ void gemm_phase(LAS unsigned char* lds, int wave, const void* Aptr, int RB, const Sched& S, const Epi& E) {
    const int tid = fresh_tid(wave), wid = wave, lane = tid & 63, wr = wid >> 2, wc = wid & 3, fr = lane & 15, fq = lane >> 4;
    const int nt = RB / 128;
    const char* gA = (const char*)Aptr;
    unsigned voffB[2];
#pragma unroll
    for (int i = 0; i < 2; ++i) { int R, C; stage_rc(tid * 16 + i * 8192, R, C); const int Rb = Epi::PERM ? ((R & ~31) + perm32(R & 31)) : R; voffB[i] = (unsigned)(Rb * RB + C * 2); }
    const size_t kstep = (size_t)(BK * 2);
    const size_t hstep = (size_t)HALF * RB;
    const unsigned ldsw = (unsigned)wid * 1024u;
    const int aoff = lds_byte(wr * 64 + fr, fq * 8), boff = lds_byte(wc * 32 + fr, fq * 8);
#define PG8_SA(b, h) (((b) * 2 + (h)) * HTB)
#define PG8_SB(b, h) ((4 + (b) * 2 + (h)) * HTB)
#define PG8_STAGEB(bufoff, gbase, vo) do { const char* _b = (const char*)(gbase); asm volatile("" : "+s"(_b));   _Pragma("unroll") for (int _i = 0; _i < 2; ++_i) \
        __builtin_amdgcn_global_load_lds((const unsigned*)(_b + (vo)[_i]), (LAS unsigned*)(lds + (bufoff) + ldsw + _i * 8192), 16, 0, 0); } while (0)
#define PG8_STAGEA(bufoff, kb, offs) do { const char* _b = gA + (size_t)(kb); asm volatile("" : "+s"(_b)); _Pragma("unroll") for (int _i = 0; _i < 2; ++_i) \
        __builtin_amdgcn_global_load_lds((const unsigned*)(_b + (offs)[_i]), (LAS unsigned*)(lds + (bufoff) + ldsw + _i * 8192), 16, 0, 0); } while (0)
#define PG8_LD8(p) __builtin_shufflevector(*(const LAS v4i_t*)(p), *(const LAS v4i_t*)((p) + 1024), 0, 1, 2, 3, 4, 5, 6, 7)
#define PG8_LDA(dst, b, h) do { _Pragma("unroll") for (int m = 0; m < 4; ++m) dst[m] = PG8_LD8(lds + PG8_SA(b, h) + aoff + m * 2048); } while (0)
#define PG8_LDB(dst, b, h) do { _Pragma("unroll") for (int n = 0; n < 2; ++n) dst[n] = PG8_LD8(lds + PG8_SB(b, h) + boff + n * 2048); } while (0)
#define PG8_LO(v) __builtin_bit_cast(bf16x8, __builtin_shufflevector(v, v, 0, 1, 2, 3))
#define PG8_HI(v) __builtin_bit_cast(bf16x8, __builtin_shufflevector(v, v, 4, 5, 6, 7))
#define PG8_MMA(ai, bj, At, Bt) do { __builtin_amdgcn_s_setprio(1); _Pragma("unroll") for (int m = 0; m < 4; ++m) _Pragma("unroll") for (int n = 0; n < 2; ++n) { \
        if constexpr (FP8) acc[ai][bj][m][n] = __builtin_amdgcn_mfma_scale_f32_16x16x128_f8f6f4(Bt[n], At[m], acc[ai][bj][m][n], 0, 0, 0, 0x7f7f7f7f, 0, 0x7f7f7f7f); \
        else { acc[ai][bj][m][n] = __builtin_amdgcn_mfma_f32_16x16x32_bf16(PG8_LO(Bt[n]), PG8_LO(At[m]), acc[ai][bj][m][n], 0, 0, 0); \
               acc[ai][bj][m][n] = __builtin_amdgcn_mfma_f32_16x16x32_bf16(PG8_HI(Bt[n]), PG8_HI(At[m]), acc[ai][bj][m][n], 0, 0, 0); } } \
        __builtin_amdgcn_s_setprio(0); } while (0)
#define PG8_WAIT_V(n) asm volatile("s_waitcnt vmcnt(" #n ")" ::: "memory")
#define PG8_WAIT_L(n) asm volatile("s_waitcnt lgkmcnt(" #n ")" ::: "memory")
#define PG8_BAR __builtin_amdgcn_s_barrier()
#define PG8_SCHED __builtin_amdgcn_sched_barrier(0)
#define PG8_AOFFS(dst, U) do { const int _t = fresh_tid(wave); _Pragma("unroll") for (int _i = 0; _i < 2; ++_i) { int _R, _C; stage_rc(_t * 16 + _i * 8192, _R, _C); _Pragma("unroll") for (int _h = 0; _h < 2; ++_h) dst[_h][_i] = S.a_off(U, _h * HALF + _R) + (unsigned)(_C * 2); } } while (0)
    Unit cur, nxt; int ui = 0;
    if (!S.next(0, cur)) return;
    f32x4 acc[2][2][4][2];
#pragma unroll
    for (int a = 0; a < 2; ++a)
#pragma unroll
        for (int b = 0; b < 2; ++b)
#pragma unroll
            for (int m = 0; m < 4; ++m)
#pragma unroll
                for (int n = 0; n < 2; ++n) acc[a][b][m][n] = (f32x4){0.f, 0.f, 0.f, 0.f};
    v8i_t At[4], B0[2], B1[2];
    unsigned ua[2][2];
    LAS u32x4* nslot = (LAS u32x4*)(lds + RING_BYTES_C + 4096) + tid;
    PG8_AOFFS(ua, cur);
    const char* cB = uniform_ptr(cur.bptr);
    PG8_STAGEB(PG8_SB(0, 0), cB, voffB); PG8_STAGEB(PG8_SB(0, 1), cB + hstep, voffB); PG8_STAGEA(PG8_SA(0, 0), 0, ua[0]); PG8_STAGEA(PG8_SA(0, 1), 0, ua[1]);
    if (wr == 1) PG8_BAR;
    PG8_WAIT_V(2); PG8_BAR;
    PG8_STAGEB(PG8_SB(1, 0), cB + kstep, voffB); PG8_STAGEA(PG8_SA(1, 0), kstep, ua[0]); PG8_STAGEB(PG8_SB(1, 1), cB + hstep + kstep, voffB);
    PG8_WAIT_V(6); PG8_BAR;
    for (;;) {
        const bool has_next = S.next(ui + 1, nxt);
        {
            unsigned nua[2][2];
            if (has_next) { PG8_AOFFS(nua, nxt); } else {
#pragma unroll
                for (int h = 0; h < 2; ++h)
#pragma unroll
                    for (int i = 0; i < 2; ++i) nua[h][i] = ua[h][i]; }
            *nslot = (u32x4){nua[0][0], nua[0][1], nua[1][0], nua[1][1]};
        }
        const char* nB = uniform_ptr(has_next ? nxt.bptr : cB);
        for (int t = 0; t < nt; t += 2) {
            const bool last = (t == nt - 2);
            const size_t k1 = (size_t)(t + 1) * kstep;
            const size_t k2 = last ? 0 : (size_t)(t + 2) * kstep, k3 = k2 + kstep;
            const char* b2 = last ? nB : cB + (size_t)(t + 2) * kstep; const char* b3 = b2 + kstep;
            asm volatile("" : "+v"(ua[0][0]), "+v"(ua[0][1]), "+v"(ua[1][0]), "+v"(ua[1][1]), "+v"(voffB[0]), "+v"(voffB[1]));
            unsigned a2o[2][2];
#pragma unroll
            for (int h = 0; h < 2; ++h)
#pragma unroll
                for (int i = 0; i < 2; ++i) a2o[h][i] = ua[h][i];
            if (last) { asm volatile("" ::: "memory"); const u32x4 nv = *nslot; a2o[0][0] = nv.x; a2o[0][1] = nv.y; a2o[1][0] = nv.z; a2o[1][1] = nv.w; }
            PG8_LDB(B0, 0, 0); PG8_LDB(B1, 0, 1); PG8_SCHED; PG8_LDA(At, 0, 0); PG8_STAGEA(PG8_SA(1, 1), k1, ua[1]);
            PG8_WAIT_V(8); PG8_WAIT_L(0); PG8_BAR; PG8_MMA(0, 0, At, B0); PG8_MMA(0, 1, At, B1); PG8_BAR; PG8_SCHED;
            PG8_LDA(At, 0, 1); PG8_STAGEB(PG8_SB(0, 0), b2, voffB); PG8_STAGEB(PG8_SB(0, 1), b2 + hstep, voffB); PG8_STAGEA(PG8_SA(0, 0), k2, a2o[0]);
            PG8_WAIT_V(8); PG8_WAIT_L(0); PG8_BAR; PG8_MMA(1, 0, At, B0); PG8_MMA(1, 1, At, B1); PG8_BAR; PG8_SCHED;
            PG8_LDB(B0, 1, 0); PG8_LDB(B1, 1, 1); PG8_SCHED; PG8_LDA(At, 1, 0); PG8_STAGEA(PG8_SA(0, 1), k2, a2o[1]);
            PG8_WAIT_V(8); PG8_WAIT_L(0); PG8_BAR; PG8_MMA(0, 0, At, B0); PG8_MMA(0, 1, At, B1); PG8_BAR; PG8_SCHED;
            PG8_LDA(At, 1, 1); PG8_STAGEB(PG8_SB(1, 0), b3, voffB); PG8_STAGEB(PG8_SB(1, 1), b3 + hstep, voffB); PG8_STAGEA(PG8_SA(1, 0), k3, a2o[0]);
            PG8_WAIT_V(8); PG8_WAIT_L(0); PG8_BAR; PG8_MMA(1, 0, At, B0); PG8_MMA(1, 1, At, B1); PG8_BAR; PG8_SCHED;
        }
        if constexpr (ALIGN_EPI) { if (wr == 0) PG8_BAR; }
        { const int _l = lane_id(); E(acc, cur, wr, wc, _l & 15, _l >> 4); }
        if (!has_next) break;
#pragma unroll
        for (int a = 0; a < 2; ++a)
#pragma unroll
            for (int b = 0; b < 2; ++b)
#pragma unroll
                for (int m = 0; m < 4; ++m)
#pragma unroll
                    for (int n = 0; n < 2; ++n) acc[a][b][m][n] = (f32x4){0.f, 0.f, 0.f, 0.f};
        cur = nxt; cB = nB; ++ui;
        { const u32x4 nv = *nslot; ua[0][0] = nv.x; ua[0][1] = nv.y; ua[1][0] = nv.z; ua[1][1] = nv.w; }
        if constexpr (ALIGN_EPI) { if (wr == 1) PG8_BAR; }
    }
    PG8_WAIT_V(0);
    if constexpr (!ALIGN_EPI) { if (wr == 0) PG8_BAR; }
    PG8_BAR;
#undef PG8_SA
#undef PG8_SB
#undef PG8_STAGEA
#undef PG8_STAGEB
#undef PG8_LDA
#undef PG8_LD8
#undef PG8_LO
#undef PG8_HI
#undef PG8_LDB
#undef PG8_MMA
#undef PG8_WAIT_V
#undef PG8_WAIT_L
#undef PG8_BAR
#undef PG8_SCHED
#undef PG8_AOFFS
}

struct EpiQKV {
    static constexpr bool PERM = true;
    bf16_t* O; const float* ropec; const float* ropes;
    __device__ __forceinline__ void operator()(const f32x4 (&acc)[2][2][4][2], const Unit& u, int wr, int wc, int fr, int fq) const {
        const int t = u.pn >> 2, colt = (u.pn & 3) * BM;
        bf16_t* base = O + (size_t)t * QKV_STRIDE;
        const int row0 = u.orow0 + wr * 64 + fr, col0 = colt + wc * 32 + 8 * fq;
        const float sc = (t == 0 || t == 3) ? C2 : 1.0f;
        const bool rope = t < 2;
        const int fi = 4 * (4 * (wc & 1) + fq);
        f32x4 cs[2][4], sn[2][4];
#pragma unroll
        for (int ai = 0; ai < 2; ++ai)
#pragma unroll
            for (int m = 0; m < 4; ++m) {
                cs[ai][m] = (f32x4){1.f, 1.f, 1.f, 1.f}; sn[ai][m] = (f32x4){0.f, 0.f, 0.f, 0.f};
                if (rope) { const int pos = (row0 + ai * HALF + m * 16) & (SEQ - 1); cs[ai][m] = *(const f32x4*)(ropec + pos * 32 + fi); sn[ai][m] = *(const f32x4*)(ropes + pos * 32 + fi); }
            }
#pragma unroll
        for (int ai = 0; ai < 2; ++ai)
#pragma unroll
            for (int m = 0; m < 4; ++m) {
                const int row = row0 + ai * HALF + m * 16;
                bf16_t* rowp = base + (size_t)row * GW + col0;
#pragma unroll
                for (int bj = 0; bj < 2; ++bj) {
                    const f32x4 x1 = acc[ai][bj][m][0], x2 = acc[ai][bj][m][1];
                    const f32x4 y1 = (x1 * cs[ai][m] - x2 * sn[ai][m]) * sc, y2 = (x2 * cs[ai][m] + x1 * sn[ai][m]) * sc;
                    u32x4 w; w.x = cvt_pk_bf16(y1[0], y1[1]); w.y = cvt_pk_bf16(y1[2], y1[3]); w.z = cvt_pk_bf16(y2[0], y2[1]); w.w = cvt_pk_bf16(y2[2], y2[3]);
                    *(u32x4*)(rowp + bj * HALF) = w;
                }
            }
    }
};

struct GroupedOrder {
    const LAS int* tab; int G, c, NT, total; const char* Bt; size_t bstride; int RB; const int* list; bool gather;
    const LAS int* rowtab;
    mutable int ecur;
    __device__ void init(const LAS int* tab_, int NT_, const void* Bt_, size_t bstride_bytes, int RB_, const int* list_, bool gather_, int G_, int c_, const LAS int* rowtab_) {
        tab = tab_; NT = NT_; Bt = (const char*)Bt_; bstride = bstride_bytes; RB = RB_; list = list_; gather = gather_; G = G_; c = c_; rowtab = rowtab_; ecur = 0;
        total = __builtin_amdgcn_readfirstlane(tab_[96 + 32]) * NT_; }
    __device__ bool next(int i, Unit& u) const {
        const int L = i * G + c; if (L >= total) return false;
        int wgid = L; { const int q = total / NXCD, r = total % NXCD, xcd = wgid % NXCD, off = wgid / NXCD; wgid = (xcd < r ? xcd * (q + 1) : r * (q + 1) + (xcd - r) * q) + off; }
        int e = ecur;
        while (e + 1 < NEXP && wgid >= __builtin_amdgcn_readfirstlane(tab[96 + e + 1]) * NT) ++e;
        ecur = e;
        const int local = wgid - __builtin_amdgcn_readfirstlane(tab[96 + e]) * NT, nrb = __builtin_amdgcn_readfirstlane(tab[32 + e]);
        const int rb = local % nrb, pn = local / nrb, ps = __builtin_amdgcn_readfirstlane(tab[64 + e]), cn = __builtin_amdgcn_readfirstlane(tab[e]);
        u.e = __builtin_amdgcn_readfirstlane(e); u.pn = __builtin_amdgcn_readfirstlane(pn); u.orow0 = __builtin_amdgcn_readfirstlane(ps + rb * BM); u.arow0 = __builtin_amdgcn_readfirstlane(gather ? (e * NTOK + rb * BM) : (ps + rb * BM));
        u.nvalid = __builtin_amdgcn_readfirstlane(cn - rb * BM); u.bptr = uniform_ptr(Bt + (size_t)u.e * bstride + (size_t)u.pn * BM * RB); u.ui = i;
        return true;
    }
    __device__ __forceinline__ unsigned a_off(const Unit& u, int r) const {
        int row;
        if (gather) { if (u.ui < ROWTAB_UNITS) row = rowtab[u.ui * BM + r]; else { row = 0; if (r < u.nvalid) row = list[u.arow0 + r] >> 2; } } else row = u.arow0 + r;
        return (unsigned)row * (unsigned)RB;
    }
    __device__ __forceinline__ void fill_rowtab(LAS int* wtab, int tid) const {
        if (tid < BM) { Unit u; const int keep = ecur;
            for (int i = 0; i < ROWTAB_UNITS && next(i, u); ++i) wtab[i * BM + tid] = (tid < u.nvalid) ? (list[u.arow0 + tid] >> 2) : 0;
            ecur = keep; }
    }
};
struct EpiGateUp {
    static constexpr bool PERM = true;
    unsigned char* H1; const float* bg; const float* bu;
    __device__ __forceinline__ void operator()(const f32x4 (&acc)[2][2][4][2], const Unit& u, int wr, int wc, int fr, int fq) const {
        const int row0 = u.orow0 + wr * 64 + fr, col0 = u.pn * HALF + wc * 32 + 8 * fq;
        const float* bgp = bg + (size_t)u.e * D_MODEL + col0; const float* bup = bu + (size_t)u.e * D_MODEL + col0;
        f32x4 bgv[2], buv[2];
#pragma unroll
        for (int n = 0; n < 2; ++n) { bgv[n] = *(const f32x4*)(bgp + 4 * n); buv[n] = *(const f32x4*)(bup + 4 * n); }
#pragma unroll
        for (int ai = 0; ai < 2; ++ai)
#pragma unroll
            for (int m = 0; m < 4; ++m) {
                float o[8];
#pragma unroll
                for (int n = 0; n < 2; ++n)
#pragma unroll
                    for (int j = 0; j < 4; ++j) {
                        float g = acc[ai][0][m][n][j] * W8_INV + bgv[n][j], uu = acc[ai][1][m][n][j] * W8_INV + buv[n][j];
                        g = fminf(g, 7.0f); uu = fminf(fmaxf(uu, -7.0f), 7.0f);
                        const float e = __builtin_amdgcn_exp2f(g * (-1.702f * 1.4426950408889634f));
                        o[4 * n + j] = (uu + 1.0f) * (g * __builtin_amdgcn_rcpf(1.0f + e));
                    }
                u32x2 w; w.x = cvt_pk4_fp8(o[0], o[1], o[2], o[3]); w.y = cvt_pk4_fp8(o[4], o[5], o[6], o[7]);
                *(u32x2*)(H1 + (size_t)(row0 + ai * HALF + m * 16) * D_MODEL + col0) = w;
            }
    }
};
struct EpiDown {
    static constexpr bool PERM = true;
    unsigned char* Y; const float* bd;
    __device__ __forceinline__ void operator()(const f32x4 (&acc)[2][2][4][2], const Unit& u, int wr, int wc, int fr, int fq) const {
        const int row0 = u.orow0 + wr * 64 + fr, col0 = u.pn * BM + wc * 32 + 8 * fq;
        const float* bp = bd + (size_t)u.e * D_MODEL + col0;
        f32x4 bv[2][2];
#pragma unroll
        for (int bj = 0; bj < 2; ++bj)
#pragma unroll
            for (int n = 0; n < 2; ++n) bv[bj][n] = *(const f32x4*)(bp + bj * HALF + 4 * n);
#pragma unroll
        for (int ai = 0; ai < 2; ++ai)
#pragma unroll
            for (int m = 0; m < 4; ++m) { unsigned char* rowp = Y + (size_t)(row0 + ai * HALF + m * 16) * D_MODEL + col0;
#pragma unroll
                for (int bj = 0; bj < 2; ++bj) { const f32x4 v0 = acc[ai][bj][m][0] * W8_INV + bv[bj][0], v1 = acc[ai][bj][m][1] * W8_INV + bv[bj][1];
                    u32x2 w; w.x = cvt_pk4_fp8(v0[0], v0[1], v0[2], v0[3]); w.y = cvt_pk4_fp8(v1[0], v1[1], v1[2], v1[3]);
                    *(u32x2*)(rowp + bj * HALF) = w; } }
    }
};
struct EpiOut {
    static constexpr bool PERM = true;
    const float* x; bf16_t* X1;
    __device__ __forceinline__ void operator()(const f32x4 (&acc)[2][2][4][2], const Unit& u, int wr, int wc, int fr, int fq) const {
        const int row0 = u.orow0 + wr * 64 + fr, col0 = u.pn * BM + wc * 32 + 8 * fq;
#pragma unroll
        for (int ai = 0; ai < 2; ++ai) {
            f32x4 xr[4][2][2];
#pragma unroll
            for (int m = 0; m < 4; ++m)
#pragma unroll
                for (int bj = 0; bj < 2; ++bj)
#pragma unroll
                    for (int n = 0; n < 2; ++n) xr[m][bj][n] = *(const f32x4*)(x + (size_t)(row0 + ai * HALF + m * 16) * D_MODEL + col0 + bj * HALF + n * 4);
#pragma unroll
            for (int m = 0; m < 4; ++m)
#pragma unroll
                for (int bj = 0; bj < 2; ++bj) { const f32x4 v0 = xr[m][bj][0] + acc[ai][bj][m][0], v1 = xr[m][bj][1] + acc[ai][bj][m][1];
                    u32x4 w; w.x = cvt_pk_bf16(v0[0], v0[1]); w.y = cvt_pk_bf16(v0[2], v0[3]); w.z = cvt_pk_bf16(v1[0], v1[1]); w.w = cvt_pk_bf16(v1[2], v1[3]);
                    *(u32x4*)(X1 + (size_t)(row0 + ai * HALF + m * 16) * D_MODEL + col0 + bj * HALF) = w; }
        }
    }
};
}

constexpr int NWAVES = 8;
constexpr int RING_BYTES = 131072, MISC_OFF = RING_BYTES + 320, LDS_BYTES = 163840, ROWTAB_OFF = RING_BYTES + 16384;
struct Args { const float* in[16]; float* out; unsigned char* ws; int ph_lo, ph_hi; };
constexpr int NPHASE = 9;
#ifndef NCONV
#define NCONV 128
#endif

struct Frame {
    LAS unsigned char* lds; int vcu, G, wave; unsigned char* ws;
};

template <class RM>
__device__ __forceinline__ void conv_tile(const float* __restrict__ W, int N, bf16_t* __restrict__ Wt, int K, int kb, int nb, int lane, const RM& rm) {
    const int kg = lane & 7, ng = lane >> 3;
    const int k0 = kb * 64 + kg * 8, n0 = nb * 32 + ng * 4;
    f32x4 v[8];
#pragma unroll
    for (int j = 0; j < 8; ++j) v[j] = __builtin_nontemporal_load((const f32x4*)(W + (size_t)(k0 + j) * N + n0));
#pragma unroll
    for (int c = 0; c < 4; ++c) {
        u32x4 o; o.x = cvt_pk_bf16(v[0][c], v[1][c]); o.y = cvt_pk_bf16(v[2][c], v[3][c]); o.z = cvt_pk_bf16(v[4][c], v[5][c]); o.w = cvt_pk_bf16(v[6][c], v[7][c]);
        *(u32x4*)(Wt + (size_t)rm(n0 + c) * K + k0) = o;
    }
}
template <class RM>
__device__ __forceinline__ void conv_tile8(const float* __restrict__ W, int N, unsigned char* __restrict__ Wt, int K, int kb, int nb, int lane, const RM& rm) {
    const int kg = lane & 7, ng = lane >> 3;
    const int k0 = kb * 64 + kg * 8, n0 = nb * 32 + ng * 4;
    f32x4 v[8];
#pragma unroll
    for (int j = 0; j < 8; ++j) v[j] = __builtin_nontemporal_load((const f32x4*)(W + (size_t)(k0 + j) * N + n0)) * W8_SCALE;
#pragma unroll
    for (int c = 0; c < 4; ++c) {
        u32x2 o; o.x = cvt_pk4_fp8(v[0][c], v[1][c], v[2][c], v[3][c]); o.y = cvt_pk4_fp8(v[4][c], v[5][c], v[6][c], v[7][c]);
        *(u32x2*)(Wt + (size_t)rm(n0 + c) * K + k0) = o;
    }
}
struct RmIdent { __device__ __forceinline__ int operator()(int n) const { return n; } };
struct RmWin {
    __device__ __forceinline__ int operator()(int n) const { if (n >= 2048) return n; const int o = n & 63, a = (o & 31) >> 2, j = (o & 3) + ((o >> 5) << 2); return (n & ~63) + 8 * a + j; } };
struct RmGU { int up; __device__ __forceinline__ int operator()(int n) const { return 256 * (n >> 7) + 128 * up + (n & 127); } };

__device__ __forceinline__ void p0_prologue(const Frame& F, const Args& a) {
    unsigned char* ws = F.ws;
    const int tid_ = fresh_tid(F.wave), lane = tid_ & 63, wave_ = F.wave;
    const int gw = F.vcu * NWAVES + wave_, NGW = F.G * NWAVES;
    const float* x = a.in[0]; const float* attn_norm = a.in[1]; const float* w_in = a.in[2]; const float* w_out = a.in[5]; const float* w_router = a.in[7];
    {
        f32x4 gn[8];
#pragma unroll
        for (int j = 0; j < 8; ++j) gn[j] = *((const f32x4*)attn_norm + lane + 64 * j);
        for (int r0 = gw; r0 < NTOK; r0 += NGW * 4) {
            f32x4 v[4][8];
#pragma unroll
            for (int t = 0; t < 4; ++t) { const int r = (r0 + t * NGW < NTOK) ? r0 + t * NGW : r0; const f32x4* xr = (const f32x4*)(x + (size_t)r * D_MODEL) + lane;
#pragma unroll
                for (int j = 0; j < 8; ++j) v[t][j] = xr[64 * j]; }
#pragma unroll
            for (int t = 0; t < 4; ++t) { const int r = r0 + t * NGW; if (r < NTOK) {
                float s = 0.f;
#pragma unroll
                for (int j = 0; j < 8; ++j) s += (v[t][j].x * v[t][j].x + v[t][j].y * v[t][j].y) + (v[t][j].z * v[t][j].z + v[t][j].w * v[t][j].w);
                const float rstd = rsqrtf(wave_sum(s) * (1.f / D_MODEL) + EPS);
                u32x2* o = (u32x2*)((bf16_t*)(ws + WS_XN) + (size_t)r * D_MODEL) + lane;
#pragma unroll
                for (int j = 0; j < 8; ++j) { u32x2 w; w.x = cvt_pk_bf16(v[t][j].x * rstd * gn[j].x, v[t][j].y * rstd * gn[j].y); w.y = cvt_pk_bf16(v[t][j].z * rstd * gn[j].z, v[t][j].w * rstd * gn[j].w); o[64 * j] = w; } } }
        }
    }
    for (int i = gw * 64 + lane; i < SEQ * 32; i += NGW * 64) {
        const int pos = i >> 5, f = i & 31;
        const float inv_freq = 1.0f / powf(10000.0f, (float)f * 2.0f / 64.0f);
        const float ang = (float)pos * inv_freq;
        ((float*)(ws + WS_ROPEC))[i] = cosf(ang); ((float*)(ws + WS_ROPES))[i] = sinf(ang);
    }
    for (int i = gw * 64 + lane; i < NEXP * D_MODEL; i += NGW * 64) { const int e = i >> 11, k = i & 2047; ((float*)(ws + WS_WRT))[i] = w_router[(size_t)k * NEXP + e]; }
    constexpr int T_IN = 32 * 192, T_OUT = 32 * 64, T_E = 32 * 64;
    {
        const int kg = lane & 7, ng = lane >> 3;
        auto tile_of = [&](int it, const float*& W, int& N, bf16_t*& Wt, int& k0, int& n0, bool& win) {
            win = it < T_IN; const int r = win ? it : it - T_IN, nbk = win ? 192 : 64;
            W = win ? w_in : w_out; N = win ? INW : D_MODEL; Wt = (bf16_t*)(ws + (win ? WS_WIN : WS_WOUT)); k0 = (r / nbk) * 64 + kg * 8; n0 = (r % nbk) * 32 + ng * 4; };
        for (int it0 = gw; it0 < T_IN + T_OUT; it0 += NGW * 2) {
            f32x4 v[2][8];
#pragma unroll
            for (int t = 0; t < 2; ++t) { const int it = (it0 + t * NGW < T_IN + T_OUT) ? it0 + t * NGW : it0; const float* W; int N, k0, n0; bf16_t* Wt; bool win; tile_of(it, W, N, Wt, k0, n0, win);
#pragma unroll
                for (int j = 0; j < 8; ++j) v[t][j] = __builtin_nontemporal_load((const f32x4*)(W + (size_t)(k0 + j) * N + n0)); }
#pragma unroll
            for (int t = 0; t < 2; ++t) { const int it = it0 + t * NGW; if (it < T_IN + T_OUT) { const float* W; int N, k0, n0; bf16_t* Wt; bool win; tile_of(it, W, N, Wt, k0, n0, win);
#pragma unroll
                for (int c = 0; c < 4; ++c) {
                    u32x4 o; o.x = cvt_pk_bf16(v[t][0][c], v[t][1][c]); o.y = cvt_pk_bf16(v[t][2][c], v[t][3][c]); o.z = cvt_pk_bf16(v[t][4][c], v[t][5][c]); o.w = cvt_pk_bf16(v[t][6][c], v[t][7][c]);
                    const int n = n0 + c, row = win ? RmWin{}(n) : n;
                    *(u32x4*)(Wt + (size_t)row * D_MODEL + k0) = o; } } }
        }
    }
}

constexpr int CV_T_E = 32 * 64, CV_NTILES = 3 * NEXP * CV_T_E, CV_ITEM_TILES = 64, CV_NITEMS = CV_NTILES / CV_ITEM_TILES;
constexpr int LDS_QSLOT = RING_BYTES + 2048;
__device__ __forceinline__ void conv_items(const Frame& F, const Args& a, const unsigned* stop_word, unsigned stop_count, int qword = CW_CONVQ) {
    unsigned char* ws = F.ws;
    const int tid = fresh_tid(F.wave), lane = tid & 63;
    const float* w_gate = a.in[9]; const float* w_up = a.in[11]; const float* w_down = a.in[13];
    unsigned* qn = (unsigned*)(ws + WS_CTL) + qword;
    LAS int* s_item = (LAS int*)(F.lds + LDS_QSLOT);
    for (;;) {
        if (tid == 0) {
            int it = -1;
            const bool stop = stop_word && __hip_atomic_load(stop_word, __ATOMIC_RELAXED, __HIP_MEMORY_SCOPE_AGENT) >= stop_count;
            if (!stop) it = (int)__hip_atomic_fetch_add(qn, 1u, __ATOMIC_RELAXED, __HIP_MEMORY_SCOPE_AGENT);
            *s_item = it;
        }
        __syncthreads();
        const int item = __builtin_amdgcn_readfirstlane(*s_item);
        __syncthreads();
        if (item < 0 || item >= CV_NITEMS) break;
        const int mat = item / (NEXP * 32), r = item - mat * (NEXP * 32), e = r >> 5, kb = (r >> 1) & 15, nh = r & 1;
        const int kh = F.wave >> 2, wq = F.wave & 3;
        const float* W = (mat == 0 ? w_gate : mat == 1 ? w_up : w_down) + (size_t)e * D_MODEL * D_MODEL;
        const float* s = W + (size_t)(kb * 128 + kh * 64) * D_MODEL + nh * 1024 + wq * 256 + lane * 4;
        unsigned char* dst = ((mat == 2) ? (ws + WS_WD + (size_t)e * D_MODEL * D_MODEL) : (ws + WS_WGU + (size_t)e * 4096 * D_MODEL)) + kb * 128;
        LAS unsigned char* T = F.lds;
        const int nl = wq * 256 + lane * 4, fz = lane & 15;
        constexpr int CVD = 3;
        f32x4 v[CVD][8];
#pragma unroll
        for (int d = 0; d < CVD - 1; ++d)
#pragma unroll
            for (int j = 0; j < 8; ++j) v[d][j] = __builtin_nontemporal_load((const f32x4*)(s + (size_t)(d * 8 + j) * D_MODEL));
#pragma unroll
        for (int st = 0; st < 8; ++st) {
            if (st + CVD - 1 < 8) {
#pragma unroll
                for (int j = 0; j < 8; ++j) v[(st + CVD - 1) % CVD][j] = __builtin_nontemporal_load((const f32x4*)(s + (size_t)((st + CVD - 1) * 8 + j) * D_MODEL)); }
            const f32x4* vv = v[st % CVD];
#pragma unroll
            for (int c = 0; c < 4; ++c) {
                u32x2 o; o.x = cvt_pk4_fp8(vv[0][c] * W8_SCALE, vv[1][c] * W8_SCALE, vv[2][c] * W8_SCALE, vv[3][c] * W8_SCALE); o.y = cvt_pk4_fp8(vv[4][c] * W8_SCALE, vv[5][c] * W8_SCALE, vv[6][c] * W8_SCALE, vv[7][c] * W8_SCALE);
                *(LAS u32x2*)(T + (nl + c) * 128 + (((kh * 8 + st) ^ fz) * 8)) = o;
            }
        }
        __syncthreads();
#pragma unroll
        for (int i = 0; i < 16; ++i) {
            const int id = tid + 512 * i, nn = id >> 3, q = id & 7, f = (nn >> 2) & 15, n = nh * 1024 + nn;
            u32x4 d = *(const LAS u32x4*)(T + nn * 128 + (((2 * q) ^ (f & 14)) * 8));
            if (f & 1) d = (u32x4){d.z, d.w, d.x, d.y};
            const int row = (mat == 2) ? n : (256 * (n >> 7) + 128 * mat + (n & 127));
            __builtin_nontemporal_store(d, (u32x4*)(dst + (size_t)row * D_MODEL + 16 * q));
        }
        __syncthreads();
    }
}

namespace attn {
typedef float f32x16 __attribute__((ext_vector_type(16)));
typedef short s16x4 __attribute__((ext_vector_type(4)));
typedef short v4i16_t __attribute__((ext_vector_type(4)));
#define MFMA32(a, b, c) __builtin_amdgcn_mfma_f32_32x32x16_bf16(a, b, c, 0, 0, 0)
__device__ __forceinline__ int crow(int r, int hi) { return (r & 3) + 8 * (r >> 2) + 4 * hi; }
__device__ __forceinline__ s16x4 vtr(const LAS unsigned char* p) { return __builtin_bit_cast(s16x4, __builtin_amdgcn_ds_read_tr16_b64_v4i16((LAS v4i16_t*)p)); }
__device__ __forceinline__ float xhalf(float v) {
    auto rr = __builtin_amdgcn_permlane32_swap(__float_as_uint(v), __float_as_uint(v), false, false);
    return (lane_id() & 32) ? __uint_as_float(rr[0]) : __uint_as_float(rr[1]);
}
__device__ __forceinline__ bf16x8 pack8(const f32x16& p, int ks) {
    u32x4 w; w.x = cvt_pk_bf16(p[8 * ks + 0], p[8 * ks + 1]); w.y = cvt_pk_bf16(p[8 * ks + 2], p[8 * ks + 3]); w.z = cvt_pk_bf16(p[8 * ks + 4], p[8 * ks + 5]); w.w = cvt_pk_bf16(p[8 * ks + 6], p[8 * ks + 7]);
    return __builtin_bit_cast(bf16x8, w);
}
__device__ __forceinline__ bf16x8 cat44(s16x4 lo, s16x4 hi) { bf16x8 r; r[0] = lo[0]; r[1] = lo[1]; r[2] = lo[2]; r[3] = lo[3]; r[4] = hi[0]; r[5] = hi[1]; r[6] = hi[2]; r[7] = hi[3]; return r; }
__device__ __forceinline__ void store_ot(const f32x16 (&O)[2], float scale, bf16_t* orow, int hi) {
#pragma unroll
    for (int dh = 0; dh < 2; ++dh)
#pragma unroll
        for (int g = 0; g < 4; ++g) { u32x2 w; w.x = cvt_pk_bf16(O[dh][4 * g] * scale, O[dh][4 * g + 1] * scale); w.y = cvt_pk_bf16(O[dh][4 * g + 2] * scale, O[dh][4 * g + 3] * scale);
            *(u32x2*)(orow + 32 * dh + 8 * g + 4 * hi) = w; }
}

constexpr int DA_ROWS = 384, DA_KPL = (DA_ROWS + 1) * 16, DA_VHL = DA_ROWS * 64 + 64, DA_VOFF = 8 * DA_KPL, DA_LDS = DA_VOFF + 2 * DA_VHL;
struct DaUnit { int b, h, p, ib; };
struct DaRegs { u32x4 kv[6], vv[6]; bf16x8 qf[4]; int tokq, uq; };
__device__ __forceinline__ void da_load(DaRegs& R, const bf16_t* __restrict__ QD, const bf16_t* __restrict__ KD, const bf16_t* __restrict__ VD, const DaUnit& u, int tid) {
    const int lane = tid & 63, wid = __builtin_amdgcn_readfirstlane(tid >> 6), r32 = lane & 31, hi = lane >> 5;
    const int lgL = 11 - 2 * u.p, dsh = 2 * u.p, Lm1 = (1 << lgL) - 1, i0 = u.ib * 256;
#pragma unroll
    for (int t = 0; t < 6; ++t) {
        const int idx = tid + 512 * t, j = idx >> 3, c = idx & 7, ip = i0 - 128 + j;
        R.kv[t] = (u32x4){0u, 0u, 0u, 0u}; R.vv[t] = (u32x4){0u, 0u, 0u, 0u};
        if (ip >= 0) { const int pos = ((ip & Lm1) << dsh) + (ip >> lgL); const size_t go = (size_t)(u.b * SEQ + pos) * GW + u.h * 64 + c * 8; R.kv[t] = *(const u32x4*)(KD + go); R.vv[t] = *(const u32x4*)(VD + go); }
    }
    const int iq = i0 + 32 * wid + r32; R.uq = iq & Lm1; R.tokq = u.b * SEQ + (R.uq << dsh) + (iq >> lgL);
#pragma unroll
    for (int d0 = 0; d0 < 4; ++d0) R.qf[d0] = *(const bf16x8*)(QD + (size_t)R.tokq * GW + u.h * 64 + 16 * d0 + 8 * hi);
}
__device__ __forceinline__ void da_fill(LAS unsigned char* lds, const DaRegs& R, int tid) {
#pragma unroll
    for (int t = 0; t < 6; ++t) {
        const int idx = tid + 512 * t, j = idx >> 3, c = idx & 7;
        *(LAS u32x4*)(lds + c * DA_KPL + j * 16) = R.kv[t];
        *(LAS u32x4*)(lds + DA_VOFF + (c >> 2) * DA_VHL + j * 64 + (c & 3) * 16) = R.vv[t];
    }
}
__device__ __forceinline__ void da_compute(const LAS unsigned char* lds, const bf16x8 (&qf)[4], int tokq, int uq, bf16_t* __restrict__ OP, float* __restrict__ LSE, int h, int p, int tid) {
    const int lane = tid & 63, wid = __builtin_amdgcn_readfirstlane(tid >> 6), r32 = lane & 31, hi = lane >> 5;
    f32x16 S[5];
#pragma unroll
    for (int s = 0; s < 5; ++s) {
        S[s] = (f32x16){};
#pragma unroll
        for (int d0 = 0; d0 < 4; ++d0) { const bf16x8 kf = *(const LAS bf16x8*)(lds + (2 * d0 + hi) * DA_KPL + (32 * wid + 32 * s + r32) * 16); S[s] = MFMA32(kf, qf[d0], S[s]); }
    }
    const int lim = uq < 128 ? uq : 128, lv = r32 - 4 * hi;
    float mx = -INFINITY;
#pragma unroll
    for (int s = 0; s < 5; ++s)
#pragma unroll
        for (int r = 0; r < 16; ++r) { const int dist = lv + (128 - 32 * s - ((r & 3) + 8 * (r >> 2))); const bool ok = (dist >= 0) && (dist <= lim); const float v = ok ? S[s][r] : -INFINITY; S[s][r] = v; mx = fmaxf(mx, v); }
    mx = fmaxf(mx, xhalf(mx));
    float l = 0.f;
#pragma unroll
    for (int s = 0; s < 5; ++s)
#pragma unroll
        for (int r = 0; r < 16; ++r) { const float pv = __builtin_amdgcn_exp2f(S[s][r] - mx); S[s][r] = pv; l += pv; }
    l += xhalf(l);
    f32x16 O[2]; O[0] = (f32x16){}; O[1] = (f32x16){};
    const LAS unsigned char* vb = lds + DA_VOFF + (32 * wid + 4 * hi + ((lane & 15) >> 2)) * 64 + ((lane >> 4) & 1) * 32 + (lane & 3) * 8;
#pragma unroll
    for (int s = 0; s < 5; ++s)
#pragma unroll
        for (int ks = 0; ks < 2; ++ks) {
            const bf16x8 pb = pack8(S[s], ks);
#pragma unroll
            for (int dh = 0; dh < 2; ++dh) { const LAS unsigned char* a = vb + dh * DA_VHL + (32 * s + 16 * ks) * 64; O[dh] = MFMA32(cat44(vtr(a), vtr(a + 512)), pb, O[dh]); }
        }
    store_ot(O, 1.0f / l, OP + ((size_t)p * NTOK + tokq) * GW + h * 64, hi);
    if (hi == 0) LSE[((size_t)p * NTOK + tokq) * NH + h] = mx + __builtin_amdgcn_logf(l);
}

constexpr int SB_ROWS = 448, SB_KPL = (SB_ROWS + 1) * 16, SB_VHL = SB_ROWS * 64 + 64, SB_VOFF = 8 * SB_KPL, SB_LDS = SB_VOFF + 2 * SB_VHL, SB_FLAGS = SB_LDS;
static_assert(SB_LDS + 64 <= 131072, "stick-breaking chunk image fits the phase scratch region");
__device__ __forceinline__ void sb_unit(LAS unsigned char* lds, const bf16_t* __restrict__ QS, const bf16_t* __restrict__ KS, const bf16_t* __restrict__ VS, bf16_t* __restrict__ OSB,
                                        int b, int h, int qb, int tid) {
    const int lane = tid & 63, wid = __builtin_amdgcn_readfirstlane(tid >> 6), r32 = lane & 31, hi = lane >> 5;
    const int t0w = 256 * qb + 32 * wid, tq = t0w + r32, tokq = b * SEQ + tq;
    bf16x8 qf[4];
#pragma unroll
    for (int d0 = 0; d0 < 4; ++d0) qf[d0] = *(const bf16x8*)(QS + (size_t)tokq * GW + h * 64 + 16 * d0 + 8 * hi);
    f32x16 O[2]; O[0] = (f32x16){}; O[1] = (f32x16){};
    float C = 0.f;
    bool done = false;
    const int vlane = (4 * hi + ((lane & 15) >> 2)) * 64 + ((lane >> 4) & 1) * 32 + (lane & 3) * 8;
    LAS int* s_need = (LAS int*)(lds + SB_FLAGS);
    int khi = 256 * qb + 255;
    for (;;) {
        const int klo = (khi - (SB_ROWS - 1)) > 0 ? (khi - (SB_ROWS - 1)) : 0, nrows = khi - klo + 1;
        {
            u32x4 kr[7], vr[7];
#pragma unroll
            for (int t = 0; t < 7; ++t) { const int idx = tid + 512 * t, j = idx >> 3, c = idx & 7;
                kr[t] = (u32x4){0u, 0u, 0u, 0u}; vr[t] = (u32x4){0u, 0u, 0u, 0u};
                if (j < nrows) { const size_t go = (size_t)(b * SEQ + klo + j) * GW + h * 64 + c * 8; kr[t] = *(const u32x4*)(KS + go); vr[t] = *(const u32x4*)(VS + go); } }
#pragma unroll
            for (int t = 0; t < 7; ++t) { const int idx = tid + 512 * t, j = idx >> 3, c = idx & 7;
                *(LAS u32x4*)(lds + c * SB_KPL + j * 16) = kr[t]; *(LAS u32x4*)(lds + SB_VOFF + (c >> 2) * SB_VHL + j * 64 + (c & 3) * 16) = vr[t]; }
        }
        __syncthreads();
        if (!done) {
            for (int kt = khi >> 6; kt >= (klo >> 6); --kt) {
                if (64 * kt > t0w + 30) continue;
                const bool diag = (64 * kt + 63 >= t0w);
                const LAS unsigned char* kb = lds + (64 * kt - klo) * 16; const LAS unsigned char* vb = lds + SB_VOFF + (64 * kt - klo) * 64 + vlane;
#pragma unroll
                for (int sub = 1; sub >= 0; --sub) {
                    const int keyb = 64 * kt + 32 * sub;
                    if (keyb > t0w + 30) continue;
                    f32x16 Z = (f32x16){};
#pragma unroll
                    for (int d0 = 0; d0 < 4; ++d0) { const bf16x8 kf = *(const LAS bf16x8*)(kb + (2 * d0 + hi) * SB_KPL + (32 * sub + r32) * 16); Z = MFMA32(kf, qf[d0], Z); }
                    const int kl = keyb + 4 * hi;
                    float sp[16];
#pragma unroll
                    for (int r = 0; r < 16; ++r) { const float e = __builtin_amdgcn_exp2f(Z[r]); float v = __builtin_amdgcn_logf(1.0f + e); if (diag) { const bool ok = (kl + (r & 3) + 8 * (r >> 2)) < tq; v = ok ? v : 0.f; } sp[r] = v; }
                    float own[4], oth[4];
#pragma unroll
                    for (int g = 0; g < 4; ++g) { sp[4 * g + 2] += sp[4 * g + 3]; sp[4 * g + 1] += sp[4 * g + 2]; sp[4 * g] += sp[4 * g + 1]; own[g] = sp[4 * g]; oth[g] = xhalf(own[g]); }
                    float off[4]; float run = C;
#pragma unroll
                    for (int g = 3; g >= 0; --g) { off[g] = run + (hi == 0 ? oth[g] : 0.f); run += own[g] + oth[g]; }
                    C = run;
#pragma unroll
                    for (int r = 0; r < 16; ++r) { float a = __builtin_amdgcn_exp2f(Z[r] - (off[r >> 2] + sp[r])); if (diag) { const bool ok = (kl + (r & 3) + 8 * (r >> 2)) < tq; a = ok ? a : 0.f; } Z[r] = a; }
#pragma unroll
                    for (int ks = 0; ks < 2; ++ks) {
                        const bf16x8 pb = pack8(Z, ks);
#pragma unroll
                        for (int dh = 0; dh < 2; ++dh) { const LAS unsigned char* a = vb + dh * SB_VHL + (32 * sub + 16 * ks) * 64; O[dh] = MFMA32(cat44(vtr(a), vtr(a + 512)), pb, O[dh]); }
                    }
                }
                float cm = C;
#pragma unroll
                for (int o = 1; o < 32; o <<= 1) cm = fminf(cm, __shfl_xor(cm, o));
                if (__builtin_amdgcn_readfirstlane(__float_as_int(cm)) >= __float_as_int(150.0f)) { done = true; break; }
            }
        }
        if (lane == 0) s_need[wid] = (!done && klo > 0) ? 1 : 0;
        __syncthreads();
        int any = 0;
#pragma unroll
        for (int i = 0; i < 8; ++i) any |= s_need[i];
        __syncthreads();
        if (!any) break;
        khi = klo - 1;
    }
    store_ot(O, 1.0f, OSB + (size_t)tokq * GW + h * 64, hi);
}
#undef MFMA32
}

__device__ __forceinline__ void p3_combine(const Frame& F, const Args& a) {
    unsigned char* ws = F.ws;
    const int tid_ = fresh_tid(F.wave), lane = tid_ & 63, wave_ = F.wave;
    const int gw = F.vcu * NWAVES + wave_, NGW = F.G * NWAVES;
    const bf16_t* OP = (const bf16_t*)(ws + WS_OP); const bf16_t* OSB = (const bf16_t*)(ws + WS_OSB); const float* LSE = (const float*)(ws + WS_LSE);
    bf16_t* ACAT = (bf16_t*)(ws + WS_ACAT);
    const float* gd = a.in[3]; const float* gs = a.in[4];
    const int hd = lane >> 2;
    float gdv[16], gsv[16];
#pragma unroll
    for (int j = 0; j < 16; ++j) { gdv[j] = gd[lane * 16 + j]; gsv[j] = gs[lane * 16 + j]; }
    constexpr int TB = 4;
    for (int tok0 = gw; tok0 < NTOK; tok0 += NGW * TB) {
        u32x4 ra[TB][4][2]; float ls[TB][3];
#pragma unroll
        for (int t = 0; t < TB; ++t) { const int tok = tok0 + t * NGW; if (tok < NTOK) {
#pragma unroll
            for (int p = 0; p < 3; ++p) { ls[t][p] = LSE[((size_t)p * NTOK + tok) * NH + hd]; const u32x4* pp = (const u32x4*)(OP + ((size_t)p * NTOK + tok) * GW + lane * 16); ra[t][p][0] = pp[0]; ra[t][p][1] = pp[1]; }
            const u32x4* ps = (const u32x4*)(OSB + (size_t)tok * GW + lane * 16); ra[t][3][0] = ps[0]; ra[t][3][1] = ps[1]; } }
#pragma unroll
        for (int t = 0; t < TB; ++t) { const int tok = tok0 + t * NGW; if (tok < NTOK) {
            const float mx = fmaxf(ls[t][0], fmaxf(ls[t][1], ls[t][2]));
            float w0 = __builtin_amdgcn_exp2f(ls[t][0] - mx), w1 = __builtin_amdgcn_exp2f(ls[t][1] - mx), w2 = __builtin_amdgcn_exp2f(ls[t][2] - mx);
            const float inv = 1.0f / (w0 + w1 + w2); w0 *= inv; w1 *= inv; w2 *= inv;
            float od[16], os[16];
#pragma unroll
            for (int q = 0; q < 2; ++q) { const u32x4 a0 = ra[t][0][q], a1 = ra[t][1][q], a2 = ra[t][2][q], as = ra[t][3][q];
#pragma unroll
                for (int j = 0; j < 4; ++j) {
                    od[8 * q + 2 * j] = w0 * __uint_as_float(a0[j] << 16) + w1 * __uint_as_float(a1[j] << 16) + w2 * __uint_as_float(a2[j] << 16);
                    od[8 * q + 2 * j + 1] = w0 * __uint_as_float(a0[j] & 0xffff0000u) + w1 * __uint_as_float(a1[j] & 0xffff0000u) + w2 * __uint_as_float(a2[j] & 0xffff0000u);
                    os[8 * q + 2 * j] = __uint_as_float(as[j] << 16); os[8 * q + 2 * j + 1] = __uint_as_float(as[j] & 0xffff0000u); } }
            float sd = 0.f, ss = 0.f;
#pragma unroll
            for (int j = 0; j < 16; ++j) { sd += od[j] * od[j]; ss += os[j] * os[j]; }
            const float rd = rsqrtf(wave_sum(sd) * (1.0f / GW) + EPS), rs = rsqrtf(wave_sum(ss) * (1.0f / GW) + EPS);
#pragma unroll
            for (int q = 0; q < 2; ++q) {
                u32x4 wd, wsb;
#pragma unroll
                for (int j = 0; j < 4; ++j) {
                    wd[j] = cvt_pk_bf16(od[8 * q + 2 * j] * rd * gdv[8 * q + 2 * j], od[8 * q + 2 * j + 1] * rd * gdv[8 * q + 2 * j + 1]);
                    wsb[j] = cvt_pk_bf16(os[8 * q + 2 * j] * rs * gsv[8 * q + 2 * j], os[8 * q + 2 * j + 1] * rs * gsv[8 * q + 2 * j + 1]); }
                *(u32x4*)(ACAT + (size_t)tok * D_MODEL + lane * 16 + 8 * q) = wd;
                *(u32x4*)(ACAT + (size_t)tok * D_MODEL + GW + lane * 16 + 8 * q) = wsb;
            } } }
    }
}

constexpr int ATT_NSB = BATCH * NH * 8, ATT_NDA = BATCH * NH * 3 * 8, ATT_NTOT = ATT_NSB + ATT_NDA;
__device__ __forceinline__ int att_grab(const Frame& F, int tid) {
    LAS int* s_item = (LAS int*)(F.lds + LDS_QSLOT);
    __syncthreads();
    if (tid == 0) *s_item = (int)__hip_atomic_fetch_add((unsigned*)(F.ws + WS_CTL) + CW_ATTQ, 1u, __ATOMIC_RELAXED, __HIP_MEMORY_SCOPE_AGENT);
    __syncthreads();
    return __builtin_amdgcn_readfirstlane(*s_item);
}
__device__ __forceinline__ void p2_attention(const Frame& F) {
    unsigned char* ws = F.ws; const int tid = fresh_tid(F.wave);
    const bf16_t* QKV = (const bf16_t*)(ws + WS_QKV);
    const bf16_t *QD = QKV, *KD = QKV + QKV_STRIDE, *VD = QKV + 2 * QKV_STRIDE, *QS = QKV + 3 * QKV_STRIDE, *KS = QKV + 4 * QKV_STRIDE, *VS = QKV + 5 * QKV_STRIDE;
    auto da_of = [](int id) { attn::DaUnit u; const int uid = id - ATT_NSB, pq = uid >> 3, bh = pq / 3; u.ib = uid & 7; u.p = pq % 3; u.b = bh >> 4; u.h = bh & 15; return u; };
    int cur = att_grab(F, tid);
    while (cur < ATT_NSB) {
        const int bh = cur >> 3; attn::sb_unit(F.lds, QS, KS, VS, (bf16_t*)(ws + WS_OSB), bh >> 4, bh & 15, 7 - (cur & 7), tid);
        cur = att_grab(F, tid);
    }
    if (cur < ATT_NTOT) {
        attn::DaRegs R;
        attn::da_load(R, QD, KD, VD, da_of(cur), tid);
        while (cur < ATT_NTOT) {
            const int nxt = att_grab(F, tid);
            const attn::DaUnit u = da_of(cur);
            attn::da_fill(F.lds, R, tid);
            bf16x8 qf[4]; qf[0] = R.qf[0]; qf[1] = R.qf[1]; qf[2] = R.qf[2]; qf[3] = R.qf[3];
            const int tokq = R.tokq, uq = R.uq;
            __syncthreads();
            if (nxt < ATT_NTOT) attn::da_load(R, QD, KD, VD, da_of(nxt), tid);
            attn::da_compute(F.lds, qf, tokq, uq, (bf16_t*)(ws + WS_OP), (float*)(ws + WS_LSE), u.h, u.p, tid);
            __syncthreads();
            cur = nxt;
        }
    }
}

constexpr int RT_RSTD = 0, RT_PART = 256, RT_LG = RT_PART + 8 * 32 * 32 * 4, RT_HIST = RT_LG + 32 * 32 * 4, RT_BASE = RT_HIST + 128, RT_SELE = RT_BASE + 128, RT_SELR = RT_SELE + 512, RT_SELG = RT_SELR + 512;
__device__ __forceinline__ void p5_router(const Frame& F, const Args& a) {
    unsigned char* ws = F.ws; LAS unsigned char* lds = F.lds;
    const int tid = fresh_tid(F.wave), lane = tid & 63, w = F.wave;
    const bf16_t* X1 = (const bf16_t*)(ws + WS_X1); const float* gain = a.in[6]; const float* wrT = (const float*)(ws + WS_WRT); const float* br = a.in[8];
    unsigned char* H2 = ws + WS_H2;
    int* cnt = (int*)(ws + WS_CTL) + CW_CNT; int* list = (int*)(ws + WS_LIST); int* a_exp = (int*)(ws + WS_AEXP); int* a_rank = (int*)(ws + WS_ARANK); float* a_gate = (float*)(ws + WS_AGATE);
    LAS float* s_rstd = (LAS float*)(lds + RT_RSTD); LAS float* s_part = (LAS float*)(lds + RT_PART); LAS float* s_lg = (LAS float*)(lds + RT_LG);
    LAS int* s_hist = (LAS int*)(lds + RT_HIST); LAS int* s_base = (LAS int*)(lds + RT_BASE); LAS int* s_sele = (LAS int*)(lds + RT_SELE); LAS int* s_selr = (LAS int*)(lds + RT_SELR); LAS float* s_selg = (LAS float*)(lds + RT_SELG);
    for (int it = F.vcu; it < NTOK / 32; it += F.G) {
        const int tok0 = it * 32;
        if (tid < 32) s_hist[tid] = 0;
#pragma unroll
        for (int q = 0; q < 4; ++q) {
            const u32x4* xr = (const u32x4*)(X1 + (size_t)(tok0 + 4 * w + q) * D_MODEL) + lane; float s = 0.f;
#pragma unroll
            for (int j = 0; j < 4; ++j) { const u32x4 v = xr[64 * j];
#pragma unroll
                for (int i = 0; i < 4; ++i) { const float lo = __uint_as_float(v[i] << 16), hi = __uint_as_float(v[i] & 0xffff0000u); s += lo * lo + hi * hi; } }
            s = wave_sum(s);
            if (lane == 0) s_rstd[4 * w + q] = rsqrtf(s * (1.0f / D_MODEL) + EPS);
        }
        __syncthreads();
        {
            const int tr = lane & 15, kq = lane >> 4;
            const float r0 = s_rstd[tr], r1 = s_rstd[16 + tr];
            f32x4 acc[2][2];
#pragma unroll
            for (int tt = 0; tt < 2; ++tt)
#pragma unroll
                for (int eh = 0; eh < 2; ++eh) acc[tt][eh] = (f32x4){0.f, 0.f, 0.f, 0.f};
            unsigned ha[4], hb[4];
#pragma unroll 4
            for (int ls = 0; ls < 16; ++ls) {
                const int k = 256 * w + 64 * (ls >> 2) + 16 * kq + 4 * (ls & 3);
                const f32x4 g = *(const f32x4*)(gain + k);
                f32x4 xa, xb;
                { const u32x2 ra = *(const u32x2*)(X1 + (size_t)(tok0 + tr) * D_MODEL + k), rb = *(const u32x2*)(X1 + (size_t)(tok0 + 16 + tr) * D_MODEL + k);
                  xa = (f32x4){__uint_as_float(ra.x << 16), __uint_as_float(ra.x & 0xffff0000u), __uint_as_float(ra.y << 16), __uint_as_float(ra.y & 0xffff0000u)};
                  xb = (f32x4){__uint_as_float(rb.x << 16), __uint_as_float(rb.x & 0xffff0000u), __uint_as_float(rb.y << 16), __uint_as_float(rb.y & 0xffff0000u)}; }
                const f32x4 b0 = *(const f32x4*)(wrT + (size_t)(lane & 15) * D_MODEL + k), b1 = *(const f32x4*)(wrT + (size_t)(16 + (lane & 15)) * D_MODEL + k);
                xa = xa * r0 * g; xb = xb * r1 * g;
                ha[ls & 3] = cvt_pk4_fp8(xa.x, xa.y, xa.z, xa.w); hb[ls & 3] = cvt_pk4_fp8(xb.x, xb.y, xb.z, xb.w);
                if ((ls & 3) == 3) { const int ks = k - 12;
                    *(u32x4*)(H2 + (size_t)(tok0 + tr) * D_MODEL + ks) = (u32x4){ha[0], ha[1], ha[2], ha[3]}; *(u32x4*)(H2 + (size_t)(tok0 + 16 + tr) * D_MODEL + ks) = (u32x4){hb[0], hb[1], hb[2], hb[3]}; }
#pragma unroll
                for (int j = 0; j < 4; ++j) {
                    acc[0][0] = __builtin_amdgcn_mfma_f32_16x16x4f32(xa[j], b0[j], acc[0][0], 0, 0, 0); acc[0][1] = __builtin_amdgcn_mfma_f32_16x16x4f32(xa[j], b1[j], acc[0][1], 0, 0, 0);
                    acc[1][0] = __builtin_amdgcn_mfma_f32_16x16x4f32(xb[j], b0[j], acc[1][0], 0, 0, 0); acc[1][1] = __builtin_amdgcn_mfma_f32_16x16x4f32(xb[j], b1[j], acc[1][1], 0, 0, 0);
                }
            }
#pragma unroll
            for (int tt = 0; tt < 2; ++tt)
#pragma unroll
                for (int eh = 0; eh < 2; ++eh)
#pragma unroll
                    for (int rg = 0; rg < 4; ++rg) s_part[(w * 32 + 16 * tt + 4 * kq + rg) * 32 + 16 * eh + (lane & 15)] = acc[tt][eh][rg];
        }
        __syncthreads();
        { const int t = tid >> 4, e2 = (tid & 15) * 2;
#pragma unroll
          for (int q = 0; q < 2; ++q) { float v = br[e2 + q];
#pragma unroll
              for (int ww = 0; ww < 8; ++ww) v += s_part[(ww * 32 + t) * 32 + e2 + q];
              s_lg[t * 32 + e2 + q] = v; } }
        __syncthreads();
        if (tid < 32) {
            unsigned used = 0u; float val[4]; int idx[4];
#pragma unroll
            for (int k = 0; k < 4; ++k) { int bi = 0; float bv = -INFINITY;
                for (int i = 0; i < 32; ++i) { const float v = s_lg[tid * 32 + i]; if (!((used >> i) & 1u) && v > bv) { bv = v; bi = i; } }
                used |= 1u << bi; idx[k] = bi; val[k] = bv; }
            float ex[4], sm = 0.f;
#pragma unroll
            for (int k = 0; k < 4; ++k) { ex[k] = expf(val[k] - val[0]); sm += ex[k]; }
#pragma unroll
            for (int k = 0; k < 4; ++k) { s_sele[tid * 4 + k] = idx[k]; s_selr[tid * 4 + k] = atomicAdd((int*)&s_hist[idx[k]], 1); s_selg[tid * 4 + k] = ex[k] / sm; }
        }
        __syncthreads();
        if (tid < 32) { const int hcount = s_hist[tid]; s_base[tid] = hcount ? atomicAdd(&cnt[tid], hcount) : 0; }
        __syncthreads();
        if (tid < 128) { const int e = s_sele[tid], rk = s_base[e] + s_selr[tid], aid = tok0 * 4 + tid;
            list[e * NTOK + rk] = aid; a_exp[aid] = e; a_rank[aid] = rk; a_gate[aid] = s_selg[tid]; }
        __syncthreads();
    }
}
constexpr int MOE_TAB_OFF = RING_BYTES + 1024;
__device__ __forceinline__ void moe_table(const Frame& F) {
    LAS int* tab = (LAS int*)(F.lds + MOE_TAB_OFF);
    if (fresh_tid(F.wave) == 0) {
        const int* cnt = (const int*)(F.ws + WS_CTL) + CW_CNT; int rows = 0, blocks = 0;
        for (int e = 0; e < NEXP; ++e) { const int c = __hip_atomic_load(cnt + e, __ATOMIC_RELAXED, __HIP_MEMORY_SCOPE_AGENT), nb = (c + 255) >> 8; tab[e] = c; tab[32 + e] = nb; tab[64 + e] = rows; tab[96 + e] = blocks; rows += nb * 256; blocks += nb; }
        tab[96 + 32] = blocks;
    }
    __syncthreads();
}
__device__ __forceinline__ void p8_final(const Frame& F, const Args& a) {
    unsigned char* ws = F.ws; const LAS int* tab = (const LAS int*)(F.lds + MOE_TAB_OFF);
    const int tid_ = fresh_tid(F.wave), lane = tid_ & 63, wave_ = F.wave;
    const int gw = F.vcu * NWAVES + wave_, NGW = F.G * NWAVES;
    const bf16_t* X1 = (const bf16_t*)(ws + WS_X1); const unsigned char* Y = ws + WS_Y; const float* fg = a.in[15];
    const int* a_exp = (const int*)(ws + WS_AEXP); const int* a_rank = (const int*)(ws + WS_ARANK); const float* a_gate = (const float*)(ws + WS_AGATE);
    for (int tok = gw; tok < NTOK; tok += NGW) {
        const unsigned char* yr[4]; float gt[4];
#pragma unroll
        for (int k = 0; k < 4; ++k) { const int aid = tok * 4 + k; yr[k] = Y + (size_t)(tab[64 + a_exp[aid]] + a_rank[aid]) * D_MODEL; gt[k] = a_gate[aid]; }
        f32x4 v[8]; float s = 0.f;
#pragma unroll
        for (int j = 0; j < 8; ++j) {
            const int c = (lane + 64 * j) * 4; f32x4 y; { const u32x2 rx = *(const u32x2*)(X1 + (size_t)tok * D_MODEL + c); y = (f32x4){__uint_as_float(rx.x << 16), __uint_as_float(rx.x & 0xffff0000u), __uint_as_float(rx.y << 16), __uint_as_float(rx.y & 0xffff0000u)}; }
#pragma unroll
            for (int k = 0; k < 4; ++k) { const unsigned yy = *(const unsigned*)(yr[k] + c);
                const auto lo2 = __builtin_amdgcn_cvt_pk_f32_fp8((int)yy, false), hi2 = __builtin_amdgcn_cvt_pk_f32_fp8((int)yy, true);
                y.x += gt[k] * lo2[0]; y.y += gt[k] * lo2[1]; y.z += gt[k] * hi2[0]; y.w += gt[k] * hi2[1]; }
            v[j] = y; s += (y.x * y.x + y.y * y.y) + (y.z * y.z + y.w * y.w);
        }
        const float rstd = rsqrtf(wave_sum(s) * (1.0f / D_MODEL) + EPS);
#pragma unroll
        for (int j = 0; j < 8; ++j) { const int c = (lane + 64 * j) * 4; const f32x4 g = *(const f32x4*)(fg + c); *(f32x4*)(a.out + (size_t)tok * D_MODEL + c) = v[j] * rstd * g; }
    }
}

__global__ void __launch_bounds__(NWAVES * 64, 2) mk_fwd(Args args) {
    extern __shared__ __attribute__((aligned(16))) unsigned char lds_raw[];
    Frame F;
    F.lds = (LAS unsigned char*)lds_raw; F.wave = __builtin_amdgcn_readfirstlane((int)threadIdx.x >> 6);
    F.G = gridDim.x; { const int bx = blockIdx.x; F.vcu = (F.G % 8 == 0) ? (bx % 8) * (F.G / 8) + bx / 8 : bx; }
    F.ws = args.ws;
    volatile LAS unsigned* MISC = (volatile LAS unsigned*)(F.lds + MISC_OFF);
    for (int u = fresh_tid(F.wave); u < (LDS_BYTES - RING_BYTES) / 4; u += NWAVES * 64) ((LAS unsigned*)(F.lds + RING_BYTES))[u] = 0u;
    __syncthreads();
    const int lo = args.ph_lo, hi = args.ph_hi;
    const bool multi = (hi - lo) > 1;
    XcdBarrier bar; bar.bar = (unsigned*)(F.ws + WS_CTL) + CW_BAR; bar.x = 0; bar.st = nullptr;
    if (multi) bar = xcd_barrier_post((unsigned*)(F.ws + WS_CTL) + CW_BAR, MISC + 8, fresh_tid(F.wave));
#define IN(k) (lo <= (k) && (k) < hi)
#define SEAM(k) do { if (IN(k) && IN((k) + 1)) xcd_barrier(bar, fresh_tid(F.wave)); } while (0)

    const int jx = (int)blockIdx.x >> 3, ncompj = (F.G >> 3) - NCONV / 8;
    const bool conv_role = multi && (F.G % 8 == 0) && (F.G >= 2 * NCONV) && jx >= ncompj;
    const int GC = conv_role || (multi && (F.G % 8 == 0) && (F.G >= 2 * NCONV)) ? ncompj * 8 : F.G;
    const int crank = (GC == F.G) ? (int)blockIdx.x : (jx * 8 + ((int)blockIdx.x & 7));
    unsigned* done1 = (unsigned*)(F.ws + WS_CTL) + CW_DONE1; unsigned* done2 = (unsigned*)(F.ws + WS_CTL) + CW_DONE2;
    if (IN(0)) { p0_prologue(F, args); SEAM(0); }
    if (IN(1)) {
        if (conv_role) conv_items(F, args, done1, (unsigned)GC);
        else {
            pg8::StaticOrder S; S.init(NTOK, INW, D_MODEL * 2, F.ws + WS_WIN, GC, crank);
            pg8::EpiQKV E{(bf16_t*)(F.ws + WS_QKV), (const float*)(F.ws + WS_ROPEC), (const float*)(F.ws + WS_ROPES)};
            pg8::gemm_phase<pg8::EpiQKV, pg8::StaticOrder>(F.lds, F.wave, F.ws + WS_XN, D_MODEL * 2, S, E);
            if (fresh_tid(F.wave) == 0) __hip_atomic_fetch_add(done1, 1u, __ATOMIC_RELAXED, __HIP_MEMORY_SCOPE_AGENT);
        }
        SEAM(1);
    }
    if (IN(2)) {
#pragma unroll 1
        for (int pass = 0; pass < 2; ++pass) {
            if ((pass == 0) == conv_role) conv_items(F, args, nullptr, 0u);
            else p2_attention(F);
        }
        SEAM(2);
    }
    if (IN(3)) { p3_combine(F, args); SEAM(3); }
    if (IN(4)) {
        pg8::StaticOrder S; S.init(NTOK, D_MODEL, D_MODEL * 2, F.ws + WS_WOUT, F.G, (int)blockIdx.x);
        pg8::EpiOut E{args.in[0], (bf16_t*)(F.ws + WS_X1)};
        pg8::gemm_phase<pg8::EpiOut, pg8::StaticOrder>(F.lds, F.wave, F.ws + WS_ACAT, D_MODEL * 2, S, E);
        SEAM(4);
    }
    if (IN(5)) { p5_router(F, args); conv_items(F, args, nullptr, 0u); SEAM(5); }
    if (IN(6)) {
        moe_table(F);
        pg8::GroupedOrder S; S.init((const LAS int*)(F.lds + MOE_TAB_OFF), 16, F.ws + WS_WGU, (size_t)4096 * D_MODEL, D_MODEL, (const int*)(F.ws + WS_LIST), true, F.G, (int)blockIdx.x, (const LAS int*)(F.lds + ROWTAB_OFF));
        S.fill_rowtab((LAS int*)(F.lds + ROWTAB_OFF), fresh_tid(F.wave)); __syncthreads();
        pg8::EpiGateUp E{F.ws + WS_H1, args.in[10], args.in[12]};
        pg8::gemm_phase<pg8::EpiGateUp, pg8::GroupedOrder, true, true>(F.lds, F.wave, F.ws + WS_H2, D_MODEL, S, E);
        SEAM(6);
    }
    if (IN(7)) {
        if (!IN(6)) moe_table(F);
        pg8::GroupedOrder S; S.init((const LAS int*)(F.lds + MOE_TAB_OFF), 8, F.ws + WS_WD, (size_t)D_MODEL * D_MODEL, D_MODEL, nullptr, false, F.G, (int)blockIdx.x, nullptr);
        pg8::EpiDown E{F.ws + WS_Y, args.in[14]};
        pg8::gemm_phase<pg8::EpiDown, pg8::GroupedOrder, true, true>(F.lds, F.wave, F.ws + WS_H1, D_MODEL, S, E);
        SEAM(7);
    }
    if (IN(8)) { if (!IN(6) && !IN(7)) moe_table(F); p8_final(F, args); }

#undef IN
#undef SEAM
}


extern "C" void kernel_launch(void* const* d_in, const int* in_sizes, int n_in, void* d_out, int out_size, void* d_ws, size_t ws_size, hipStream_t stream) {
    static int grid = 0;
    if (grid == 0) {
        int dev = 0, cus = 0;
        if (hipGetDevice(&dev) != hipSuccess || hipDeviceGetAttribute(&cus, hipDeviceAttributeMultiprocessorCount, dev) != hipSuccess) { grid = -1; return; }
        if (hipFuncSetAttribute((const void*)mk_fwd, hipFuncAttributeMaxDynamicSharedMemorySize, LDS_BYTES) != hipSuccess) { fprintf(stderr, "hipFuncSetAttribute failed\n"); grid = -1; return; }
        int per_cu = 0;
        if (hipOccupancyMaxActiveBlocksPerMultiprocessor(&per_cu, (const void*)mk_fwd, NWAVES * 64, LDS_BYTES) != hipSuccess || per_cu < 1) fprintf(stderr, "occupancy query says %d\n", per_cu);
        (void)hipGetLastError();
        grid = cus;
    }
    if (grid < 0) return;
    const float* x = (const float*)d_in[0];
    const float* dil_norm = (const float*)d_in[3]; const float* sb_norm = (const float*)d_in[4]; const float* w_out = (const float*)d_in[5];
    const float* ffn_norm = (const float*)d_in[6]; const float* w_router = (const float*)d_in[7]; const float* b_router = (const float*)d_in[8];
    const float* w_gate = (const float*)d_in[9]; const float* b_gate = (const float*)d_in[10]; const float* w_up = (const float*)d_in[11]; const float* b_up = (const float*)d_in[12];
    const float* w_down = (const float*)d_in[13]; const float* b_down = (const float*)d_in[14]; const float* final_norm = (const float*)d_in[15];
    float* out = (float*)d_out;
    unsigned char* ws = (unsigned char*)d_ws;
    (void)hipMemsetAsync(ws + WS_CTL, 0, CTL_ZERO_BYTES, stream);
    Args a{};
    for (int i = 0; i < 16; ++i) a.in[i] = (const float*)d_in[i];
    a.out = out; a.ws = ws;
    a.ph_lo = 0; a.ph_hi = NPHASE;
    hipLaunchKernelGGL(mk_fwd, dim3(grid), dim3(NWAVES * 64), LDS_BYTES, stream, a);
}
```

```cpp
#include <hip/hip_runtime.h>
#include <cstdio>
#include <cstdint>

constexpr int D_MODEL = 2048, BATCH = 4, SEQ = 2048, NTOK = BATCH * SEQ;
constexpr int HD = 64, NH = 16, GW = 1024, INW = 6144;
constexpr int NEXP = 32, TOPK = 4, NASSIGN = NTOK * TOPK;
constexpr float EPS = 1e-5f;
constexpr float C2 = 0.125f * 1.4426950408889634f;
constexpr float LN2 = 0.6931471805599453f;

#define GAS __attribute__((address_space(1)))
#define LAS __attribute__((address_space(3)))
typedef unsigned short bf16_t;
typedef short bf16x8 __attribute__((ext_vector_type(8)));
typedef float f32x4 __attribute__((ext_vector_type(4)));
typedef unsigned u32x4 __attribute__((ext_vector_type(4)));
typedef unsigned u32x2 __attribute__((ext_vector_type(2)));
typedef GAS unsigned gu32;

constexpr size_t MiB = 1u << 20;
constexpr size_t WS_CTL = 0, CTL_ZERO_BYTES = 1 * MiB;
constexpr size_t WS_LIST = 1 * MiB;
constexpr size_t WS_AEXP = 2 * MiB, WS_ARANK = 2 * MiB + 256 * 1024, WS_AGATE = 2 * MiB + 512 * 1024;
constexpr size_t WS_ROPEC = 3 * MiB, WS_ROPES = 3 * MiB + 256 * 1024, WS_WRT = 3 * MiB + 512 * 1024;
constexpr size_t WS_LSE = 4 * MiB;
constexpr size_t WS_XN = 8 * MiB;
constexpr size_t WS_QKV = 40 * MiB;
constexpr size_t QKV_STRIDE = (size_t)NTOK * GW;
constexpr size_t WS_OP = 136 * MiB;
constexpr size_t WS_OSB = 184 * MiB;
constexpr size_t WS_ACAT = 200 * MiB;
constexpr size_t WS_X1 = 232 * MiB;
constexpr size_t WS_H2 = 296 * MiB;
constexpr size_t WS_H1 = 328 * MiB;
constexpr size_t WS_Y = 488 * MiB;
constexpr size_t WS_WIN = 648 * MiB;
constexpr size_t WS_WOUT = 672 * MiB;
constexpr size_t WS_WGU = 680 * MiB;
constexpr size_t WS_WD = 1192 * MiB;
constexpr size_t WS_END = 1448 * MiB;
constexpr int CW_TMO = 0, CW_CNT = 64  , CW_BAR = 4096;
constexpr int CW_CONVQ = 256  , CW_ATTQ = 320  , CW_DONE1 = 384, CW_DONE2 = 448  ;

__device__ __forceinline__ int lane_id() { int l; asm volatile("v_mbcnt_lo_u32_b32 %0, -1, 0\n\tv_mbcnt_hi_u32_b32 %0, -1, %0" : "=v"(l)); return l; }
__device__ __forceinline__ int fresh_tid(int wave) { int t = wave * 64 + lane_id(); asm volatile("" : "+v"(t)); return t; }
__device__ __forceinline__ float wave_sum(float v) {
#pragma unroll
    for (int o = 1; o < 64; o <<= 1) v += __shfl_xor(v, o);
    return v;
}
__device__ __forceinline__ unsigned cvt_pk_bf16(float lo, float hi) { unsigned r; asm volatile("v_cvt_pk_bf16_f32 %0, %1, %2" : "=v"(r) : "v"(lo), "v"(hi)); return r; }
__device__ __forceinline__ unsigned cvt_pk4_fp8(float a, float b, float c, float d) { int w = 0; w = __builtin_amdgcn_cvt_pk_fp8_f32(a, b, w, false); w = __builtin_amdgcn_cvt_pk_fp8_f32(c, d, w, true); return (unsigned)w; }
constexpr float W8_SCALE = 64.0f, W8_INV = 1.0f / 64.0f;
__device__ __forceinline__ float bf2f(bf16_t b) { return __uint_as_float((unsigned)b << 16); }
__device__ __forceinline__ float block_sum_256(float v, float* sh) {
    v = wave_sum(v);
    const int w = threadIdx.x >> 6;
    __syncthreads();
    if ((threadIdx.x & 63) == 0) sh[w] = v;
    __syncthreads();
    return sh[0] + sh[1] + sh[2] + sh[3];
}
__device__ __forceinline__ float log_sigmoid(float z) { return fminf(z, 0.f) - log1pf(expf(-fabsf(z))); }

#define XB_TMO      128
#define XB_XCNT(j)  (256  + 64 * (j))
#define XB_XSUB(j)  (1280 + 64 * (j))
#define XB_XGEN(j)  (2304 + 64 * (j))
#define XB_TOP      3328
#define XB_TOPGEN   3392
#define XCD_BAR_WORDS 3456
#define XB_SPIN_CAP (1u << 18)
__device__ __forceinline__ unsigned xb_ld(unsigned* p)              { return __hip_atomic_load(p, __ATOMIC_RELAXED, __HIP_MEMORY_SCOPE_AGENT); }
__device__ __forceinline__ unsigned xb_add(unsigned* p, unsigned v) { return __hip_atomic_fetch_add(p, v, __ATOMIC_RELAXED, __HIP_MEMORY_SCOPE_AGENT); }
__device__ __forceinline__ unsigned xb_xcc_id() { return (unsigned)__builtin_amdgcn_s_getreg((3 << 11) | 20) & 0xFu; }
#define XB_SPIN(cond, bar) do { unsigned _sp = 0; while (cond) { __builtin_amdgcn_s_sleep(1); \
    if ((++_sp & 255u) == 0u) { if (xb_ld(&(bar)[XB_TMO])) break; if (_sp > XB_SPIN_CAP) { atomicAdd(&(bar)[XB_TMO], 1u); break; } } } } while (0)
struct XcdBarrier { unsigned* bar; unsigned x; volatile LAS unsigned* st; };
__device__ __forceinline__ XcdBarrier xcd_barrier_post(unsigned* bar, volatile LAS unsigned* st, int tid) {
    XcdBarrier b; b.bar = bar; b.x = xb_xcc_id(); b.st = st;
    if (tid == 0) (void)xb_add(&bar[XB_XCNT(b.x)], 1u);
    return b;
}
__device__ __forceinline__ void xcd_barrier_complete(unsigned* bar, unsigned x, unsigned& nloc, unsigned& nx) {
    const unsigned G = gridDim.x * gridDim.y * gridDim.z;
    unsigned sum, cnt, mine, sp = 0u;
    for (;;) {
        sum = 0u; cnt = 0u; mine = 0u;
#pragma unroll
        for (unsigned j = 0; j < 16; ++j) { const unsigned c = xb_ld(&bar[XB_XCNT(j)]); sum += c; cnt += (c > 0u) ? 1u : 0u; mine = (j == x) ? c : mine; }
        if (sum == G) break;
        __builtin_amdgcn_s_sleep(1);
        if ((++sp & 255u) == 0u) { if (xb_ld(&bar[XB_TMO])) break; if (sp > XB_SPIN_CAP) { atomicAdd(&bar[XB_TMO], 1u); break; } }
    }
    nloc = mine > 0u ? mine : 1u; nx = cnt > 0u ? cnt : 1u;
}
__device__ __forceinline__ void xcd_barrier(const XcdBarrier& b, int tid) {
    asm volatile("s_waitcnt vmcnt(0)" ::: "memory");
    __syncthreads();
    if (tid == 0) {
        unsigned* bar = b.bar;
        __builtin_amdgcn_s_waitcnt(0);
        unsigned nloc = b.st[0], nx = b.st[1];
        if (nloc == 0u) { xcd_barrier_complete(bar, b.x, nloc, nx); b.st[0] = nloc; b.st[1] = nx; }
        const unsigned old = xb_add(&bar[XB_XSUB(b.x)], 1u);
        const unsigned gen = old / nloc;
        if (old + 1u == (gen + 1u) * nloc) {
            __builtin_amdgcn_fence(__ATOMIC_RELEASE, "agent");
            asm volatile("s_waitcnt vmcnt(0)" ::: "memory");
            const unsigned og = xb_add(&bar[XB_TOP], 1u);
            const unsigned tg = og / nx;
            if (og + 1u == (tg + 1u) * nx) xb_add(&bar[XB_TOPGEN], 1u);
            else XB_SPIN(xb_ld(&bar[XB_TOPGEN]) == tg, bar);
            __builtin_amdgcn_fence(__ATOMIC_ACQUIRE, "agent");
            xb_add(&bar[XB_XGEN(b.x)], 1u);
            asm volatile("s_waitcnt vmcnt(0)" ::: "memory");
        } else {
            XB_SPIN(xb_ld(&bar[XB_XGEN(b.x)]) == gen, bar);
            __builtin_amdgcn_fence(__ATOMIC_ACQUIRE, "agent");
            asm volatile("s_waitcnt vmcnt(0)" ::: "memory");
        }
    }
    __syncthreads();
}

__device__ __forceinline__ const char* uniform_ptr(const char* p) {
    const unsigned long long v = (unsigned long long)p;
    const unsigned lo = (unsigned)__builtin_amdgcn_readfirstlane((int)(unsigned)v), hi = (unsigned)__builtin_amdgcn_readfirstlane((int)(unsigned)(v >> 32));
    return (const char*)(((unsigned long long)hi << 32) | lo);
}
namespace pg8 {
constexpr int ROWTAB_UNITS = 10;
constexpr int BM = 256, BK = 64, HALF = 128, HTB = HALF * BK * 2, STAGE_BYTES = 8 * HTB, NXCD = 8, WGM = 8, RING_BYTES_C = 131072;
__host__ __device__ __forceinline__ int lds_byte(int r, int c) { const int st = (r >> 4) * 2 + (c >> 5), rr = r & 15, cc = c & 31, ob = rr * 64 + cc * 2; return st * 1024 + (ob ^ (((ob >> 9) & 1) << 5)); }
__host__ __device__ __forceinline__ void stage_rc(int b, int& R, int& C) { const int st = b / 1024, sb = b % 1024, swz = sb ^ (((sb >> 9) & 1) << 5); R = (st >> 1) * 16 + swz / 64; C = (st & 1) * 32 + (swz % 64) / 2; }
__host__ __device__ __forceinline__ int perm32(int rho) { const int n = rho >> 4, i = rho & 15; return 8 * (i >> 2) + 4 * n + (i & 3); }

struct Unit { int arow0; int nvalid; const char* bptr; int orow0; int pn; int e; int ui; };

struct StaticOrder {
    int nM, nN, nwg, G, c, wgm; const char* Bt; int RB;
    __device__ void init(int M, int N, int RB_, const void* Bt_, int G_, int c_, int wgm_ = WGM) { nM = M / BM; nN = N / BM; nwg = nM * nN; G = G_; c = c_; Bt = (const char*)Bt_; RB = RB_; wgm = wgm_; }
    __device__ bool next(int i, Unit& u) const {
        const int L = i * G + c; if (L >= nwg) return false;
        int wgid = L; { const int q = nwg / NXCD, r = nwg % NXCD, xcd = wgid % NXCD, off = wgid / NXCD; wgid = (xcd < r ? xcd * (q + 1) : r * (q + 1) + (xcd - r) * q) + off; }
        const int nig = wgm * nN, gid = wgid / nig, fm = gid * wgm, gsz = (nM - fm) < wgm ? (nM - fm) : wgm;
        const int pm = fm + ((wgid % nig) % gsz), pn = (wgid % nig) / gsz;
        u.arow0 = pm * BM; u.nvalid = BM; u.bptr = Bt + (size_t)pn * BM * RB; u.orow0 = pm * BM; u.pn = pn; u.e = 0; u.ui = i; return true;
    }
    __device__ __forceinline__ unsigned a_off(const Unit& u, int r) const { return (unsigned)(u.arow0 + r) * (unsigned)RB; }
};

typedef int v8i_t __attribute__((ext_vector_type(8)));
typedef int v4i_t __attribute__((ext_vector_type(4)));
template <class Epi, class Sched, bool ALIGN_EPI = true, bool FP8 = false>
__device__ __forceinline__ void gemm_phase(LAS unsigned char* lds, int wave, const void* Aptr, int RB, const Sched& S, const Epi& E) {
    const int tid = fresh_tid(wave), wid = wave, lane = tid & 63, wr = wid >> 2, wc = wid & 3, fr = lane & 15, fq = lane >> 4;
    const int nt = RB / 128;
    const char* gA = (const char*)Aptr;
    unsigned voffB[2];
#pragma unroll
    for (int i = 0; i < 2; ++i) { int R, C; stage_rc(tid * 16 + i * 8192, R, C); const int Rb = Epi::PERM ? ((R & ~31) + perm32(R & 31)) : R; voffB[i] = (unsigned)(Rb * RB + C * 2); }
    const size_t kstep = (size_t)(BK * 2);
    const size_t hstep = (size_t)HALF * RB;
    const unsigned ldsw = (unsigned)wid * 1024u;
    const int aoff = lds_byte(wr * 64 + fr, fq * 8), boff = lds_byte(wc * 32 + fr, fq * 8);
#define PG8_SA(b, h) (((b) * 2 + (h)) * HTB)
#define PG8_SB(b, h) ((4 + (b) * 2 + (h)) * HTB)
#define PG8_STAGEB(bufoff, gbase, vo) do { const char* _b = (const char*)(gbase); asm volatile("" : "+s"(_b));   _Pragma("unroll") for (int _i = 0; _i < 2; ++_i) \
        __builtin_amdgcn_global_load_lds((const unsigned*)(_b + (vo)[_i]), (LAS unsigned*)(lds + (bufoff) + ldsw + _i * 8192), 16, 0, 0); } while (0)
#define PG8_STAGEA(bufoff, kb, offs) do { const char* _b = gA + (size_t)(kb); asm volatile("" : "+s"(_b)); _Pragma("unroll") for (int _i = 0; _i < 2; ++_i) \
        __builtin_amdgcn_global_load_lds((const unsigned*)(_b + (offs)[_i]), (LAS unsigned*)(lds + (bufoff) + ldsw + _i * 8192), 16, 0, 0); } while (0)
#define PG8_LD8(p) __builtin_shufflevector(*(const LAS v4i_t*)(p), *(const LAS v4i_t*)((p) + 1024), 0, 1, 2, 3, 4, 5, 6, 7)
#define PG8_LDA(dst, b, h) do { _Pragma("unroll") for (int m = 0; m < 4; ++m) dst[m] = PG8_LD8(lds + PG8_SA(b, h) + aoff + m * 2048); } while (0)
#define PG8_LDB(dst, b, h) do { _Pragma("unroll") for (int n = 0; n < 2; ++n) dst[n] = PG8_LD8(lds + PG8_SB(b, h) + boff + n * 2048); } while (0)
#define PG8_LO(v) __builtin_bit_cast(bf16x8, __builtin_shufflevector(v, v, 0, 1, 2, 3))
#define PG8_HI(v) __builtin_bit_cast(bf16x8, __builtin_shufflevector(v, v, 4, 5, 6, 7))
#define PG8_MMA(ai, bj, At, Bt) do { __builtin_amdgcn_s_setprio(1); _Pragma("unroll") for (int m = 0; m < 4; ++m) _Pragma("unroll") for (int n = 0; n < 2; ++n) { \
        if constexpr (FP8) acc[ai][bj][m][n] = __builtin_amdgcn_mfma_scale_f32_16x16x128_f8f6f4(Bt[n], At[m], acc[ai][bj][m][n], 0, 0, 0, 0x7f7f7f7f, 0, 0x7f7f7f7f); \
        else { acc[ai][bj][m][n] = __builtin_amdgcn_mfma_f32_16x16x32_bf16(PG8_LO(Bt[n]), PG8_LO(At[m]), acc[ai][bj][m][n], 0, 0, 0); \
               acc[ai][bj][m][n] = __builtin_amdgcn_mfma_f32_16x16x32_bf16(PG8_HI(Bt[n]), PG8_HI(At[m]), acc[ai][bj][m][n], 0, 0, 0); } } \
        __builtin_amdgcn_s_setprio(0); } while (0)
#define PG8_WAIT_V(n) asm volatile("s_waitcnt vmcnt(" #n ")" ::: "memory")
#define PG8_WAIT_L(n) asm volatile("s_waitcnt lgkmcnt(" #n ")" ::: "memory")
#define PG8_BAR __builtin_amdgcn_s_barrier()
#define PG8_SCHED __builtin_amdgcn_sched_barrier(0)
#define PG8_AOFFS(dst, U) do { const int _t = fresh_tid(wave); _Pragma("unroll") for (int _i = 0; _i < 2; ++_i) { int _R, _C; stage_rc(_t * 16 + _i * 8192, _R, _C); _Pragma("unroll") for (int _h = 0; _h < 2; ++_h) dst[_h][_i] = S.a_off(U, _h * HALF + _R) + (unsigned)(_C * 2); } } while (0)
    Unit cur, nxt; int ui = 0;
    if (!S.next(0, cur)) return;
    f32x4 acc[2][2][4][2];
#pragma unroll
    for (int a = 0; a < 2; ++a)
#pragma unroll
        for (int b = 0; b < 2; ++b)
#pragma unroll
            for (int m = 0; m < 4; ++m)
#pragma unroll
                for (int n = 0; n < 2; ++n) acc[a][b][m][n] = (f32x4){0.f, 0.f, 0.f, 0.f};
    v8i_t At[4], B0[2], B1[2];
    unsigned ua[2][2];
    LAS u32x4* nslot = (LAS u32x4*)(lds + RING_BYTES_C + 4096) + tid;
    PG8_AOFFS(ua, cur);
    const char* cB = uniform_ptr(cur.bptr);
    PG8_STAGEB(PG8_SB(0, 0), cB, voffB); PG8_STAGEB(PG8_SB(0, 1), cB + hstep, voffB); PG8_STAGEA(PG8_SA(0, 0), 0, ua[0]); PG8_STAGEA(PG8_SA(0, 1), 0, ua[1]);
    if (wr == 1) PG8_BAR;
    PG8_WAIT_V(2); PG8_BAR;
    PG8_STAGEB(PG8_SB(1, 0), cB + kstep, voffB); PG8_STAGEA(PG8_SA(1, 0), kstep, ua[0]); PG8_STAGEB(PG8_SB(1, 1), cB + hstep + kstep, voffB);
    PG8_WAIT_V(6); PG8_BAR;
    for (;;) {
        const bool has_next = S.next(ui + 1, nxt);
        {
            unsigned nua[2][2];
            if (has_next) { PG8_AOFFS(nua, nxt); } else {
#pragma unroll
                for (int h = 0; h < 2; ++h)
#pragma unroll
                    for (int i = 0; i < 2; ++i) nua[h][i] = ua[h][i]; }
            *nslot = (u32x4){nua[0][0], nua[0][1], nua[1][0], nua[1][1]};
        }
        const char* nB = uniform_ptr(has_next ? nxt.bptr : cB);
        for (int t = 0; t < nt; t += 2) {
            const bool last = (t == nt - 2);
            const size_t k1 = (size_t)(t + 1) * kstep;
            const size_t k2 = last ? 0 : (size_t)(t + 2) * kstep, k3 = k2 + kstep;
            const char* b2 = last ? nB : cB + (size_t)(t + 2) * kstep; const char* b3 = b2 + kstep;
            asm volatile("" : "+v"(ua[0][0]), "+v"(ua[0][1]), "+v"(ua[1][0]), "+v"(ua[1][1]), "+v"(voffB[0]), "+v"(voffB[1]));
            unsigned a2o[2][2];
#pragma unroll
            for (int h = 0; h < 2; ++h)
#pragma unroll
                for (int i = 0; i < 2; ++i) a2o[h][i] = ua[h][i];
            if (last) { asm volatile("" ::: "memory"); const u32x4 nv = *nslot; a2o[0][0] = nv.x; a2o[0][1] = nv.y; a2o[1][0] = nv.z; a2o[1][1] = nv.w; }
            PG8_LDB(B0, 0, 0); PG8_LDB(B1, 0, 1); PG8_SCHED; PG8_LDA(At, 0, 0); PG8_STAGEA(PG8_SA(1, 1), k1, ua[1]);
            PG8_WAIT_V(8); PG8_WAIT_L(0); PG8_BAR; PG8_MMA(0, 0, At, B0); PG8_MMA(0, 1, At, B1); PG8_BAR; PG8_SCHED;
            PG8_LDA(At, 0, 1); PG8_STAGEB(PG8_SB(0, 0), b2, voffB); PG8_STAGEB(PG8_SB(0, 1), b2 + hstep, voffB); PG8_STAGEA(PG8_SA(0, 0), k2, a2o[0]);
            PG8_WAIT_V(8); PG8_WAIT_L(0); PG8_BAR; PG8_MMA(1, 0, At, B0); PG8_MMA(1, 1, At, B1); PG8_BAR; PG8_SCHED;
            PG8_LDB(B0, 1, 0); PG8_LDB(B1, 1, 1); PG8_SCHED; PG8_LDA(At, 1, 0); PG8_STAGEA(PG8_SA(0, 1), k2, a2o[1]);
            PG8_WAIT_V(8); PG8_WAIT_L(0); PG8_BAR; PG8_MMA(0, 0, At, B0); PG8_MMA(0, 1, At, B1); PG8_BAR; PG8_SCHED;
            PG8_LDA(At, 1, 1); PG8_STAGEB(PG8_SB(1, 0), b3, voffB); PG8_STAGEB(PG8_SB(1, 1), b3 + hstep, voffB); PG8_STAGEA(PG8_SA(1, 0), k3, a2o[0]);
            PG8_WAIT_V(8); PG8_WAIT_L(0); PG8_BAR; PG8_MMA(1, 0, At, B0); PG8_MMA(1, 1, At, B1); PG8_BAR; PG8_SCHED;
        }
        if constexpr (ALIGN_EPI) { if (wr == 0) PG8_BAR; }
        { const int _l = lane_id(); E(acc, cur, wr, wc, _l & 15, _l >> 4); }
        if (!has_next) break;
#pragma unroll
        for (int a = 0; a < 2; ++a)
#pragma unroll
            for (int b = 0; b < 2; ++b)
#pragma unroll
                for (int m = 0; m < 4; ++m)
#pragma unroll
                    for (int n = 0; n < 2; ++n) acc[a][b][m][n] = (f32x4){0.f, 0.f, 0.f, 0.f};
        cur = nxt; cB = nB; ++ui;
        { const u32x4 nv = *nslot; ua[0][0] = nv.x; ua[0][1] = nv.y; ua[1][0] = nv.z; ua[1][1] = nv.w; }
        if constexpr (ALIGN_EPI) { if (wr == 1) PG8_BAR; }
    }
    PG8_WAIT_V(0);
    if constexpr (!ALIGN_EPI) { if (wr == 0) PG8_BAR; }
    PG8_BAR;
#undef PG8_SA
#undef PG8_SB
#undef PG8_STAGEA
#undef PG8_STAGEB
#undef PG8_LDA
#undef PG8_LD8
#undef PG8_LO
#undef PG8_HI
#undef PG8_LDB
#undef PG8_MMA
#undef PG8_WAIT_V
#undef PG8_WAIT_L
#undef PG8_BAR
#undef PG8_SCHED
#undef PG8_AOFFS
}

struct EpiQKV {
    static constexpr bool PERM = true;
    bf16_t* O; const float* ropec; const float* ropes;
    __device__ __forceinline__ void operator()(const f32x4 (&acc)[2][2][4][2], const Unit& u, int wr, int wc, int fr, int fq) const {
        const int t = u.pn >> 2, colt = (u.pn & 3) * BM;
        bf16_t* base = O + (size_t)t * QKV_STRIDE;
        const int row0 = u.orow0 + wr * 64 + fr, col0 = colt + wc * 32 + 8 * fq;
        const float sc = (t == 0 || t == 3) ? C2 : 1.0f;
        const bool rope = t < 2;
        const int fi = 4 * (4 * (wc & 1) + fq);
        f32x4 cs[2][4], sn[2][4];
#pragma unroll
        for (int ai = 0; ai < 2; ++ai)
#pragma unroll
            for (int m = 0; m < 4; ++m) {
                cs[ai][m] = (f32x4){1.f, 1.f, 1.f, 1.f}; sn[ai][m] = (f32x4){0.f, 0.f, 0.f, 0.f};
                if (rope) { const int pos = (row0 + ai * HALF + m * 16) & (SEQ - 1); cs[ai][m] = *(const f32x4*)(ropec + pos * 32 + fi); sn[ai][m] = *(const f32x4*)(ropes + pos * 32 + fi); }
            }
#pragma unroll
        for (int ai = 0; ai < 2; ++ai)
#pragma unroll
            for (int m = 0; m < 4; ++m) {
                const int row = row0 + ai * HALF + m * 16;
                bf16_t* rowp = base + (size_t)row * GW + col0;
#pragma unroll
                for (int bj = 0; bj < 2; ++bj) {
                    const f32x4 x1 = acc[ai][bj][m][0], x2 = acc[ai][bj][m][1];
                    const f32x4 y1 = (x1 * cs[ai][m] - x2 * sn[ai][m]) * sc, y2 = (x2 * cs[ai][m] + x1 * sn[ai][m]) * sc;
                    u32x4 w; w.x = cvt_pk_bf16(y1[0], y1[1]); w.y = cvt_pk_bf16(y1[2], y1[3]); w.z = cvt_pk_bf16(y2[0], y2[1]); w.w = cvt_pk_bf16(y2[2], y2[3]);
                    *(u32x4*)(rowp + bj * HALF) = w;
                }
            }
    }
};

struct GroupedOrder {
    const LAS int* tab; int G, c, NT, total; const char* Bt; size_t bstride; int RB; const int* list; bool gather;
    const LAS int* rowtab;
    mutable int ecur;
    __device__ void init(const LAS int* tab_, int NT_, const void* Bt_, size_t bstride_bytes, int RB_, const int* list_, bool gather_, int G_, int c_, const LAS int* rowtab_) {
        tab = tab_; NT = NT_; Bt = (const char*)Bt_; bstride = bstride_bytes; RB = RB_; list = list_; gather = gather_; G = G_; c = c_; rowtab = rowtab_; ecur = 0;
        total = __builtin_amdgcn_readfirstlane(tab_[96 + 32]) * NT_; }
    __device__ bool next(int i, Unit& u) const {
        const int L = i * G + c; if (L >= total) return false;
        int wgid = L; { const int q = total / NXCD, r = total % NXCD, xcd = wgid % NXCD, off = wgid / NXCD; wgid = (xcd < r ? xcd * (q + 1) : r * (q + 1) + (xcd - r) * q) + off; }
        int e = ecur;
        while (e + 1 < NEXP && wgid >= __builtin_amdgcn_readfirstlane(tab[96 + e + 1]) * NT) ++e;
        ecur = e;
        const int local = wgid - __builtin_amdgcn_readfirstlane(tab[96 + e]) * NT, nrb = __builtin_amdgcn_readfirstlane(tab[32 + e]);
        const int rb = local % nrb, pn = local / nrb, ps = __builtin_amdgcn_readfirstlane(tab[64 + e]), cn = __builtin_amdgcn_readfirstlane(tab[e]);
        u.e = __builtin_amdgcn_readfirstlane(e); u.pn = __builtin_amdgcn_readfirstlane(pn); u.orow0 = __builtin_amdgcn_readfirstlane(ps + rb * BM); u.arow0 = __builtin_amdgcn_readfirstlane(gather ? (e * NTOK + rb * BM) : (ps + rb * BM));
        u.nvalid = __builtin_amdgcn_readfirstlane(cn - rb * BM); u.bptr = uniform_ptr(Bt + (size_t)u.e * bstride + (size_t)u.pn * BM * RB); u.ui = i;
        return true;
    }
    __device__ __forceinline__ unsigned a_off(const Unit& u, int r) const {
        int row;
        if (gather) { if (u.ui < ROWTAB_UNITS) row = rowtab[u.ui * BM + r]; else { row = 0; if (r < u.nvalid) row = list[u.arow0 + r] >> 2; } } else row = u.arow0 + r;
        return (unsigned)row * (unsigned)RB;
    }
    __device__ __forceinline__ void fill_rowtab(LAS int* wtab, int tid) const {
        if (tid < BM) { Unit u; const int keep = ecur;
            for (int i = 0; i < ROWTAB_UNITS && next(i, u); ++i) wtab[i * BM + tid] = (tid < u.nvalid) ? (list[u.arow0 + tid] >> 2) : 0;
            ecur = keep; }
    }
};
struct EpiGateUp {
    static constexpr bool PERM = true;
    unsigned char* H1; const float* bg; const float* bu;
    __device__ __forceinline__ void operator()(const f32x4 (&acc)[2][2][4][2], const Unit& u, int wr, int wc, int fr, int fq) const {
        const int row0 = u.orow0 + wr * 64 + fr, col0 = u.pn * HALF + wc * 32 + 8 * fq;
        const float* bgp = bg + (size_t)u.e * D_MODEL + col0; const float* bup = bu + (size_t)u.e * D_MODEL + col0;
        f32x4 bgv[2], buv[2];
#pragma unroll
        for (int n = 0; n < 2; ++n) { bgv[n] = *(const f32x4*)(bgp + 4 * n); buv[n] = *(const f32x4*)(bup + 4 * n); }
#pragma unroll
        for (int ai = 0; ai < 2; ++ai)
#pragma unroll
            for (int m = 0; m < 4; ++m) {
                float o[8];
#pragma unroll
                for (int n = 0; n < 2; ++n)
#pragma unroll
                    for (int j = 0; j < 4; ++j) {
                        float g = acc[ai][0][m][n][j] * W8_INV + bgv[n][j], uu = acc[ai][1][m][n][j] * W8_INV + buv[n][j];
                        g = fminf(g, 7.0f); uu = fminf(fmaxf(uu, -7.0f), 7.0f);
                        const float e = __builtin_amdgcn_exp2f(g * (-1.702f * 1.4426950408889634f));
                        o[4 * n + j] = (uu + 1.0f) * (g * __builtin_amdgcn_rcpf(1.0f + e));
                    }
                u32x2 w; w.x = cvt_pk4_fp8(o[0], o[1], o[2], o[3]); w.y = cvt_pk4_fp8(o[4], o[5], o[6], o[7]);
                *(u32x2*)(H1 + (size_t)(row0 + ai * HALF + m * 16) * D_MODEL + col0) = w;
            }
    }
};
struct EpiDown {
    static constexpr bool PERM = true;
    unsigned char* Y; const float* bd;
    __device__ __forceinline__ void operator()(const f32x4 (&acc)[2][2][4][2], const Unit& u, int wr, int wc, int fr, int fq) const {
        const int row0 = u.orow0 + wr * 64 + fr, col0 = u.pn * BM + wc * 32 + 8 * fq;
        const float* bp = bd + (size_t)u.e * D_MODEL + col0;
        f32x4 bv[2][2];
#pragma unroll
        for (int bj = 0; bj < 2; ++bj)
#pragma unroll
            for (int n = 0; n < 2; ++n) bv[bj][n] = *(const f32x4*)(bp + bj * HALF + 4 * n);
#pragma unroll
        for (int ai = 0; ai < 2; ++ai)
#pragma unroll
            for (int m = 0; m < 4; ++m) { unsigned char* rowp = Y + (size_t)(row0 + ai * HALF + m * 16) * D_MODEL + col0;
#pragma unroll
                for (int bj = 0; bj < 2; ++bj) { const f32x4 v0 = acc[ai][bj][m][0] * W8_INV + bv[bj][0], v1 = acc[ai][bj][m][1] * W8_INV + bv[bj][1];
                    u32x2 w; w.x = cvt_pk4_fp8(v0[0], v0[1], v0[2], v0[3]); w.y = cvt_pk4_fp8(v1[0], v1[1], v1[2], v1[3]);
                    *(u32x2*)(rowp + bj * HALF) = w; } }
    }
};
struct EpiOut {
    static constexpr bool PERM = true;
    const float* x; bf16_t* X1;
    __device__ __forceinline__ void operator()(const f32x4 (&acc)[2][2][4][2], const Unit& u, int wr, int wc, int fr, int fq) const {
        const int row0 = u.orow0 + wr * 64 + fr, col0 = u.pn * BM + wc * 32 + 8 * fq;
#pragma unroll
        for (int ai = 0; ai < 2; ++ai) {
            f32x4 xr[4][2][2];
#pragma unroll
            for (int m = 0; m < 4; ++m)
#pragma unroll
                for (int bj = 0; bj < 2; ++bj)
#pragma unroll
                    for (int n = 0; n < 2; ++n) xr[m][bj][n] = *(const f32x4*)(x + (size_t)(row0 + ai * HALF + m * 16) * D_MODEL + col0 + bj * HALF + n * 4);
#pragma unroll
            for (int m = 0; m < 4; ++m)
#pragma unroll
                for (int bj = 0; bj < 2; ++bj) { const f32x4 v0 = xr[m][bj][0] + acc[ai][bj][m][0], v1 = xr[m][bj][1] + acc[ai][bj][m][1];
                    u32x4 w; w.x = cvt_pk_bf16(v0[0], v0[1]); w.y = cvt_pk_bf16(v0[2], v0[3]); w.z = cvt_pk_bf16(v1[0], v1[1]); w.w = cvt_pk_bf16(v1[2], v1[3]);
                    *(u32x4*)(X1 + (size_t)(row0 + ai * HALF + m * 16) * D_MODEL + col0 + bj * HALF) = w; }
        }
    }
};
}

constexpr int NWAVES = 8;
constexpr int RING_BYTES = 131072, MISC_OFF = RING_BYTES + 320, LDS_BYTES = 163840, ROWTAB_OFF = RING_BYTES + 16384;
struct Args { const float* in[16]; float* out; unsigned char* ws; int ph_lo, ph_hi; };
constexpr int NPHASE = 9;
#ifndef NCONV
#define NCONV 128
#endif

struct Frame {
    LAS unsigned char* lds; int vcu, G, wave; unsigned char* ws;
};

template <class RM>
__device__ __forceinline__ void conv_tile(const float* __restrict__ W, int N, bf16_t* __restrict__ Wt, int K, int kb, int nb, int lane, const RM& rm) {
    const int kg = lane & 7, ng = lane >> 3;
    const int k0 = kb * 64 + kg * 8, n0 = nb * 32 + ng * 4;
    f32x4 v[8];
#pragma unroll
    for (int j = 0; j < 8; ++j) v[j] = __builtin_nontemporal_load((const f32x4*)(W + (size_t)(k0 + j) * N + n0));
#pragma unroll
    for (int c = 0; c < 4; ++c) {
        u32x4 o; o.x = cvt_pk_bf16(v[0][c], v[1][c]); o.y = cvt_pk_bf16(v[2][c], v[3][c]); o.z = cvt_pk_bf16(v[4][c], v[5][c]); o.w = cvt_pk_bf16(v[6][c], v[7][c]);
        *(u32x4*)(Wt + (size_t)rm(n0 + c) * K + k0) = o;
    }
}
template <class RM>
__device__ __forceinline__ void conv_tile8(const float* __restrict__ W, int N, unsigned char* __restrict__ Wt, int K, int kb, int nb, int lane, const RM& rm) {
    const int kg = lane & 7, ng = lane >> 3;
    const int k0 = kb * 64 + kg * 8, n0 = nb * 32 + ng * 4;
    f32x4 v[8];
#pragma unroll
    for (int j = 0; j < 8; ++j) v[j] = __builtin_nontemporal_load((const f32x4*)(W + (size_t)(k0 + j) * N + n0)) * W8_SCALE;
#pragma unroll
    for (int c = 0; c < 4; ++c) {
        u32x2 o; o.x = cvt_pk4_fp8(v[0][c], v[1][c], v[2][c], v[3][c]); o.y = cvt_pk4_fp8(v[4][c], v[5][c], v[6][c], v[7][c]);
        *(u32x2*)(Wt + (size_t)rm(n0 + c) * K + k0) = o;
    }
}
struct RmIdent { __device__ __forceinline__ int operator()(int n) const { return n; } };
struct RmWin {
    __device__ __forceinline__ int operator()(int n) const { if (n >= 2048) return n; const int o = n & 63, a = (o & 31) >> 2, j = (o & 3) + ((o >> 5) << 2); return (n & ~63) + 8 * a + j; } };
struct RmGU { int up; __device__ __forceinline__ int operator()(int n) const { return 256 * (n >> 7) + 128 * up + (n & 127); } };

__device__ __forceinline__ void p0_prologue(const Frame& F, const Args& a) {
    unsigned char* ws = F.ws;
    const int tid_ = fresh_tid(F.wave), lane = tid_ & 63, wave_ = F.wave;
    const int gw = F.vcu * NWAVES + wave_, NGW = F.G * NWAVES;
    const float* x = a.in[0]; const float* attn_norm = a.in[1]; const float* w_in = a.in[2]; const float* w_out = a.in[5]; const float* w_router = a.in[7];
    {
        f32x4 gn[8];
#pragma unroll
        for (int j = 0; j < 8; ++j) gn[j] = *((const f32x4*)attn_norm + lane + 64 * j);
        for (int r0 = gw; r0 < NTOK; r0 += NGW * 4) {
            f32x4 v[4][8];
#pragma unroll
            for (int t = 0; t < 4; ++t) { const int r = (r0 + t * NGW < NTOK) ? r0 + t * NGW : r0; const f32x4* xr = (const f32x4*)(x + (size_t)r * D_MODEL) + lane;
#pragma unroll
                for (int j = 0; j < 8; ++j) v[t][j] = xr[64 * j]; }
#pragma unroll
            for (int t = 0; t < 4; ++t) { const int r = r0 + t * NGW; if (r < NTOK) {
                float s = 0.f;
#pragma unroll
                for (int j = 0; j < 8; ++j) s += (v[t][j].x * v[t][j].x + v[t][j].y * v[t][j].y) + (v[t][j].z * v[t][j].z + v[t][j].w * v[t][j].w);
                const float rstd = rsqrtf(wave_sum(s) * (1.f / D_MODEL) + EPS);
                u32x2* o = (u32x2*)((bf16_t*)(ws + WS_XN) + (size_t)r * D_MODEL) + lane;
#pragma unroll
                for (int j = 0; j < 8; ++j) { u32x2 w; w.x = cvt_pk_bf16(v[t][j].x * rstd * gn[j].x, v[t][j].y * rstd * gn[j].y); w.y = cvt_pk_bf16(v[t][j].z * rstd * gn[j].z, v[t][j].w * rstd * gn[j].w); o[64 * j] = w; } } }
        }
    }
    for (int i = gw * 64 + lane; i < SEQ * 32; i += NGW * 64) {
        const int pos = i >> 5, f = i & 31;
        const float inv_freq = 1.0f / powf(10000.0f, (float)f * 2.0f / 64.0f);
        const float ang = (float)pos * inv_freq;
        ((float*)(ws + WS_ROPEC))[i] = cosf(ang); ((float*)(ws + WS_ROPES))[i] = sinf(ang);
    }
    for (int i = gw * 64 + lane; i < NEXP * D_MODEL; i += NGW * 64) { const int e = i >> 11, k = i & 2047; ((float*)(ws + WS_WRT))[i] = w_router[(size_t)k * NEXP + e]; }
    constexpr int T_IN = 32 * 192, T_OUT = 32 * 64, T_E = 32 * 64;
    {
        const int kg = lane & 7, ng = lane >> 3;
        auto tile_of = [&](int it, const float*& W, int& N, bf16_t*& Wt, int& k0, int& n0, bool& win) {
            win = it < T_IN; const int r = win ? it : it - T_IN, nbk = win ? 192 : 64;
            W = win ? w_in : w_out; N = win ? INW : D_MODEL; Wt = (bf16_t*)(ws + (win ? WS_WIN : WS_WOUT)); k0 = (r / nbk) * 64 + kg * 8; n0 = (r % nbk) * 32 + ng * 4; };
        for (int it0 = gw; it0 < T_IN + T_OUT; it0 += NGW * 2) {
            f32x4 v[2][8];
#pragma unroll
            for (int t = 0; t < 2; ++t) { const int it = (it0 + t * NGW < T_IN + T_OUT) ? it0 + t * NGW : it0; const float* W; int N, k0, n0; bf16_t* Wt; bool win; tile_of(it, W, N, Wt, k0, n0, win);
#pragma unroll
                for (int j = 0; j < 8; ++j) v[t][j] = __builtin_nontemporal_load((const f32x4*)(W + (size_t)(k0 + j) * N + n0)); }
#pragma unroll
            for (int t = 0; t < 2; ++t) { const int it = it0 + t * NGW; if (it < T_IN + T_OUT) { const float* W; int N, k0, n0; bf16_t* Wt; bool win; tile_of(it, W, N, Wt, k0, n0, win);
#pragma unroll
                for (int c = 0; c < 4; ++c) {
                    u32x4 o; o.x = cvt_pk_bf16(v[t][0][c], v[t][1][c]); o.y = cvt_pk_bf16(v[t][2][c], v[t][3][c]); o.z = cvt_pk_bf16(v[t][4][c], v[t][5][c]); o.w = cvt_pk_bf16(v[t][6][c], v[t][7][c]);
                    const int n = n0 + c, row = win ? RmWin{}(n) : n;
                    *(u32x4*)(Wt + (size_t)row * D_MODEL + k0) = o; } } }
        }
    }
}

constexpr int CV_T_E = 32 * 64, CV_NTILES = 3 * NEXP * CV_T_E, CV_ITEM_TILES = 64, CV_NITEMS = CV_NTILES / CV_ITEM_TILES;
constexpr int LDS_QSLOT = RING_BYTES + 2048;
__device__ __forceinline__ void conv_items(const Frame& F, const Args& a, const unsigned* stop_word, unsigned stop_count, int qword = CW_CONVQ) {
    unsigned char* ws = F.ws;
    const int tid = fresh_tid(F.wave), lane = tid & 63;
    const float* w_gate = a.in[9]; const float* w_up = a.in[11]; const float* w_down = a.in[13];
    unsigned* qn = (unsigned*)(ws + WS_CTL) + qword;
    LAS int* s_item = (LAS int*)(F.lds + LDS_QSLOT);
    for (;;) {
        if (tid == 0) {
            int it = -1;
            const bool stop = stop_word && __hip_atomic_load(stop_word, __ATOMIC_RELAXED, __HIP_MEMORY_SCOPE_AGENT) >= stop_count;
            if (!stop) it = (int)__hip_atomic_fetch_add(qn, 1u, __ATOMIC_RELAXED, __HIP_MEMORY_SCOPE_AGENT);
            *s_item = it;
        }
        __syncthreads();
        const int item = __builtin_amdgcn_readfirstlane(*s_item);
        __syncthreads();
        if (item < 0 || item >= CV_NITEMS) break;
        const int mat = item / (NEXP * 32), r = item - mat * (NEXP * 32), e = r >> 5, kb = (r >> 1) & 15, nh = r & 1;
        const int kh = F.wave >> 2, wq = F.wave & 3;
        const float* W = (mat == 0 ? w_gate : mat == 1 ? w_up : w_down) + (size_t)e * D_MODEL * D_MODEL;
        const float* s = W + (size_t)(kb * 128 + kh * 64) * D_MODEL + nh * 1024 + wq * 256 + lane * 4;
        unsigned char* dst = ((mat == 2) ? (ws + WS_WD + (size_t)e * D_MODEL * D_MODEL) : (ws + WS_WGU + (size_t)e * 4096 * D_MODEL)) + kb * 128;
        LAS unsigned char* T = F.lds;
        const int nl = wq * 256 + lane * 4, fz = lane & 15;
        constexpr int CVD = 3;
        f32x4 v[CVD][8];
#pragma unroll
        for (int d = 0; d < CVD - 1; ++d)
#pragma unroll
            for (int j = 0; j < 8; ++j) v[d][j] = __builtin_nontemporal_load((const f32x4*)(s + (size_t)(d * 8 + j) * D_MODEL));
#pragma unroll
        for (int st = 0; st < 8; ++st) {
            if (st + CVD - 1 < 8) {
#pragma unroll
                for (int j = 0; j < 8; ++j) v[(st + CVD - 1) % CVD][j] = __builtin_nontemporal_load((const f32x4*)(s + (size_t)((st + CVD - 1) * 8 + j) * D_MODEL)); }
            const f32x4* vv = v[st % CVD];
#pragma unroll
            for (int c = 0; c < 4; ++c) {
                u32x2 o; o.x = cvt_pk4_fp8(vv[0][c] * W8_SCALE, vv[1][c] * W8_SCALE, vv[2][c] * W8_SCALE, vv[3][c] * W8_SCALE); o.y = cvt_pk4_fp8(vv[4][c] * W8_SCALE, vv[5][c] * W8_SCALE, vv[6][c] * W8_SCALE, vv[7][c] * W8_SCALE);
                *(LAS u32x2*)(T + (nl + c) * 128 + (((kh * 8 + st) ^ fz) * 8)) = o;
            }
        }
        __syncthreads();
#pragma unroll
        for (int i = 0; i < 16; ++i) {
            const int id = tid + 512 * i, nn = id >> 3, q = id & 7, f = (nn >> 2) & 15, n = nh * 1024 + nn;
            u32x4 d = *(const LAS u32x4*)(T + nn * 128 + (((2 * q) ^ (f & 14)) * 8));
            if (f & 1) d = (u32x4){d.z, d.w, d.x, d.y};
            const int row = (mat == 2) ? n : (256 * (n >> 7) + 128 * mat + (n & 127));
            __builtin_nontemporal_store(d, (u32x4*)(dst + (size_t)row * D_MODEL + 16 * q));
        }
        __syncthreads();
    }
}

namespace attn {
typedef float f32x16 __attribute__((ext_vector_type(16)));
typedef short s16x4 __attribute__((ext_vector_type(4)));
typedef short v4i16_t __attribute__((ext_vector_type(4)));
#define MFMA32(a, b, c) __builtin_amdgcn_mfma_f32_32x32x16_bf16(a, b, c, 0, 0, 0)
__device__ __forceinline__ int crow(int r, int hi) { return (r & 3) + 8 * (r >> 2) + 4 * hi; }
__device__ __forceinline__ s16x4 vtr(const LAS unsigned char* p) { return __builtin_bit_cast(s16x4, __builtin_amdgcn_ds_read_tr16_b64_v4i16((LAS v4i16_t*)p)); }
__device__ __forceinline__ float xhalf(float v) {
    auto rr = __builtin_amdgcn_permlane32_swap(__float_as_uint(v), __float_as_uint(v), false, false);
    return (lane_id() & 32) ? __uint_as_float(rr[0]) : __uint_as_float(rr[1]);
}
__device__ __forceinline__ bf16x8 pack8(const f32x16& p, int ks) {
    u32x4 w; w.x = cvt_pk_bf16(p[8 * ks + 0], p[8 * ks + 1]); w.y = cvt_pk_bf16(p[8 * ks + 2], p[8 * ks + 3]); w.z = cvt_pk_bf16(p[8 * ks + 4], p[8 * ks + 5]); w.w = cvt_pk_bf16(p[8 * ks + 6], p[8 * ks + 7]);
    return __builtin_bit_cast(bf16x8, w);
}
__device__ __forceinline__ bf16x8 cat44(s16x4 lo, s16x4 hi) { bf16x8 r; r[0] = lo[0]; r[1] = lo[1]; r[2] = lo[2]; r[3] = lo[3]; r[4] = hi[0]; r[5] = hi[1]; r[6] = hi[2]; r[7] = hi[3]; return r; }
__device__ __forceinline__ void store_ot(const f32x16 (&O)[2], float scale, bf16_t* orow, int hi) {
#pragma unroll
    for (int dh = 0; dh < 2; ++dh)
#pragma unroll
        for (int g = 0; g < 4; ++g) { u32x2 w; w.x = cvt_pk_bf16(O[dh][4 * g] * scale, O[dh][4 * g + 1] * scale); w.y = cvt_pk_bf16(O[dh][4 * g + 2] * scale, O[dh][4 * g + 3] * scale);
            *(u32x2*)(orow + 32 * dh + 8 * g + 4 * hi) = w; }
}

constexpr int DA_ROWS = 384, DA_KPL = (DA_ROWS + 1) * 16, DA_VHL = DA_ROWS * 64 + 64, DA_VOFF = 8 * DA_KPL, DA_LDS = DA_VOFF + 2 * DA_VHL;
struct DaUnit { int b, h, p, ib; };
struct DaRegs { u32x4 kv[6], vv[6]; bf16x8 qf[4]; int tokq, uq; };
__device__ __forceinline__ void da_load(DaRegs& R, const bf16_t* __restrict__ QD, const bf16_t* __restrict__ KD, const bf16_t* __restrict__ VD, const DaUnit& u, int tid) {
    const int lane = tid & 63, wid = __builtin_amdgcn_readfirstlane(tid >> 6), r32 = lane & 31, hi = lane >> 5;
    const int lgL = 11 - 2 * u.p, dsh = 2 * u.p, Lm1 = (1 << lgL) - 1, i0 = u.ib * 256;
#pragma unroll
    for (int t = 0; t < 6; ++t) {
        const int idx = tid + 512 * t, j = idx >> 3, c = idx & 7, ip = i0 - 128 + j;
        R.kv[t] = (u32x4){0u, 0u, 0u, 0u}; R.vv[t] = (u32x4){0u, 0u, 0u, 0u};
        if (ip >= 0) { const int pos = ((ip & Lm1) << dsh) + (ip >> lgL); const size_t go = (size_t)(u.b * SEQ + pos) * GW + u.h * 64 + c * 8; R.kv[t] = *(const u32x4*)(KD + go); R.vv[t] = *(const u32x4*)(VD + go); }
    }
    const int iq = i0 + 32 * wid + r32; R.uq = iq & Lm1; R.tokq = u.b * SEQ + (R.uq << dsh) + (iq >> lgL);
#pragma unroll
    for (int d0 = 0; d0 < 4; ++d0) R.qf[d0] = *(const bf16x8*)(QD + (size_t)R.tokq * GW + u.h * 64 + 16 * d0 + 8 * hi);
}
__device__ __forceinline__ void da_fill(LAS unsigned char* lds, const DaRegs& R, int tid) {
#pragma unroll
    for (int t = 0; t < 6; ++t) {
        const int idx = tid + 512 * t, j = idx >> 3, c = idx & 7;
        *(LAS u32x4*)(lds + c * DA_KPL + j * 16) = R.kv[t];
        *(LAS u32x4*)(lds + DA_VOFF + (c >> 2) * DA_VHL + j * 64 + (c & 3) * 16) = R.vv[t];
    }
}
__device__ __forceinline__ void da_compute(const LAS unsigned char* lds, const bf16x8 (&qf)[4], int tokq, int uq, bf16_t* __restrict__ OP, float* __restrict__ LSE, int h, int p, int tid) {
    const int lane = tid & 63, wid = __builtin_amdgcn_readfirstlane(tid >> 6), r32 = lane & 31, hi = lane >> 5;
    f32x16 S[5];
#pragma unroll
    for (int s = 0; s < 5; ++s) {
        S[s] = (f32x16){};
#pragma unroll
        for (int d0 = 0; d0 < 4; ++d0) { const bf16x8 kf = *(const LAS bf16x8*)(lds + (2 * d0 + hi) * DA_KPL + (32 * wid + 32 * s + r32) * 16); S[s] = MFMA32(kf, qf[d0], S[s]); }
    }
    const int lim = uq < 128 ? uq : 128, lv = r32 - 4 * hi;
    float mx = -INFINITY;
#pragma unroll
    for (int s = 0; s < 5; ++s)
#pragma unroll
        for (int r = 0; r < 16; ++r) { const int dist = lv + (128 - 32 * s - ((r & 3) + 8 * (r >> 2))); const bool ok = (dist >= 0) && (dist <= lim); const float v = ok ? S[s][r] : -INFINITY; S[s][r] = v; mx = fmaxf(mx, v); }
    mx = fmaxf(mx, xhalf(mx));
    float l = 0.f;
#pragma unroll
    for (int s = 0; s < 5; ++s)
#pragma unroll
        for (int r = 0; r < 16; ++r) { const float pv = __builtin_amdgcn_exp2f(S[s][r] - mx); S[s][r] = pv; l += pv; }
    l += xhalf(l);
    f32x16 O[2]; O[0] = (f32x16){}; O[1] = (f32x16){};
    const LAS unsigned char* vb = lds + DA_VOFF + (32 * wid + 4 * hi + ((lane & 15) >> 2)) * 64 + ((lane >> 4) & 1) * 32 + (lane & 3) * 8;
#pragma unroll
    for (int s = 0; s < 5; ++s)
#pragma unroll
        for (int ks = 0; ks < 2; ++ks) {
            const bf16x8 pb = pack8(S[s], ks);
#pragma unroll
            for (int dh = 0; dh < 2; ++dh) { const LAS unsigned char* a = vb + dh * DA_VHL + (32 * s + 16 * ks) * 64; O[dh] = MFMA32(cat44(vtr(a), vtr(a + 512)), pb, O[dh]); }
        }
    store_ot(O, 1.0f / l, OP + ((size_t)p * NTOK + tokq) * GW + h * 64, hi);
    if (hi == 0) LSE[((size_t)p * NTOK + tokq) * NH + h] = mx + __builtin_amdgcn_logf(l);
}

constexpr int SB_ROWS = 448, SB_KPL = (SB_ROWS + 1) * 16, SB_VHL = SB_ROWS * 64 + 64, SB_VOFF = 8 * SB_KPL, SB_LDS = SB_VOFF + 2 * SB_VHL, SB_FLAGS = SB_LDS;
static_assert(SB_LDS + 64 <= 131072, "stick-breaking chunk image fits the phase scratch region");
__device__ __forceinline__ void sb_unit(LAS unsigned char* lds, const bf16_t* __restrict__ QS, const bf16_t* __restrict__ KS, const bf16_t* __restrict__ VS, bf16_t* __restrict__ OSB,
                                        int b, int h, int qb, int tid) {
    const int lane = tid & 63, wid = __builtin_amdgcn_readfirstlane(tid >> 6), r32 = lane & 31, hi = lane >> 5;
    const int t0w = 256 * qb + 32 * wid, tq = t0w + r32, tokq = b * SEQ + tq;
    bf16x8 qf[4];
#pragma unroll
    for (int d0 = 0; d0 < 4; ++d0) qf[d0] = *(const bf16x8*)(QS + (size_t)tokq * GW + h * 64 + 16 * d0 + 8 * hi);
    f32x16 O[2]; O[0] = (f32x16){}; O[1] = (f32x16){};
    float C = 0.f;
    bool done = false;
    const int vlane = (4 * hi + ((lane & 15) >> 2)) * 64 + ((lane >> 4) & 1) * 32 + (lane & 3) * 8;
    LAS int* s_need = (LAS int*)(lds + SB_FLAGS);
    int khi = 256 * qb + 255;
    for (;;) {
        const int klo = (khi - (SB_ROWS - 1)) > 0 ? (khi - (SB_ROWS - 1)) : 0, nrows = khi - klo + 1;
        {
            u32x4 kr[7], vr[7];
#pragma unroll
            for (int t = 0; t < 7; ++t) { const int idx = tid + 512 * t, j = idx >> 3, c = idx & 7;
                kr[t] = (u32x4){0u, 0u, 0u, 0u}; vr[t] = (u32x4){0u, 0u, 0u, 0u};
                if (j < nrows) { const size_t go = (size_t)(b * SEQ + klo + j) * GW + h * 64 + c * 8; kr[t] = *(const u32x4*)(KS + go); vr[t] = *(const u32x4*)(VS + go); } }
#pragma unroll
            for (int t = 0; t < 7; ++t) { const int idx = tid + 512 * t, j = idx >> 3, c = idx & 7;
                *(LAS u32x4*)(lds + c * SB_KPL + j * 16) = kr[t]; *(LAS u32x4*)(lds + SB_VOFF + (c >> 2) * SB_VHL + j * 64 + (c & 3) * 16) = vr[t]; }
        }
        __syncthreads();
        if (!done) {
            for (int kt = khi >> 6; kt >= (klo >> 6); --kt) {
                if (64 * kt > t0w + 30) continue;
                const bool diag = (64 * kt + 63 >= t0w);
                const LAS unsigned char* kb = lds + (64 * kt - klo) * 16; const LAS unsigned char* vb = lds + SB_VOFF + (64 * kt - klo) * 64 + vlane;
#pragma unroll
                for (int sub = 1; sub >= 0; --sub) {
                    const int keyb = 64 * kt + 32 * sub;
                    if (keyb > t0w + 30) continue;
                    f32x16 Z = (f32x16){};
#pragma unroll
                    for (int d0 = 0; d0 < 4; ++d0) { const bf16x8 kf = *(const LAS bf16x8*)(kb + (2 * d0 + hi) * SB_KPL + (32 * sub + r32) * 16); Z = MFMA32(kf, qf[d0], Z); }
                    const int kl = keyb + 4 * hi;
                    float sp[16];
#pragma unroll
                    for (int r = 0; r < 16; ++r) { const float e = __builtin_amdgcn_exp2f(Z[r]); float v = __builtin_amdgcn_logf(1.0f + e); if (diag) { const bool ok = (kl + (r & 3) + 8 * (r >> 2)) < tq; v = ok ? v : 0.f; } sp[r] = v; }
                    float own[4], oth[4];
#pragma unroll
                    for (int g = 0; g < 4; ++g) { sp[4 * g + 2] += sp[4 * g + 3]; sp[4 * g + 1] += sp[4 * g + 2]; sp[4 * g] += sp[4 * g + 1]; own[g] = sp[4 * g]; oth[g] = xhalf(own[g]); }
                    float off[4]; float run = C;
#pragma unroll
                    for (int g = 3; g >= 0; --g) { off[g] = run + (hi == 0 ? oth[g] : 0.f); run += own[g] + oth[g]; }
                    C = run;
#pragma unroll
                    for (int r = 0; r < 16; ++r) { float a = __builtin_amdgcn_exp2f(Z[r] - (off[r >> 2] + sp[r])); if (diag) { const bool ok = (kl + (r & 3) + 8 * (r >> 2)) < tq; a = ok ? a : 0.f; } Z[r] = a; }
#pragma unroll
                    for (int ks = 0; ks < 2; ++ks) {
                        const bf16x8 pb = pack8(Z, ks);
#pragma unroll
                        for (int dh = 0; dh < 2; ++dh) { const LAS unsigned char* a = vb + dh * SB_VHL + (32 * sub + 16 * ks) * 64; O[dh] = MFMA32(cat44(vtr(a), vtr(a + 512)), pb, O[dh]); }
                    }
                }
                float cm = C;
#pragma unroll
                for (int o = 1; o < 32; o <<= 1) cm = fminf(cm, __shfl_xor(cm, o));
                if (__builtin_amdgcn_readfirstlane(__float_as_int(cm)) >= __float_as_int(150.0f)) { done = true; break; }
            }
        }
        if (lane == 0) s_need[wid] = (!done && klo > 0) ? 1 : 0;
        __syncthreads();
        int any = 0;
#pragma unroll
        for (int i = 0; i < 8; ++i) any |= s_need[i];
        __syncthreads();
        if (!any) break;
        khi = klo - 1;
    }
    store_ot(O, 1.0f, OSB + (size_t)tokq * GW + h * 64, hi);
}
#undef MFMA32
}

__device__ __forceinline__ void p3_combine(const Frame& F, const Args& a) {
    unsigned char* ws = F.ws;
    const int tid_ = fresh_tid(F.wave), lane = tid_ & 63, wave_ = F.wave;
    const int gw = F.vcu * NWAVES + wave_, NGW = F.G * NWAVES;
    const bf16_t* OP = (const bf16_t*)(ws + WS_OP); const bf16_t* OSB = (const bf16_t*)(ws + WS_OSB); const float* LSE = (const float*)(ws + WS_LSE);
    bf16_t* ACAT = (bf16_t*)(ws + WS_ACAT);
    const float* gd = a.in[3]; const float* gs = a.in[4];
    const int hd = lane >> 2;
    float gdv[16], gsv[16];
#pragma unroll
    for (int j = 0; j < 16; ++j) { gdv[j] = gd[lane * 16 + j]; gsv[j] = gs[lane * 16 + j]; }
    constexpr int TB = 4;
    for (int tok0 = gw; tok0 < NTOK; tok0 += NGW * TB) {
        u32x4 ra[TB][4][2]; float ls[TB][3];
#pragma unroll
        for (int t = 0; t < TB; ++t) { const int tok = tok0 + t * NGW; if (tok < NTOK) {
#pragma unroll
            for (int p = 0; p < 3; ++p) { ls[t][p] = LSE[((size_t)p * NTOK + tok) * NH + hd]; const u32x4* pp = (const u32x4*)(OP + ((size_t)p * NTOK + tok) * GW + lane * 16); ra[t][p][0] = pp[0]; ra[t][p][1] = pp[1]; }
            const u32x4* ps = (const u32x4*)(OSB + (size_t)tok * GW + lane * 16); ra[t][3][0] = ps[0]; ra[t][3][1] = ps[1]; } }
#pragma unroll
        for (int t = 0; t < TB; ++t) { const int tok = tok0 + t * NGW; if (tok < NTOK) {
            const float mx = fmaxf(ls[t][0], fmaxf(ls[t][1], ls[t][2]));
            float w0 = __builtin_amdgcn_exp2f(ls[t][0] - mx), w1 = __builtin_amdgcn_exp2f(ls[t][1] - mx), w2 = __builtin_amdgcn_exp2f(ls[t][2] - mx);
            const float inv = 1.0f / (w0 + w1 + w2); w0 *= inv; w1 *= inv; w2 *= inv;
            float od[16], os[16];
#pragma unroll
            for (int q = 0; q < 2; ++q) { const u32x4 a0 = ra[t][0][q], a1 = ra[t][1][q], a2 = ra[t][2][q], as = ra[t][3][q];
#pragma unroll
                for (int j = 0; j < 4; ++j) {
                    od[8 * q + 2 * j] = w0 * __uint_as_float(a0[j] << 16) + w1 * __uint_as_float(a1[j] << 16) + w2 * __uint_as_float(a2[j] << 16);
                    od[8 * q + 2 * j + 1] = w0 * __uint_as_float(a0[j] & 0xffff0000u) + w1 * __uint_as_float(a1[j] & 0xffff0000u) + w2 * __uint_as_float(a2[j] & 0xffff0000u);
                    os[8 * q + 2 * j] = __uint_as_float(as[j] << 16); os[8 * q + 2 * j + 1] = __uint_as_float(as[j] & 0xffff0000u); } }
            float sd = 0.f, ss = 0.f;
#pragma unroll
            for (int j = 0; j < 16; ++j) { sd += od[j] * od[j]; ss += os[j] * os[j]; }
            const float rd = rsqrtf(wave_sum(sd) * (1.0f / GW) + EPS), rs = rsqrtf(wave_sum(ss) * (1.0f / GW) + EPS);
#pragma unroll
            for (int q = 0; q < 2; ++q) {
                u32x4 wd, wsb;
#pragma unroll
                for (int j = 0; j < 4; ++j) {
                    wd[j] = cvt_pk_bf16(od[8 * q + 2 * j] * rd * gdv[8 * q + 2 * j], od[8 * q + 2 * j + 1] * rd * gdv[8 * q + 2 * j + 1]);
                    wsb[j] = cvt_pk_bf16(os[8 * q + 2 * j] * rs * gsv[8 * q + 2 * j], os[8 * q + 2 * j + 1] * rs * gsv[8 * q + 2 * j + 1]); }
                *(u32x4*)(ACAT + (size_t)tok * D_MODEL + lane * 16 + 8 * q) = wd;
                *(u32x4*)(ACAT + (size_t)tok * D_MODEL + GW + lane * 16 + 8 * q) = wsb;
            } } }
    }
}

constexpr int ATT_NSB = BATCH * NH * 8, ATT_NDA = BATCH * NH * 3 * 8, ATT_NTOT = ATT_NSB + ATT_NDA;
__device__ __forceinline__ int att_grab(const Frame& F, int tid) {
    LAS int* s_item = (LAS int*)(F.lds + LDS_QSLOT);
    __syncthreads();
    if (tid == 0) *s_item = (int)__hip_atomic_fetch_add((unsigned*)(F.ws + WS_CTL) + CW_ATTQ, 1u, __ATOMIC_RELAXED, __HIP_MEMORY_SCOPE_AGENT);
    __syncthreads();
    return __builtin_amdgcn_readfirstlane(*s_item);
}
__device__ __forceinline__ void p2_attention(const Frame& F) {
    unsigned char* ws = F.ws; const int tid = fresh_tid(F.wave);
    const bf16_t* QKV = (const bf16_t*)(ws + WS_QKV);
    const bf16_t *QD = QKV, *KD = QKV + QKV_STRIDE, *VD = QKV + 2 * QKV_STRIDE, *QS = QKV + 3 * QKV_STRIDE, *KS = QKV + 4 * QKV_STRIDE, *VS = QKV + 5 * QKV_STRIDE;
    auto da_of = [](int id) { attn::DaUnit u; const int uid = id - ATT_NSB, pq = uid >> 3, bh = pq / 3; u.ib = uid & 7; u.p = pq % 3; u.b = bh >> 4; u.h = bh & 15; return u; };
    int cur = att_grab(F, tid);
    while (cur < ATT_NSB) {
        const int bh = cur >> 3; attn::sb_unit(F.lds, QS, KS, VS, (bf16_t*)(ws + WS_OSB), bh >> 4, bh & 15, 7 - (cur & 7), tid);
        cur = att_grab(F, tid);
    }
    if (cur < ATT_NTOT) {
        attn::DaRegs R;
        attn::da_load(R, QD, KD, VD, da_of(cur), tid);
        while (cur < ATT_NTOT) {
            const int nxt = att_grab(F, tid);
            const attn::DaUnit u = da_of(cur);
            attn::da_fill(F.lds, R, tid);
            bf16x8 qf[4]; qf[0] = R.qf[0]; qf[1] = R.qf[1]; qf[2] = R.qf[2]; qf[3] = R.qf[3];
            const int tokq = R.tokq, uq = R.uq;
            __syncthreads();
            if (nxt < ATT_NTOT) attn::da_load(R, QD, KD, VD, da_of(nxt), tid);
            attn::da_compute(F.lds, qf, tokq, uq, (bf16_t*)(ws + WS_OP), (float*)(ws + WS_LSE), u.h, u.p, tid);
            __syncthreads();
            cur = nxt;
        }
    }
}

constexpr int RT_RSTD = 0, RT_PART = 256, RT_LG = RT_PART + 8 * 32 * 32 * 4, RT_HIST = RT_LG + 32 * 32 * 4, RT_BASE = RT_HIST + 128, RT_SELE = RT_BASE + 128, RT_SELR = RT_SELE + 512, RT_SELG = RT_SELR + 512;
__device__ __forceinline__ void p5_router(const Frame& F, const Args& a) {
    unsigned char* ws = F.ws; LAS unsigned char* lds = F.lds;
    const int tid = fresh_tid(F.wave), lane = tid & 63, w = F.wave;
    const bf16_t* X1 = (const bf16_t*)(ws + WS_X1); const float* gain = a.in[6]; const float* wrT = (const float*)(ws + WS_WRT); const float* br = a.in[8];
    unsigned char* H2 = ws + WS_H2;
    int* cnt = (int*)(ws + WS_CTL) + CW_CNT; int* list = (int*)(ws + WS_LIST); int* a_exp = (int*)(ws + WS_AEXP); int* a_rank = (int*)(ws + WS_ARANK); float* a_gate = (float*)(ws + WS_AGATE);
    LAS float* s_rstd = (LAS float*)(lds + RT_RSTD); LAS float* s_part = (LAS float*)(lds + RT_PART); LAS float* s_lg = (LAS float*)(lds + RT_LG);
    LAS int* s_hist = (LAS int*)(lds + RT_HIST); LAS int* s_base = (LAS int*)(lds + RT_BASE); LAS int* s_sele = (LAS int*)(lds + RT_SELE); LAS int* s_selr = (LAS int*)(lds + RT_SELR); LAS float* s_selg = (LAS float*)(lds + RT_SELG);
    for (int it = F.vcu; it < NTOK / 32; it += F.G) {
        const int tok0 = it * 32;
        if (tid < 32) s_hist[tid] = 0;
#pragma unroll
        for (int q = 0; q < 4; ++q) {
            const u32x4* xr = (const u32x4*)(X1 + (size_t)(tok0 + 4 * w + q) * D_MODEL) + lane; float s = 0.f;
#pragma unroll
            for (int j = 0; j < 4; ++j) { const u32x4 v = xr[64 * j];
#pragma unroll
                for (int i = 0; i < 4; ++i) { const float lo = __uint_as_float(v[i] << 16), hi = __uint_as_float(v[i] & 0xffff0000u); s += lo * lo + hi * hi; } }
            s = wave_sum(s);
            if (lane == 0) s_rstd[4 * w + q] = rsqrtf(s * (1.0f / D_MODEL) + EPS);
        }
        __syncthreads();
        {
            const int tr = lane & 15, kq = lane >> 4;
            const float r0 = s_rstd[tr], r1 = s_rstd[16 + tr];
            f32x4 acc[2][2];
#pragma unroll
            for (int tt = 0; tt < 2; ++tt)
#pragma unroll
                for (int eh = 0; eh < 2; ++eh) acc[tt][eh] = (f32x4){0.f, 0.f, 0.f, 0.f};
            unsigned ha[4], hb[4];
#pragma unroll 4
            for (int ls = 0; ls < 16; ++ls) {
                const int k = 256 * w + 64 * (ls >> 2) + 16 * kq + 4 * (ls & 3);
                const f32x4 g = *(const f32x4*)(gain + k);
                f32x4 xa, xb;
                { const u32x2 ra = *(const u32x2*)(X1 + (size_t)(tok0 + tr) * D_MODEL + k), rb = *(const u32x2*)(X1 + (size_t)(tok0 + 16 + tr) * D_MODEL + k);
                  xa = (f32x4){__uint_as_float(ra.x << 16), __uint_as_float(ra.x & 0xffff0000u), __uint_as_float(ra.y << 16), __uint_as_float(ra.y & 0xffff0000u)};
                  xb = (f32x4){__uint_as_float(rb.x << 16), __uint_as_float(rb.x & 0xffff0000u), __uint_as_float(rb.y << 16), __uint_as_float(rb.y & 0xffff0000u)}; }
                const f32x4 b0 = *(const f32x4*)(wrT + (size_t)(lane & 15) * D_MODEL + k), b1 = *(const f32x4*)(wrT + (size_t)(16 + (lane & 15)) * D_MODEL + k);
                xa = xa * r0 * g; xb = xb * r1 * g;
                ha[ls & 3] = cvt_pk4_fp8(xa.x, xa.y, xa.z, xa.w); hb[ls & 3] = cvt_pk4_fp8(xb.x, xb.y, xb.z, xb.w);
                if ((ls & 3) == 3) { const int ks = k - 12;
                    *(u32x4*)(H2 + (size_t)(tok0 + tr) * D_MODEL + ks) = (u32x4){ha[0], ha[1], ha[2], ha[3]}; *(u32x4*)(H2 + (size_t)(tok0 + 16 + tr) * D_MODEL + ks) = (u32x4){hb[0], hb[1], hb[2], hb[3]}; }
#pragma unroll
                for (int j = 0; j < 4; ++j) {
                    acc[0][0] = __builtin_amdgcn_mfma_f32_16x16x4f32(xa[j], b0[j], acc[0][0], 0, 0, 0); acc[0][1] = __builtin_amdgcn_mfma_f32_16x16x4f32(xa[j], b1[j], acc[0][1], 0, 0, 0);
                    acc[1][0] = __builtin_amdgcn_mfma_f32_16x16x4f32(xb[j], b0[j], acc[1][0], 0, 0, 0); acc[1][1] = __builtin_amdgcn_mfma_f32_16x16x4f32(xb[j], b1[j], acc[1][1], 0, 0, 0);
                }
            }
#pragma unroll
            for (int tt = 0; tt < 2; ++tt)
#pragma unroll
                for (int eh = 0; eh < 2; ++eh)
#pragma unroll
                    for (int rg = 0; rg < 4; ++rg) s_part[(w * 32 + 16 * tt + 4 * kq + rg) * 32 + 16 * eh + (lane & 15)] = acc[tt][eh][rg];
        }
        __syncthreads();
        { const int t = tid >> 4, e2 = (tid & 15) * 2;
#pragma unroll
          for (int q = 0; q < 2; ++q) { float v = br[e2 + q];
#pragma unroll
              for (int ww = 0; ww < 8; ++ww) v += s_part[(ww * 32 + t) * 32 + e2 + q];
              s_lg[t * 32 + e2 + q] = v; } }
        __syncthreads();
        if (tid < 32) {
            unsigned used = 0u; float val[4]; int idx[4];
#pragma unroll
            for (int k = 0; k < 4; ++k) { int bi = 0; float bv = -INFINITY;
                for (int i = 0; i < 32; ++i) { const float v = s_lg[tid * 32 + i]; if (!((used >> i) & 1u) && v > bv) { bv = v; bi = i; } }
                used |= 1u << bi; idx[k] = bi; val[k] = bv; }
            float ex[4], sm = 0.f;
#pragma unroll
            for (int k = 0; k < 4; ++k) { ex[k] = expf(val[k] - val[0]); sm += ex[k]; }
#pragma unroll
            for (int k = 0; k < 4; ++k) { s_sele[tid * 4 + k] = idx[k]; s_selr[tid * 4 + k] = atomicAdd((int*)&s_hist[idx[k]], 1); s_selg[tid * 4 + k] = ex[k] / sm; }
        }
        __syncthreads();
        if (tid < 32) { const int hcount = s_hist[tid]; s_base[tid] = hcount ? atomicAdd(&cnt[tid], hcount) : 0; }
        __syncthreads();
        if (tid < 128) { const int e = s_sele[tid], rk = s_base[e] + s_selr[tid], aid = tok0 * 4 + tid;
            list[e * NTOK + rk] = aid; a_exp[aid] = e; a_rank[aid] = rk; a_gate[aid] = s_selg[tid]; }
        __syncthreads();
    }
}
constexpr int MOE_TAB_OFF = RING_BYTES + 1024;
__device__ __forceinline__ void moe_table(const Frame& F) {
    LAS int* tab = (LAS int*)(F.lds + MOE_TAB_OFF);
    if (fresh_tid(F.wave) == 0) {
        const int* cnt = (const int*)(F.ws + WS_CTL) + CW_CNT; int rows = 0, blocks = 0;
        for (int e = 0; e < NEXP; ++e) { const int c = __hip_atomic_load(cnt + e, __ATOMIC_RELAXED, __HIP_MEMORY_SCOPE_AGENT), nb = (c + 255) >> 8; tab[e] = c; tab[32 + e] = nb; tab[64 + e] = rows; tab[96 + e] = blocks; rows += nb * 256; blocks += nb; }
        tab[96 + 32] = blocks;
    }
    __syncthreads();
}
__device__ __forceinline__ void p8_final(const Frame& F, const Args& a) {
    unsigned char* ws = F.ws; const LAS int* tab = (const LAS int*)(F.lds + MOE_TAB_OFF);
    const int tid_ = fresh_tid(F.wave), lane = tid_ & 63, wave_ = F.wave;
    const int gw = F.vcu * NWAVES + wave_, NGW = F.G * NWAVES;
    const bf16_t* X1 = (const bf16_t*)(ws + WS_X1); const unsigned char* Y = ws + WS_Y; const float* fg = a.in[15];
    const int* a_exp = (const int*)(ws + WS_AEXP); const int* a_rank = (const int*)(ws + WS_ARANK); const float* a_gate = (const float*)(ws + WS_AGATE);
    for (int tok = gw; tok < NTOK; tok += NGW) {
        const unsigned char* yr[4]; float gt[4];
#pragma unroll
        for (int k = 0; k < 4; ++k) { const int aid = tok * 4 + k; yr[k] = Y + (size_t)(tab[64 + a_exp[aid]] + a_rank[aid]) * D_MODEL; gt[k] = a_gate[aid]; }
        f32x4 v[8]; float s = 0.f;
#pragma unroll
        for (int j = 0; j < 8; ++j) {
            const int c = (lane + 64 * j) * 4; f32x4 y; { const u32x2 rx = *(const u32x2*)(X1 + (size_t)tok * D_MODEL + c); y = (f32x4){__uint_as_float(rx.x << 16), __uint_as_float(rx.x & 0xffff0000u), __uint_as_float(rx.y << 16), __uint_as_float(rx.y & 0xffff0000u)}; }
#pragma unroll
            for (int k = 0; k < 4; ++k) { const unsigned yy = *(const unsigned*)(yr[k] + c);
                const auto lo2 = __builtin_amdgcn_cvt_pk_f32_fp8((int)yy, false), hi2 = __builtin_amdgcn_cvt_pk_f32_fp8((int)yy, true);
                y.x += gt[k] * lo2[0]; y.y += gt[k] * lo2[1]; y.z += gt[k] * hi2[0]; y.w += gt[k] * hi2[1]; }
            v[j] = y; s += (y.x * y.x + y.y * y.y) + (y.z * y.z + y.w * y.w);
        }
        const float rstd = rsqrtf(wave_sum(s) * (1.0f / D_MODEL) + EPS);
#pragma unroll
        for (int j = 0; j < 8; ++j) { const int c = (lane + 64 * j) * 4; const f32x4 g = *(const f32x4*)(fg + c); *(f32x4*)(a.out + (size_t)tok * D_MODEL + c) = v[j] * rstd * g; }
    }
}

__global__ void __launch_bounds__(NWAVES * 64, 2) mk_fwd(Args args) {
    extern __shared__ __attribute__((aligned(16))) unsigned char lds_raw[];
    Frame F;
    F.lds = (LAS unsigned char*)lds_raw; F.wave = __builtin_amdgcn_readfirstlane((int)threadIdx.x >> 6);
    F.G = gridDim.x; { const int bx = blockIdx.x; F.vcu = (F.G % 8 == 0) ? (bx % 8) * (F.G / 8) + bx / 8 : bx; }
    F.ws = args.ws;
    volatile LAS unsigned* MISC = (volatile LAS unsigned*)(F.lds + MISC_OFF);
    for (int u = fresh_tid(F.wave); u < (LDS_BYTES - RING_BYTES) / 4; u += NWAVES * 64) ((LAS unsigned*)(F.lds + RING_BYTES))[u] = 0u;
    __syncthreads();
    const int lo = args.ph_lo, hi = args.ph_hi;
    const bool multi = (hi - lo) > 1;
    XcdBarrier bar; bar.bar = (unsigned*)(F.ws + WS_CTL) + CW_BAR; bar.x = 0; bar.st = nullptr;
    if (multi) bar = xcd_barrier_post((unsigned*)(F.ws + WS_CTL) + CW_BAR, MISC + 8, fresh_tid(F.wave));
#define IN(k) (lo <= (k) && (k) < hi)
#define SEAM(k) do { if (IN(k) && IN((k) + 1)) xcd_barrier(bar, fresh_tid(F.wave)); } while (0)

    const int jx = (int)blockIdx.x >> 3, ncompj = (F.G >> 3) - NCONV / 8;
    const bool conv_role = multi && (F.G % 8 == 0) && (F.G >= 2 * NCONV) && jx >= ncompj;
    const int GC = conv_role || (multi && (F.G % 8 == 0) && (F.G >= 2 * NCONV)) ? ncompj * 8 : F.G;
    const int crank = (GC == F.G) ? (int)blockIdx.x : (jx * 8 + ((int)blockIdx.x & 7));
    unsigned* done1 = (unsigned*)(F.ws + WS_CTL) + CW_DONE1; unsigned* done2 = (unsigned*)(F.ws + WS_CTL) + CW_DONE2;
    if (IN(0)) { p0_prologue(F, args); SEAM(0); }
    if (IN(1)) {
        if (conv_role) conv_items(F, args, done1, (unsigned)GC);
        else {
            pg8::StaticOrder S; S.init(NTOK, INW, D_MODEL * 2, F.ws + WS_WIN, GC, crank, 4);
            pg8::EpiQKV E{(bf16_t*)(F.ws + WS_QKV), (const float*)(F.ws + WS_ROPEC), (const float*)(F.ws + WS_ROPES)};
            pg8::gemm_phase<pg8::EpiQKV, pg8::StaticOrder>(F.lds, F.wave, F.ws + WS_XN, D_MODEL * 2, S, E);
            if (fresh_tid(F.wave) == 0) __hip_atomic_fetch_add(done1, 1u, __ATOMIC_RELAXED, __HIP_MEMORY_SCOPE_AGENT);
        }
        SEAM(1);
    }
    if (IN(2)) {
#pragma unroll 1
        for (int pass = 0; pass < 2; ++pass) {
            if ((pass == 0) == conv_role) conv_items(F, args, nullptr, 0u);
            else p2_attention(F);
        }
        SEAM(2);
    }
    if (IN(3)) { p3_combine(F, args); SEAM(3); }
    if (IN(4)) {
        pg8::StaticOrder S; S.init(NTOK, D_MODEL, D_MODEL * 2, F.ws + WS_WOUT, F.G, (int)blockIdx.x);
        pg8::EpiOut E{args.in[0], (bf16_t*)(F.ws + WS_X1)};
        pg8::gemm_phase<pg8::EpiOut, pg8::StaticOrder>(F.lds, F.wave, F.ws + WS_ACAT, D_MODEL * 2, S, E);
        SEAM(4);
    }
    if (IN(5)) { p5_router(F, args); conv_items(F, args, nullptr, 0u); SEAM(5); }
    if (IN(6)) {
        moe_table(F);
        pg8::GroupedOrder S; S.init((const LAS int*)(F.lds + MOE_TAB_OFF), 16, F.ws + WS_WGU, (size_t)4096 * D_MODEL, D_MODEL, (const int*)(F.ws + WS_LIST), true, F.G, (int)blockIdx.x, (const LAS int*)(F.lds + ROWTAB_OFF));
        S.fill_rowtab((LAS int*)(F.lds + ROWTAB_OFF), fresh_tid(F.wave)); __syncthreads();
        pg8::EpiGateUp E{F.ws + WS_H1, args.in[10], args.in[12]};
        pg8::gemm_phase<pg8::EpiGateUp, pg8::GroupedOrder, true, true>(F.lds, F.wave, F.ws + WS_H2, D_MODEL, S, E);
        SEAM(6);
    }
    if (IN(7)) {
        if (!IN(6)) moe_table(F);
        pg8::GroupedOrder S; S.init((const LAS int*)(F.lds + MOE_TAB_OFF), 8, F.ws + WS_WD, (size_t)D_MODEL * D_MODEL, D_MODEL, nullptr, false, F.G, (int)blockIdx.x, nullptr);
        pg8::EpiDown E{F.ws + WS_Y, args.in[14]};
        pg8::gemm_phase<pg8::EpiDown, pg8::GroupedOrder, true, true>(F.lds, F.wave, F.ws + WS_H1, D_MODEL, S, E);
        SEAM(7);
    }
    if (IN(8)) { if (!IN(6) && !IN(7)) moe_table(F); p8_final(F, args); }

#undef IN
#undef SEAM
}


extern "C" void kernel_launch(void* const* d_in, const int* in_sizes, int n_in, void* d_out, int out_size, void* d_ws, size_t ws_size, hipStream_t stream) {
    static int grid = 0;
    if (grid == 0) {
        int dev = 0, cus = 0;
        if (hipGetDevice(&dev) != hipSuccess || hipDeviceGetAttribute(&cus, hipDeviceAttributeMultiprocessorCount, dev) != hipSuccess) { grid = -1; return; }
        if (hipFuncSetAttribute((const void*)mk_fwd, hipFuncAttributeMaxDynamicSharedMemorySize, LDS_BYTES) != hipSuccess) { fprintf(stderr, "hipFuncSetAttribute failed\n"); grid = -1; return; }
        int per_cu = 0;
        if (hipOccupancyMaxActiveBlocksPerMultiprocessor(&per_cu, (const void*)mk_fwd, NWAVES * 64, LDS_BYTES) != hipSuccess || per_cu < 1) fprintf(stderr, "occupancy query says %d\n", per_cu);
        (void)hipGetLastError();
        grid = cus;
    }
    if (grid < 0) return;
    const float* x = (const float*)d_in[0];
    const float* dil_norm = (const float*)d_in[3]; const float* sb_norm = (const float*)d_in[4]; const float* w_out = (const float*)d_in[5];
    const float* ffn_norm = (const float*)d_in[6]; const float* w_router = (const float*)d_in[7]; const float* b_router = (const float*)d_in[8];
    const float* w_gate = (const float*)d_in[9]; const float* b_gate = (const float*)d_in[10]; const float* w_up = (const float*)d_in[11]; const float* b_up = (const float*)d_in[12];
    const float* w_down = (const float*)d_in[13]; const float* b_down = (const float*)d_in[14]; const float* final_norm = (const float*)d_in[15];
    float* out = (float*)d_out;
    unsigned char* ws = (unsigned char*)d_ws;
    (void)hipMemsetAsync(ws + WS_CTL, 0, CTL_ZERO_BYTES, stream);
    Args a{};
    for (int i = 0; i < 16; ++i) a.in[i] = (const float*)d_in[i];
    a.out = out; a.ws = ws;
    a.ph_lo = 0; a.ph_hi = NPHASE;
    hipLaunchKernelGGL(mk_fwd, dim3(grid), dim3(NWAVES * 64), LDS_BYTES, stream, a);
}
```

```cpp
#include <hip/hip_runtime.h>
#include <cstdio>
#include <cstdint>

constexpr int D_MODEL = 2048, BATCH = 4, SEQ = 2048, NTOK = BATCH * SEQ;
constexpr int HD = 64, NH = 16, GW = 1024, INW = 6144;
constexpr int NEXP = 32, TOPK = 4, NASSIGN = NTOK * TOPK;
constexpr float EPS = 1e-5f;
constexpr float C2 = 0.125f * 1.4426950408889634f;
constexpr float LN2 = 0.6931471805599453f;

#define GAS __attribute__((address_space(1)))
#define LAS __attribute__((address_space(3)))
typedef unsigned short bf16_t;
typedef short bf16x8 __attribute__((ext_vector_type(8)));
typedef float f32x4 __attribute__((ext_vector_type(4)));
typedef unsigned u32x4 __attribute__((ext_vector_type(4)));
typedef unsigned u32x2 __attribute__((ext_vector_type(2)));
typedef GAS unsigned gu32;

constexpr size_t MiB = 1u << 20;
constexpr size_t WS_CTL = 0, CTL_ZERO_BYTES = 1 * MiB;
constexpr size_t WS_LIST = 1 * MiB;
constexpr size_t WS_AEXP = 2 * MiB, WS_ARANK = 2 * MiB + 256 * 1024, WS_AGATE = 2 * MiB + 512 * 1024;
constexpr size_t WS_ROPEC = 3 * MiB, WS_ROPES = 3 * MiB + 256 * 1024, WS_WRT = 3 * MiB + 512 * 1024;
constexpr size_t WS_LSE = 4 * MiB;
constexpr size_t WS_XN = 8 * MiB;
constexpr size_t WS_QKV = 40 * MiB;
constexpr size_t QKV_STRIDE = (size_t)NTOK * GW;
constexpr size_t WS_OP = 136 * MiB;
constexpr size_t WS_OSB = 184 * MiB;
constexpr size_t WS_ACAT = 200 * MiB;
constexpr size_t WS_X1 = 232 * MiB;
constexpr size_t WS_H2 = 296 * MiB;
constexpr size_t WS_H1 = 328 * MiB;
constexpr size_t WS_Y = 488 * MiB;
constexpr size_t WS_WIN = 648 * MiB;
constexpr size_t WS_WOUT = 672 * MiB;
constexpr size_t WS_WGU = 680 * MiB;
constexpr size_t WS_WD = 1192 * MiB;
constexpr size_t WS_END = 1448 * MiB;
constexpr int CW_TMO = 0, CW_CNT = 64  , CW_BAR = 4096;
constexpr int CW_CONVQ = 256  , CW_ATTQ = 320  , CW_DONE1 = 384, CW_DONE2 = 448  ;

__device__ __forceinline__ int lane_id() { int l; asm volatile("v_mbcnt_lo_u32_b32 %0, -1, 0\n\tv_mbcnt_hi_u32_b32 %0, -1, %0" : "=v"(l)); return l; }
__device__ __forceinline__ int fresh_tid(int wave) { int t = wave * 64 + lane_id(); asm volatile("" : "+v"(t)); return t; }
__device__ __forceinline__ float wave_sum(float v) {
#pragma unroll
    for (int o = 1; o < 64; o <<= 1) v += __shfl_xor(v, o);
    return v;
}
__device__ __forceinline__ unsigned cvt_pk_bf16(float lo, float hi) { unsigned r; asm volatile("v_cvt_pk_bf16_f32 %0, %1, %2" : "=v"(r) : "v"(lo), "v"(hi)); return r; }
__device__ __forceinline__ unsigned cvt_pk4_fp8(float a, float b, float c, float d) { int w = 0; w = __builtin_amdgcn_cvt_pk_fp8_f32(a, b, w, false); w = __builtin_amdgcn_cvt_pk_fp8_f32(c, d, w, true); return (unsigned)w; }
constexpr float W8_SCALE = 64.0f, W8_INV = 1.0f / 64.0f;
__device__ __forceinline__ float bf2f(bf16_t b) { return __uint_as_float((unsigned)b << 16); }
__device__ __forceinline__ float block_sum_256(float v, float* sh) {
    v = wave_sum(v);
    const int w = threadIdx.x >> 6;
    __syncthreads();
    if ((threadIdx.x & 63) == 0) sh[w] = v;
    __syncthreads();
    return sh[0] + sh[1] + sh[2] + sh[3];
}
__device__ __forceinline__ float log_sigmoid(float z) { return fminf(z, 0.f) - log1pf(expf(-fabsf(z))); }

#define XB_TMO      128
#define XB_XCNT(j)  (256  + 64 * (j))
#define XB_XSUB(j)  (1280 + 64 * (j))
#define XB_XGEN(j)  (2304 + 64 * (j))
#define XB_TOP      3328
#define XB_TOPGEN   3392
#define XCD_BAR_WORDS 3456
#define XB_SPIN_CAP (1u << 18)
__device__ __forceinline__ unsigned xb_ld(unsigned* p)              { return __hip_atomic_load(p, __ATOMIC_RELAXED, __HIP_MEMORY_SCOPE_AGENT); }
__device__ __forceinline__ unsigned xb_add(unsigned* p, unsigned v) { return __hip_atomic_fetch_add(p, v, __ATOMIC_RELAXED, __HIP_MEMORY_SCOPE_AGENT); }
__device__ __forceinline__ unsigned xb_xcc_id() { return (unsigned)__builtin_amdgcn_s_getreg((3 << 11) | 20) & 0xFu; }
#define XB_SPIN(cond, bar) do { unsigned _sp = 0; while (cond) { __builtin_amdgcn_s_sleep(1); \
    if ((++_sp & 255u) == 0u) { if (xb_ld(&(bar)[XB_TMO])) break; if (_sp > XB_SPIN_CAP) { atomicAdd(&(bar)[XB_TMO], 1u); break; } } } } while (0)
struct XcdBarrier { unsigned* bar; unsigned x; volatile LAS unsigned* st; };
__device__ __forceinline__ XcdBarrier xcd_barrier_post(unsigned* bar, volatile LAS unsigned* st, int tid) {
    XcdBarrier b; b.bar = bar; b.x = xb_xcc_id(); b.st = st;
    if (tid == 0) (void)xb_add(&bar[XB_XCNT(b.x)], 1u);
    return b;
}
__device__ __forceinline__ void xcd_barrier_complete(unsigned* bar, unsigned x, unsigned& nloc, unsigned& nx) {
    const unsigned G = gridDim.x * gridDim.y * gridDim.z;
    unsigned sum, cnt, mine, sp = 0u;
    for (;;) {
        sum = 0u; cnt = 0u; mine = 0u;
#pragma unroll
        for (unsigned j = 0; j < 16; ++j) { const unsigned c = xb_ld(&bar[XB_XCNT(j)]); sum += c; cnt += (c > 0u) ? 1u : 0u; mine = (j == x) ? c : mine; }
        if (sum == G) break;
        __builtin_amdgcn_s_sleep(1);
        if ((++sp & 255u) == 0u) { if (xb_ld(&bar[XB_TMO])) break; if (sp > XB_SPIN_CAP) { atomicAdd(&bar[XB_TMO], 1u); break; } }
    }
    nloc = mine > 0u ? mine : 1u; nx = cnt > 0u ? cnt : 1u;
}
__device__ __forceinline__ void xcd_barrier(const XcdBarrier& b, int tid) {
    asm volatile("s_waitcnt vmcnt(0)" ::: "memory");
    __syncthreads();
    if (tid == 0) {
        unsigned* bar = b.bar;
        __builtin_amdgcn_s_waitcnt(0);
        unsigned nloc = b.st[0], nx = b.st[1];
        if (nloc == 0u) { xcd_barrier_complete(bar, b.x, nloc, nx); b.st[0] = nloc; b.st[1] = nx; }
        const unsigned old = xb_add(&bar[XB_XSUB(b.x)], 1u);
        const unsigned gen = old / nloc;
        if (old + 1u == (gen + 1u) * nloc) {
            __builtin_amdgcn_fence(__ATOMIC_RELEASE, "agent");
            asm volatile("s_waitcnt vmcnt(0)" ::: "memory");
            const unsigned og = xb_add(&bar[XB_TOP], 1u);
            const unsigned tg = og / nx;
            if (og + 1u == (tg + 1u) * nx) xb_add(&bar[XB_TOPGEN], 1u);
            else XB_SPIN(xb_ld(&bar[XB_TOPGEN]) == tg, bar);
            __builtin_amdgcn_fence(__ATOMIC_ACQUIRE, "agent");
            xb_add(&bar[XB_XGEN(b.x)], 1u);
            asm volatile("s_waitcnt vmcnt(0)" ::: "memory");
        } else {
            XB_SPIN(xb_ld(&bar[XB_XGEN(b.x)]) == gen, bar);
            __builtin_amdgcn_fence(__ATOMIC_ACQUIRE, "agent");
            asm volatile("s_waitcnt vmcnt(0)" ::: "memory");
        }
    }
    __syncthreads();
}

__device__ __forceinline__ const char* uniform_ptr(const char* p) {
    const unsigned long long v = (unsigned long long)p;
    const unsigned lo = (unsigned)__builtin_amdgcn_readfirstlane((int)(unsigned)v), hi = (unsigned)__builtin_amdgcn_readfirstlane((int)(unsigned)(v >> 32));
    return (const char*)(((unsigned long long)hi << 32) | lo);
}
namespace pg8 {
constexpr int ROWTAB_UNITS = 10;
constexpr int BM = 256, BK = 64, HALF = 128, HTB = HALF * BK * 2, STAGE_BYTES = 8 * HTB, NXCD = 8, WGM = 8, RING_BYTES_C = 131072;
__host__ __device__ __forceinline__ int lds_byte(int r, int c) { const int st = (r >> 4) * 2 + (c >> 5), rr = r & 15, cc = c & 31, ob = rr * 64 + cc * 2; return st * 1024 + (ob ^ (((ob >> 9) & 1) << 5)); }
__host__ __device__ __forceinline__ void stage_rc(int b, int& R, int& C) { const int st = b / 1024, sb = b % 1024, swz = sb ^ (((sb >> 9) & 1) << 5); R = (st >> 1) * 16 + swz / 64; C = (st & 1) * 32 + (swz % 64) / 2; }
__host__ __device__ __forceinline__ int perm32(int rho) { const int n = rho >> 4, i = rho & 15; return 8 * (i >> 2) + 4 * n + (i & 3); }

struct Unit { int arow0; int nvalid; const char* bptr; int orow0; int pn; int e; int ui; };

struct StaticOrder {
    int nM, nN, nwg, G, c, wgm; const char* Bt; int RB;
    __device__ void init(int M, int N, int RB_, const void* Bt_, int G_, int c_, int wgm_ = WGM) { nM = M / BM; nN = N / BM; nwg = nM * nN; G = G_; c = c_; Bt = (const char*)Bt_; RB = RB_; wgm = wgm_; }
    __device__ bool next(int i, Unit& u) const {
        const int L = i * G + c; if (L >= nwg) return false;
        int wgid = L; { const int q = nwg / NXCD, r = nwg % NXCD, xcd = wgid % NXCD, off = wgid / NXCD; wgid = (xcd < r ? xcd * (q + 1) : r * (q + 1) + (xcd - r) * q) + off; }
        const int nig = wgm * nN, gid = wgid / nig, fm = gid * wgm, gsz = (nM - fm) < wgm ? (nM - fm) : wgm;
        const int pm = fm + ((wgid % nig) % gsz), pn = (wgid % nig) / gsz;
        u.arow0 = pm * BM; u.nvalid = BM; u.bptr = Bt + (size_t)pn * BM * RB; u.orow0 = pm * BM; u.pn = pn; u.e = 0; u.ui = i; return true;
    }
    __device__ __forceinline__ unsigned a_off(const Unit& u, int r) const { return (unsigned)(u.arow0 + r) * (unsigned)RB; }
};

typedef int v8i_t __attribute__((ext_vector_type(8)));
typedef int v4i_t __attribute__((ext_vector_type(4)));
template <class Epi, class Sched, bool ALIGN_EPI = true, bool FP8 = false>
__device__ __forceinline__ void gemm_phase(LAS unsigned char* lds, int wave, const void* Aptr, int RB, const Sched& S, const Epi& E) {
    const int tid = fresh_tid(wave), wid = wave, lane = tid & 63, wr = wid >> 2, wc = wid & 3, fr = lane & 15, fq = lane >> 4;
    const int nt = RB / 128;
    const char* gA = (const char*)Aptr;
    unsigned voffB[2];
#pragma unroll
    for (int i = 0; i < 2; ++i) { int R, C; stage_rc(tid * 16 + i * 8192, R, C); const int Rb = Epi::PERM ? ((R & ~31) + perm32(R & 31)) : R; voffB[i] = (unsigned)(Rb * RB + C * 2); }
    const size_t kstep = (size_t)(BK * 2);
    const size_t hstep = (size_t)HALF * RB;
    const unsigned ldsw = (unsigned)wid * 1024u;
    const int aoff = lds_byte(wr * 64 + fr, fq * 8), boff = lds_byte(wc * 32 + fr, fq * 8);
#define PG8_SA(b, h) (((b) * 2 + (h)) * HTB)
#define PG8_SB(b, h) ((4 + (b) * 2 + (h)) * HTB)
#define PG8_STAGEB(bufoff, gbase, vo) do { const char* _b = (const char*)(gbase); asm volatile("" : "+s"(_b));   _Pragma("unroll") for (int _i = 0; _i < 2; ++_i) \
        __builtin_amdgcn_global_load_lds((const unsigned*)(_b + (vo)[_i]), (LAS unsigned*)(lds + (bufoff) + ldsw + _i * 8192), 16, 0, 0); } while (0)
#define PG8_STAGEA(bufoff, kb, offs) do { const char* _b = gA + (size_t)(kb); asm volatile("" : "+s"(_b)); _Pragma("unroll") for (int _i = 0; _i < 2; ++_i) \
        __builtin_amdgcn_global_load_lds((const unsigned*)(_b + (offs)[_i]), (LAS unsigned*)(lds + (bufoff) + ldsw + _i * 8192), 16, 0, 0); } while (0)
#define PG8_LD8(p) __builtin_shufflevector(*(const LAS v4i_t*)(p), *(const LAS v4i_t*)((p) + 1024), 0, 1, 2, 3, 4, 5, 6, 7)
#define PG8_LDA(dst, b, h) do { _Pragma("unroll") for (int m = 0; m < 4; ++m) dst[m] = PG8_LD8(lds + PG8_SA(b, h) + aoff + m * 2048); } while (0)
#define PG8_LDB(dst, b, h) do { _Pragma("unroll") for (int n = 0; n < 2; ++n) dst[n] = PG8_LD8(lds + PG8_SB(b, h) + boff + n * 2048); } while (0)
#define PG8_LO(v) __builtin_bit_cast(bf16x8, __builtin_shufflevector(v, v, 0, 1, 2, 3))
#define PG8_HI(v) __builtin_bit_cast(bf16x8, __builtin_shufflevector(v, v, 4, 5, 6, 7))
#define PG8_MMA(ai, bj, At, Bt) do { __builtin_amdgcn_s_setprio(1); _Pragma("unroll") for (int m = 0; m < 4; ++m) _Pragma("unroll") for (int n = 0; n < 2; ++n) { \
        if constexpr (FP8) acc[ai][bj][m][n] = __builtin_amdgcn_mfma_scale_f32_16x16x128_f8f6f4(Bt[n], At[m], acc[ai][bj][m][n], 0, 0, 0, 0x7f7f7f7f, 0, 0x7f7f7f7f); \
        else { acc[ai][bj][m][n] = __builtin_amdgcn_mfma_f32_16x16x32_bf16(PG8_LO(Bt[n]), PG8_LO(At[m]), acc[ai][bj][m][n], 0, 0, 0); \
               acc[ai][bj][m][n] = __builtin_amdgcn_mfma_f32_16x16x32_bf16(PG8_HI(Bt[n]), PG8_HI(At[m]), acc[ai][bj][m][n], 0, 0, 0); } } \
        __builtin_amdgcn_s_setprio(0); } while (0)
#define PG8_WAIT_V(n) asm volatile("s_waitcnt vmcnt(" #n ")" ::: "memory")
#define PG8_WAIT_L(n) asm volatile("s_waitcnt lgkmcnt(" #n ")" ::: "memory")
#define PG8_BAR __builtin_amdgcn_s_barrier()
#define PG8_SCHED __builtin_amdgcn_sched_barrier(0)
#define PG8_AOFFS(dst, U) do { const int _t = fresh_tid(wave); _Pragma("unroll") for (int _i = 0; _i < 2; ++_i) { int _R, _C; stage_rc(_t * 16 + _i * 8192, _R, _C); _Pragma("unroll") for (int _h = 0; _h < 2; ++_h) dst[_h][_i] = S.a_off(U, _h * HALF + _R) + (unsigned)(_C * 2); } } while (0)
    Unit cur, nxt; int ui = 0;
    if (!S.next(0, cur)) return;
    f32x4 acc[2][2][4][2];
#pragma unroll
    for (int a = 0; a < 2; ++a)
#pragma unroll
        for (int b = 0; b < 2; ++b)
#pragma unroll
            for (int m = 0; m < 4; ++m)
#pragma unroll
                for (int n = 0; n < 2; ++n) acc[a][b][m][n] = (f32x4){0.f, 0.f, 0.f, 0.f};
    v8i_t At[4], B0[2], B1[2];
    unsigned ua[2][2];
    LAS u32x4* nslot = (LAS u32x4*)(lds + RING_BYTES_C + 4096) + tid;
    PG8_AOFFS(ua, cur);
    const char* cB = uniform_ptr(cur.bptr);
    PG8_STAGEB(PG8_SB(0, 0), cB, voffB); PG8_STAGEB(PG8_SB(0, 1), cB + hstep, voffB); PG8_STAGEA(PG8_SA(0, 0), 0, ua[0]); PG8_STAGEA(PG8_SA(0, 1), 0, ua[1]);
    if (wr == 1) PG8_BAR;
    PG8_WAIT_V(2); PG8_BAR;
    PG8_STAGEB(PG8_SB(1, 0), cB + kstep, voffB); PG8_STAGEA(PG8_SA(1, 0), kstep, ua[0]); PG8_STAGEB(PG8_SB(1, 1), cB + hstep + kstep, voffB);
    PG8_WAIT_V(6); PG8_BAR;
    for (;;) {
        const bool has_next = S.next(ui + 1, nxt);
        {
            unsigned nua[2][2];
            if (has_next) { PG8_AOFFS(nua, nxt); } else {
#pragma unroll
                for (int h = 0; h < 2; ++h)
#pragma unroll
                    for (int i = 0; i < 2; ++i) nua[h][i] = ua[h][i]; }
            *nslot = (u32x4){nua[0][0], nua[0][1], nua[1][0], nua[1][1]};
        }
        const char* nB = uniform_ptr(has_next ? nxt.bptr : cB);
        for (int t = 0; t < nt; t += 2) {
            const bool last = (t == nt - 2);
            const size_t k1 = (size_t)(t + 1) * kstep;
            const size_t k2 = last ? 0 : (size_t)(t + 2) * kstep, k3 = k2 + kstep;
            const char* b2 = last ? nB : cB + (size_t)(t + 2) * kstep; const char* b3 = b2 + kstep;
            asm volatile("" : "+v"(ua[0][0]), "+v"(ua[0][1]), "+v"(ua[1][0]), "+v"(ua[1][1]), "+v"(voffB[0]), "+v"(voffB[1]));
            unsigned a2o[2][2];
#pragma unroll
            for (int h = 0; h < 2; ++h)
#pragma unroll
                for (int i = 0; i < 2; ++i) a2o[h][i] = ua[h][i];
            if (last) { asm volatile("" ::: "memory"); const u32x4 nv = *nslot; a2o[0][0] = nv.x; a2o[0][1] = nv.y; a2o[1][0] = nv.z; a2o[1][1] = nv.w; }
            PG8_LDB(B0, 0, 0); PG8_LDB(B1, 0, 1); PG8_SCHED; PG8_LDA(At, 0, 0); PG8_STAGEA(PG8_SA(1, 1), k1, ua[1]);
            PG8_WAIT_V(8); PG8_WAIT_L(0); PG8_BAR; PG8_MMA(0, 0, At, B0); PG8_MMA(0, 1, At, B1); PG8_BAR; PG8_SCHED;
            PG8_LDA(At, 0, 1); PG8_STAGEB(PG8_SB(0, 0), b2, voffB); PG8_STAGEB(PG8_SB(0, 1), b2 + hstep, voffB); PG8_STAGEA(PG8_SA(0, 0), k2, a2o[0]);
            PG8_WAIT_V(8); PG8_WAIT_L(0); PG8_BAR; PG8_MMA(1, 0, At, B0); PG8_MMA(1, 1, At, B1); PG8_BAR; PG8_SCHED;
            PG8_LDB(B0, 1, 0); PG8_LDB(B1, 1, 1); PG8_SCHED; PG8_LDA(At, 1, 0); PG8_STAGEA(PG8_SA(0, 1), k2, a2o[1]);
            PG8_WAIT_V(8); PG8_WAIT_L(0); PG8_BAR; PG8_MMA(0, 0, At, B0); PG8_MMA(0, 1, At, B1); PG8_BAR; PG8_SCHED;
            PG8_LDA(At, 1, 1); PG8_STAGEB(PG8_SB(1, 0), b3, voffB); PG8_STAGEB(PG8_SB(1, 1), b3 + hstep, voffB); PG8_STAGEA(PG8_SA(1, 0), k3, a2o[0]);
            PG8_WAIT_V(8); PG8_WAIT_L(0); PG8_BAR; PG8_MMA(1, 0, At, B0); PG8_MMA(1, 1, At, B1); PG8_BAR; PG8_SCHED;
        }
        if constexpr (ALIGN_EPI) { if (wr == 0) PG8_BAR; }
        { const int _l = lane_id(); E(acc, cur, wr, wc, _l & 15, _l >> 4); }
        if (!has_next) break;
#pragma unroll
        for (int a = 0; a < 2; ++a)
#pragma unroll
            for (int b = 0; b < 2; ++b)
#pragma unroll
                for (int m = 0; m < 4; ++m)
#pragma unroll
                    for (int n = 0; n < 2; ++n) acc[a][b][m][n] = (f32x4){0.f, 0.f, 0.f, 0.f};
        cur = nxt; cB = nB; ++ui;
        { const u32x4 nv = *nslot; ua[0][0] = nv.x; ua[0][1] = nv.y; ua[1][0] = nv.z; ua[1][1] = nv.w; }
        if constexpr (ALIGN_EPI) { if (wr == 1) PG8_BAR; }
    }
    PG8_WAIT_V(0);
    if constexpr (!ALIGN_EPI) { if (wr == 0) PG8_BAR; }
    PG8_BAR;
#undef PG8_SA
#undef PG8_SB
#undef PG8_STAGEA
#undef PG8_STAGEB
#undef PG8_LDA
#undef PG8_LD8
#undef PG8_LO
#undef PG8_HI
#undef PG8_LDB
#undef PG8_MMA
#undef PG8_WAIT_V
#undef PG8_WAIT_L
#undef PG8_BAR
#undef PG8_SCHED
#undef PG8_AOFFS
}

struct EpiQKV {
    static constexpr bool PERM = true;
    bf16_t* O; const float* ropec; const float* ropes;
    __device__ __forceinline__ void operator()(const f32x4 (&acc)[2][2][4][2], const Unit& u, int wr, int wc, int fr, int fq) const {
        const int t = u.pn >> 2, colt = (u.pn & 3) * BM;
        bf16_t* base = O + (size_t)t * QKV_STRIDE;
        const int row0 = u.orow0 + wr * 64 + fr, col0 = colt + wc * 32 + 8 * fq;
        const float sc = (t == 0 || t == 3) ? C2 : 1.0f;
        const bool rope = t < 2;
        const int fi = 4 * (4 * (wc & 1) + fq);
        f32x4 cs[2][4], sn[2][4];
#pragma unroll
        for (int ai = 0; ai < 2; ++ai)
#pragma unroll
            for (int m = 0; m < 4; ++m) {
                cs[ai][m] = (f32x4){1.f, 1.f, 1.f, 1.f}; sn[ai][m] = (f32x4){0.f, 0.f, 0.f, 0.f};
                if (rope) { const int pos = (row0 + ai * HALF + m * 16) & (SEQ - 1); cs[ai][m] = *(const f32x4*)(ropec + pos * 32 + fi); sn[ai][m] = *(const f32x4*)(ropes + pos * 32 + fi); }
            }
#pragma unroll
        for (int ai = 0; ai < 2; ++ai)
#pragma unroll
            for (int m = 0; m < 4; ++m) {
                const int row = row0 + ai * HALF + m * 16;
                bf16_t* rowp = base + (size_t)row * GW + col0;
#pragma unroll
                for (int bj = 0; bj < 2; ++bj) {
                    const f32x4 x1 = acc[ai][bj][m][0], x2 = acc[ai][bj][m][1];
                    const f32x4 y1 = (x1 * cs[ai][m] - x2 * sn[ai][m]) * sc, y2 = (x2 * cs[ai][m] + x1 * sn[ai][m]) * sc;
                    u32x4 w; w.x = cvt_pk_bf16(y1[0], y1[1]); w.y = cvt_pk_bf16(y1[2], y1[3]); w.z = cvt_pk_bf16(y2[0], y2[1]); w.w = cvt_pk_bf16(y2[2], y2[3]);
                    *(u32x4*)(rowp + bj * HALF) = w;
                }
            }
    }
};

struct GroupedOrder {
    const LAS int* tab; int G, c, NT, total; const char* Bt; size_t bstride; int RB; const int* list; bool gather;
    const LAS int* rowtab;
    mutable int ecur;
    int ibase, iend;
    __device__ void init(const LAS int* tab_, int NT_, const void* Bt_, size_t bstride_bytes, int RB_, const int* list_, bool gather_, int G_, int c_, const LAS int* rowtab_) {
        tab = tab_; NT = NT_; Bt = (const char*)Bt_; bstride = bstride_bytes; RB = RB_; list = list_; gather = gather_; G = G_; c = c_; rowtab = rowtab_; ecur = 0; ibase = 0; iend = 0x7fffffff;
        total = __builtin_amdgcn_readfirstlane(tab_[96 + 32]) * NT_; }
    __device__ bool next(int i_, Unit& u) const {
        const int i = i_ + ibase; if (i >= iend) return false;
        const int L = i * G + c; if (L >= total) return false;
        int wgid = L; { const int q = total / NXCD, r = total % NXCD, xcd = wgid % NXCD, off = wgid / NXCD; wgid = (xcd < r ? xcd * (q + 1) : r * (q + 1) + (xcd - r) * q) + off; }
        int e = ecur;
        while (e + 1 < NEXP && wgid >= __builtin_amdgcn_readfirstlane(tab[96 + e + 1]) * NT) ++e;
        ecur = e;
        const int local = wgid - __builtin_amdgcn_readfirstlane(tab[96 + e]) * NT, nrb = __builtin_amdgcn_readfirstlane(tab[32 + e]);
        const int rb = local % nrb, pn = local / nrb, ps = __builtin_amdgcn_readfirstlane(tab[64 + e]), cn = __builtin_amdgcn_readfirstlane(tab[e]);
        u.e = __builtin_amdgcn_readfirstlane(e); u.pn = __builtin_amdgcn_readfirstlane(pn); u.orow0 = __builtin_amdgcn_readfirstlane(ps + rb * BM); u.arow0 = __builtin_amdgcn_readfirstlane(gather ? (e * NTOK + rb * BM) : (ps + rb * BM));
        u.nvalid = __builtin_amdgcn_readfirstlane(cn - rb * BM); u.bptr = uniform_ptr(Bt + (size_t)u.e * bstride + (size_t)u.pn * BM * RB); u.ui = i;
        return true;
    }
    __device__ __forceinline__ unsigned a_off(const Unit& u, int r) const {
        int row;
        if (gather) { if (u.ui < ROWTAB_UNITS) row = rowtab[u.ui * BM + r]; else { row = 0; if (r < u.nvalid) row = list[u.arow0 + r] >> 2; } } else row = u.arow0 + r;
        return (unsigned)row * (unsigned)RB;
    }
    __device__ __forceinline__ void fill_rowtab(LAS int* wtab, int tid) const {
        if (tid < BM) { Unit u; const int keep = ecur;
            for (int i = 0; i < ROWTAB_UNITS && next(i, u); ++i) wtab[i * BM + tid] = (tid < u.nvalid) ? (list[u.arow0 + tid] >> 2) : 0;
            ecur = keep; }
    }
};
struct EpiGateUp {
    static constexpr bool PERM = true;
    unsigned char* H1; const float* bg; const float* bu;
    __device__ __forceinline__ void operator()(const f32x4 (&acc)[2][2][4][2], const Unit& u, int wr, int wc, int fr, int fq) const {
        const int row0 = u.orow0 + wr * 64 + fr, col0 = u.pn * HALF + wc * 32 + 8 * fq;
        const float* bgp = bg + (size_t)u.e * D_MODEL + col0; const float* bup = bu + (size_t)u.e * D_MODEL + col0;
        f32x4 bgv[2], buv[2];
#pragma unroll
        for (int n = 0; n < 2; ++n) { bgv[n] = *(const f32x4*)(bgp + 4 * n); buv[n] = *(const f32x4*)(bup + 4 * n); }
#pragma unroll
        for (int ai = 0; ai < 2; ++ai)
#pragma unroll
            for (int m = 0; m < 4; ++m) {
                float o[8];
#pragma unroll
                for (int n = 0; n < 2; ++n)
#pragma unroll
                    for (int j = 0; j < 4; ++j) {
                        float g = acc[ai][0][m][n][j] * W8_INV + bgv[n][j], uu = acc[ai][1][m][n][j] * W8_INV + buv[n][j];
                        g = fminf(g, 7.0f); uu = fminf(fmaxf(uu, -7.0f), 7.0f);
                        const float e = __builtin_amdgcn_exp2f(g * (-1.702f * 1.4426950408889634f));
                        o[4 * n + j] = (uu + 1.0f) * (g * __builtin_amdgcn_rcpf(1.0f + e));
                    }
                u32x2 w; w.x = cvt_pk4_fp8(o[0], o[1], o[2], o[3]); w.y = cvt_pk4_fp8(o[4], o[5], o[6], o[7]);
                *(u32x2*)(H1 + (size_t)(row0 + ai * HALF + m * 16) * D_MODEL + col0) = w;
            }
    }
};
struct EpiDown {
    static constexpr bool PERM = true;
    unsigned char* Y; const float* bd;
    __device__ __forceinline__ void operator()(const f32x4 (&acc)[2][2][4][2], const Unit& u, int wr, int wc, int fr, int fq) const {
        const int row0 = u.orow0 + wr * 64 + fr, col0 = u.pn * BM + wc * 32 + 8 * fq;
        const float* bp = bd + (size_t)u.e * D_MODEL + col0;
        f32x4 bv[2][2];
#pragma unroll
        for (int bj = 0; bj < 2; ++bj)
#pragma unroll
            for (int n = 0; n < 2; ++n) bv[bj][n] = *(const f32x4*)(bp + bj * HALF + 4 * n);
#pragma unroll
        for (int ai = 0; ai < 2; ++ai)
#pragma unroll
            for (int m = 0; m < 4; ++m) { unsigned char* rowp = Y + (size_t)(row0 + ai * HALF + m * 16) * D_MODEL + col0;
#pragma unroll
                for (int bj = 0; bj < 2; ++bj) { const f32x4 v0 = acc[ai][bj][m][0] * W8_INV + bv[bj][0], v1 = acc[ai][bj][m][1] * W8_INV + bv[bj][1];
                    u32x2 w; w.x = cvt_pk4_fp8(v0[0], v0[1], v0[2], v0[3]); w.y = cvt_pk4_fp8(v1[0], v1[1], v1[2], v1[3]);
                    *(u32x2*)(rowp + bj * HALF) = w; } }
    }
};
struct EpiOut {
    static constexpr bool PERM = true;
    const float* x; bf16_t* X1;
    __device__ __forceinline__ void operator()(const f32x4 (&acc)[2][2][4][2], const Unit& u, int wr, int wc, int fr, int fq) const {
        const int row0 = u.orow0 + wr * 64 + fr, col0 = u.pn * BM + wc * 32 + 8 * fq;
#pragma unroll
        for (int ai = 0; ai < 2; ++ai) {
            f32x4 xr[4][2][2];
#pragma unroll
            for (int m = 0; m < 4; ++m)
#pragma unroll
                for (int bj = 0; bj < 2; ++bj)
#pragma unroll
                    for (int n = 0; n < 2; ++n) xr[m][bj][n] = *(const f32x4*)(x + (size_t)(row0 + ai * HALF + m * 16) * D_MODEL + col0 + bj * HALF + n * 4);
#pragma unroll
            for (int m = 0; m < 4; ++m)
#pragma unroll
                for (int bj = 0; bj < 2; ++bj) { const f32x4 v0 = xr[m][bj][0] + acc[ai][bj][m][0], v1 = xr[m][bj][1] + acc[ai][bj][m][1];
                    u32x4 w; w.x = cvt_pk_bf16(v0[0], v0[1]); w.y = cvt_pk_bf16(v0[2], v0[3]); w.z = cvt_pk_bf16(v1[0], v1[1]); w.w = cvt_pk_bf16(v1[2], v1[3]);
                    *(u32x4*)(X1 + (size_t)(row0 + ai * HALF + m * 16) * D_MODEL + col0 + bj * HALF) = w; }
        }
    }
};
}

constexpr int NWAVES = 8;
constexpr int RING_BYTES = 131072, MISC_OFF = RING_BYTES + 320, LDS_BYTES = 163840, ROWTAB_OFF = RING_BYTES + 16384;
struct Args { const float* in[16]; float* out; unsigned char* ws; int ph_lo, ph_hi; };
constexpr int NPHASE = 9;
#ifndef NCONV
#define NCONV 128
#endif

struct Frame {
    LAS unsigned char* lds; int vcu, G, wave; unsigned char* ws;
};

template <class RM>
__device__ __forceinline__ void conv_tile(const float* __restrict__ W, int N, bf16_t* __restrict__ Wt, int K, int kb, int nb, int lane, const RM& rm) {
    const int kg = lane & 7, ng = lane >> 3;
    const int k0 = kb * 64 + kg * 8, n0 = nb * 32 + ng * 4;
    f32x4 v[8];
#pragma unroll
    for (int j = 0; j < 8; ++j) v[j] = __builtin_nontemporal_load((const f32x4*)(W + (size_t)(k0 + j) * N + n0));
#pragma unroll
    for (int c = 0; c < 4; ++c) {
        u32x4 o; o.x = cvt_pk_bf16(v[0][c], v[1][c]); o.y = cvt_pk_bf16(v[2][c], v[3][c]); o.z = cvt_pk_bf16(v[4][c], v[5][c]); o.w = cvt_pk_bf16(v[6][c], v[7][c]);
        *(u32x4*)(Wt + (size_t)rm(n0 + c) * K + k0) = o;
    }
}
template <class RM>
__device__ __forceinline__ void conv_tile8(const float* __restrict__ W, int N, unsigned char* __restrict__ Wt, int K, int kb, int nb, int lane, const RM& rm) {
    const int kg = lane & 7, ng = lane >> 3;
    const int k0 = kb * 64 + kg * 8, n0 = nb * 32 + ng * 4;
    f32x4 v[8];
#pragma unroll
    for (int j = 0; j < 8; ++j) v[j] = __builtin_nontemporal_load((const f32x4*)(W + (size_t)(k0 + j) * N + n0)) * W8_SCALE;
#pragma unroll
    for (int c = 0; c < 4; ++c) {
        u32x2 o; o.x = cvt_pk4_fp8(v[0][c], v[1][c], v[2][c], v[3][c]); o.y = cvt_pk4_fp8(v[4][c], v[5][c], v[6][c], v[7][c]);
        *(u32x2*)(Wt + (size_t)rm(n0 + c) * K + k0) = o;
    }
}
struct RmIdent { __device__ __forceinline__ int operator()(int n) const { return n; } };
struct RmWin {
    __device__ __forceinline__ int operator()(int n) const { if (n >= 2048) return n; const int o = n & 63, a = (o & 31) >> 2, j = (o & 3) + ((o >> 5) << 2); return (n & ~63) + 8 * a + j; } };
struct RmGU { int up; __device__ __forceinline__ int operator()(int n) const { return 256 * (n >> 7) + 128 * up + (n & 127); } };

__device__ __forceinline__ void p0_prologue(const Frame& F, const Args& a) {
    unsigned char* ws = F.ws;
    const int tid_ = fresh_tid(F.wave), lane = tid_ & 63, wave_ = F.wave;
    const int gw = F.vcu * NWAVES + wave_, NGW = F.G * NWAVES;
    const float* x = a.in[0]; const float* attn_norm = a.in[1]; const float* w_in = a.in[2]; const float* w_out = a.in[5]; const float* w_router = a.in[7];
    {
        f32x4 gn[8];
#pragma unroll
        for (int j = 0; j < 8; ++j) gn[j] = *((const f32x4*)attn_norm + lane + 64 * j);
        for (int r0 = gw; r0 < NTOK; r0 += NGW * 4) {
            f32x4 v[4][8];
#pragma unroll
            for (int t = 0; t < 4; ++t) { const int r = (r0 + t * NGW < NTOK) ? r0 + t * NGW : r0; const f32x4* xr = (const f32x4*)(x + (size_t)r * D_MODEL) + lane;
#pragma unroll
                for (int j = 0; j < 8; ++j) v[t][j] = xr[64 * j]; }
#pragma unroll
            for (int t = 0; t < 4; ++t) { const int r = r0 + t * NGW; if (r < NTOK) {
                float s = 0.f;
#pragma unroll
                for (int j = 0; j < 8; ++j) s += (v[t][j].x * v[t][j].x + v[t][j].y * v[t][j].y) + (v[t][j].z * v[t][j].z + v[t][j].w * v[t][j].w);
                const float rstd = rsqrtf(wave_sum(s) * (1.f / D_MODEL) + EPS);
                u32x2* o = (u32x2*)((bf16_t*)(ws + WS_XN) + (size_t)r * D_MODEL) + lane;
#pragma unroll
                for (int j = 0; j < 8; ++j) { u32x2 w; w.x = cvt_pk_bf16(v[t][j].x * rstd * gn[j].x, v[t][j].y * rstd * gn[j].y); w.y = cvt_pk_bf16(v[t][j].z * rstd * gn[j].z, v[t][j].w * rstd * gn[j].w); o[64 * j] = w; } } }
        }
    }
    for (int i = gw * 64 + lane; i < SEQ * 32; i += NGW * 64) {
        const int pos = i >> 5, f = i & 31;
        const float inv_freq = 1.0f / powf(10000.0f, (float)f * 2.0f / 64.0f);
        const float ang = (float)pos * inv_freq;
        ((float*)(ws + WS_ROPEC))[i] = cosf(ang); ((float*)(ws + WS_ROPES))[i] = sinf(ang);
    }
    for (int i = gw * 64 + lane; i < NEXP * D_MODEL; i += NGW * 64) { const int e = i >> 11, k = i & 2047; ((float*)(ws + WS_WRT))[i] = w_router[(size_t)k * NEXP + e]; }
    constexpr int T_IN = 32 * 192, T_OUT = 32 * 64, T_E = 32 * 64;
    {
        const int kg = lane & 7, ng = lane >> 3;
        auto tile_of = [&](int it, const float*& W, int& N, bf16_t*& Wt, int& k0, int& n0, bool& win) {
            win = it < T_IN; const int r = win ? it : it - T_IN, nbk = win ? 192 : 64;
            W = win ? w_in : w_out; N = win ? INW : D_MODEL; Wt = (bf16_t*)(ws + (win ? WS_WIN : WS_WOUT)); k0 = (r / nbk) * 64 + kg * 8; n0 = (r % nbk) * 32 + ng * 4; };
        for (int it0 = gw; it0 < T_IN + T_OUT; it0 += NGW * 2) {
            f32x4 v[2][8];
#pragma unroll
            for (int t = 0; t < 2; ++t) { const int it = (it0 + t * NGW < T_IN + T_OUT) ? it0 + t * NGW : it0; const float* W; int N, k0, n0; bf16_t* Wt; bool win; tile_of(it, W, N, Wt, k0, n0, win);
#pragma unroll
                for (int j = 0; j < 8; ++j) v[t][j] = __builtin_nontemporal_load((const f32x4*)(W + (size_t)(k0 + j) * N + n0)); }
#pragma unroll
            for (int t = 0; t < 2; ++t) { const int it = it0 + t * NGW; if (it < T_IN + T_OUT) { const float* W; int N, k0, n0; bf16_t* Wt; bool win; tile_of(it, W, N, Wt, k0, n0, win);
#pragma unroll
                for (int c = 0; c < 4; ++c) {
                    u32x4 o; o.x = cvt_pk_bf16(v[t][0][c], v[t][1][c]); o.y = cvt_pk_bf16(v[t][2][c], v[t][3][c]); o.z = cvt_pk_bf16(v[t][4][c], v[t][5][c]); o.w = cvt_pk_bf16(v[t][6][c], v[t][7][c]);
                    const int n = n0 + c, row = win ? RmWin{}(n) : n;
                    *(u32x4*)(Wt + (size_t)row * D_MODEL + k0) = o; } } }
        }
    }
}

constexpr int CV_T_E = 32 * 64, CV_NTILES = 3 * NEXP * CV_T_E, CV_ITEM_TILES = 64, CV_NITEMS = CV_NTILES / CV_ITEM_TILES;
constexpr int CV_Q1 = 2 * NEXP * 32;
constexpr int LDS_QSLOT = RING_BYTES + 2048;
__device__ __forceinline__ void conv_items(const Frame& F, const Args& a, const unsigned* stop_word, unsigned stop_count, int limit, int nstatic = 0, int base = 0, int stride = 0) {
    unsigned char* ws = F.ws;
    const int tid = fresh_tid(F.wave), lane = tid & 63;
    const float* w_gate = a.in[9]; const float* w_up = a.in[11]; const float* w_down = a.in[13];
    unsigned* qn = (unsigned*)(ws + WS_CTL) + CW_CONVQ;
    LAS int* s_item = (LAS int*)(F.lds + LDS_QSLOT);
    for (int jj = 0;; ++jj) {
        int item;
        if (nstatic > 0) { if (jj >= nstatic) break; item = base + jj * stride; }
        else {
            if (tid == 0) {
                int it = -1;
                const bool stop = stop_word && __hip_atomic_load(stop_word, __ATOMIC_RELAXED, __HIP_MEMORY_SCOPE_AGENT) >= stop_count;
                if (!stop) it = (int)__hip_atomic_fetch_add(qn, 1u, __ATOMIC_RELAXED, __HIP_MEMORY_SCOPE_AGENT);
                *s_item = it;
            }
            __syncthreads();
            item = __builtin_amdgcn_readfirstlane(*s_item);
            __syncthreads();
        }
        if (item < 0 || item >= limit) break;
        const int mat = item / (NEXP * 32), r = item - mat * (NEXP * 32), e = r >> 5, kb = (r >> 1) & 15, nh = r & 1;
        const int kh = F.wave >> 2, wq = F.wave & 3;
        const float* W = (mat == 0 ? w_gate : mat == 1 ? w_up : w_down) + (size_t)e * D_MODEL * D_MODEL;
        const float* s = W + (size_t)(kb * 128 + kh * 64) * D_MODEL + nh * 1024 + wq * 256 + lane * 4;
        unsigned char* dst = ((mat == 2) ? (ws + WS_WD + (size_t)e * D_MODEL * D_MODEL) : (ws + WS_WGU + (size_t)e * 4096 * D_MODEL)) + kb * 128;
        LAS unsigned char* T = F.lds;
        const int nl = wq * 256 + lane * 4, fz = lane & 15;
        constexpr int CVD = 3;
        f32x4 v[CVD][8];
#pragma unroll
        for (int d = 0; d < CVD - 1; ++d)
#pragma unroll
            for (int j = 0; j < 8; ++j) v[d][j] = __builtin_nontemporal_load((const f32x4*)(s + (size_t)(d * 8 + j) * D_MODEL));
#pragma unroll
        for (int st = 0; st < 8; ++st) {
            if (st + CVD - 1 < 8) {
#pragma unroll
                for (int j = 0; j < 8; ++j) v[(st + CVD - 1) % CVD][j] = __builtin_nontemporal_load((const f32x4*)(s + (size_t)((st + CVD - 1) * 8 + j) * D_MODEL)); }
            const f32x4* vv = v[st % CVD];
#pragma unroll
            for (int c = 0; c < 4; ++c) {
                u32x2 o; o.x = cvt_pk4_fp8(vv[0][c] * W8_SCALE, vv[1][c] * W8_SCALE, vv[2][c] * W8_SCALE, vv[3][c] * W8_SCALE); o.y = cvt_pk4_fp8(vv[4][c] * W8_SCALE, vv[5][c] * W8_SCALE, vv[6][c] * W8_SCALE, vv[7][c] * W8_SCALE);
                *(LAS u32x2*)(T + (nl + c) * 128 + (((kh * 8 + st) ^ fz) * 8)) = o;
            }
        }
        __syncthreads();
#pragma unroll
        for (int i = 0; i < 16; ++i) {
            const int id = tid + 512 * i, nn = id >> 3, q = id & 7, f = (nn >> 2) & 15, n = nh * 1024 + nn;
            u32x4 d = *(const LAS u32x4*)(T + nn * 128 + (((2 * q) ^ (f & 14)) * 8));
            if (f & 1) d = (u32x4){d.z, d.w, d.x, d.y};
            const int row = (mat == 2) ? n : (256 * (n >> 7) + 128 * mat + (n & 127));
            __builtin_nontemporal_store(d, (u32x4*)(dst + (size_t)row * D_MODEL + 16 * q));
        }
        __syncthreads();
    }
}

namespace attn {
typedef float f32x16 __attribute__((ext_vector_type(16)));
typedef short s16x4 __attribute__((ext_vector_type(4)));
typedef short v4i16_t __attribute__((ext_vector_type(4)));
#define MFMA32(a, b, c) __builtin_amdgcn_mfma_f32_32x32x16_bf16(a, b, c, 0, 0, 0)
__device__ __forceinline__ int crow(int r, int hi) { return (r & 3) + 8 * (r >> 2) + 4 * hi; }
__device__ __forceinline__ s16x4 vtr(const LAS unsigned char* p) { return __builtin_bit_cast(s16x4, __builtin_amdgcn_ds_read_tr16_b64_v4i16((LAS v4i16_t*)p)); }
__device__ __forceinline__ float xhalf(float v) {
    auto rr = __builtin_amdgcn_permlane32_swap(__float_as_uint(v), __float_as_uint(v), false, false);
    return (lane_id() & 32) ? __uint_as_float(rr[0]) : __uint_as_float(rr[1]);
}
__device__ __forceinline__ bf16x8 pack8(const f32x16& p, int ks) {
    u32x4 w; w.x = cvt_pk_bf16(p[8 * ks + 0], p[8 * ks + 1]); w.y = cvt_pk_bf16(p[8 * ks + 2], p[8 * ks + 3]); w.z = cvt_pk_bf16(p[8 * ks + 4], p[8 * ks + 5]); w.w = cvt_pk_bf16(p[8 * ks + 6], p[8 * ks + 7]);
    return __builtin_bit_cast(bf16x8, w);
}
__device__ __forceinline__ bf16x8 cat44(s16x4 lo, s16x4 hi) { bf16x8 r; r[0] = lo[0]; r[1] = lo[1]; r[2] = lo[2]; r[3] = lo[3]; r[4] = hi[0]; r[5] = hi[1]; r[6] = hi[2]; r[7] = hi[3]; return r; }
__device__ __forceinline__ void store_ot(const f32x16 (&O)[2], float scale, bf16_t* orow, int hi) {
#pragma unroll
    for (int dh = 0; dh < 2; ++dh)
#pragma unroll
        for (int g = 0; g < 4; ++g) { u32x2 w; w.x = cvt_pk_bf16(O[dh][4 * g] * scale, O[dh][4 * g + 1] * scale); w.y = cvt_pk_bf16(O[dh][4 * g + 2] * scale, O[dh][4 * g + 3] * scale);
            *(u32x2*)(orow + 32 * dh + 8 * g + 4 * hi) = w; }
}

constexpr int DA_ROWS = 384, DA_KPL = (DA_ROWS + 1) * 16, DA_VHL = DA_ROWS * 64 + 64, DA_VOFF = 8 * DA_KPL, DA_LDS = DA_VOFF + 2 * DA_VHL;
struct DaUnit { int b, h, p, ib; };
struct DaRegs { u32x4 kv[6], vv[6]; bf16x8 qf[4]; int tokq, uq; };
__device__ __forceinline__ void da_load(DaRegs& R, const bf16_t* __restrict__ QD, const bf16_t* __restrict__ KD, const bf16_t* __restrict__ VD, const DaUnit& u, int tid) {
    const int lane = tid & 63, wid = __builtin_amdgcn_readfirstlane(tid >> 6), r32 = lane & 31, hi = lane >> 5;
    const int lgL = 11 - 2 * u.p, dsh = 2 * u.p, Lm1 = (1 << lgL) - 1, i0 = u.ib * 256;
#pragma unroll
    for (int t = 0; t < 6; ++t) {
        const int idx = tid + 512 * t, j = idx >> 3, c = idx & 7, ip = i0 - 128 + j;
        R.kv[t] = (u32x4){0u, 0u, 0u, 0u}; R.vv[t] = (u32x4){0u, 0u, 0u, 0u};
        if (ip >= 0) { const int pos = ((ip & Lm1) << dsh) + (ip >> lgL); const size_t go = (size_t)(u.b * SEQ + pos) * GW + u.h * 64 + c * 8; R.kv[t] = *(const u32x4*)(KD + go); R.vv[t] = *(const u32x4*)(VD + go); }
    }
    const int iq = i0 + 32 * wid + r32; R.uq = iq & Lm1; R.tokq = u.b * SEQ + (R.uq << dsh) + (iq >> lgL);
#pragma unroll
    for (int d0 = 0; d0 < 4; ++d0) R.qf[d0] = *(const bf16x8*)(QD + (size_t)R.tokq * GW + u.h * 64 + 16 * d0 + 8 * hi);
}
__device__ __forceinline__ void da_fill(LAS unsigned char* lds, const DaRegs& R, int tid) {
#pragma unroll
    for (int t = 0; t < 6; ++t) {
        const int idx = tid + 512 * t, j = idx >> 3, c = idx & 7;
        *(LAS u32x4*)(lds + c * DA_KPL + j * 16) = R.kv[t];
        *(LAS u32x4*)(lds + DA_VOFF + (c >> 2) * DA_VHL + j * 64 + (c & 3) * 16) = R.vv[t];
    }
}
__device__ __forceinline__ void da_compute(const LAS unsigned char* lds, const bf16x8 (&qf)[4], int tokq, int uq, bf16_t* __restrict__ OP, float* __restrict__ LSE, int h, int p, int tid) {
    const int lane = tid & 63, wid = __builtin_amdgcn_readfirstlane(tid >> 6), r32 = lane & 31, hi = lane >> 5;
    f32x16 S[5];
#pragma unroll
    for (int s = 0; s < 5; ++s) {
        S[s] = (f32x16){};
#pragma unroll
        for (int d0 = 0; d0 < 4; ++d0) { const bf16x8 kf = *(const LAS bf16x8*)(lds + (2 * d0 + hi) * DA_KPL + (32 * wid + 32 * s + r32) * 16); S[s] = MFMA32(kf, qf[d0], S[s]); }
    }
    const int lim = uq < 128 ? uq : 128, lv = r32 - 4 * hi;
    float mx = -INFINITY;
#pragma unroll
    for (int s = 0; s < 5; ++s)
#pragma unroll
        for (int r = 0; r < 16; ++r) { const int dist = lv + (128 - 32 * s - ((r & 3) + 8 * (r >> 2))); const bool ok = (dist >= 0) && (dist <= lim); const float v = ok ? S[s][r] : -INFINITY; S[s][r] = v; mx = fmaxf(mx, v); }
    mx = fmaxf(mx, xhalf(mx));
    float l = 0.f;
#pragma unroll
    for (int s = 0; s < 5; ++s)
#pragma unroll
        for (int r = 0; r < 16; ++r) { const float pv = __builtin_amdgcn_exp2f(S[s][r] - mx); S[s][r] = pv; l += pv; }
    l += xhalf(l);
    f32x16 O[2]; O[0] = (f32x16){}; O[1] = (f32x16){};
    const LAS unsigned char* vb = lds + DA_VOFF + (32 * wid + 4 * hi + ((lane & 15) >> 2)) * 64 + ((lane >> 4) & 1) * 32 + (lane & 3) * 8;
#pragma unroll
    for (int s = 0; s < 5; ++s)
#pragma unroll
        for (int ks = 0; ks < 2; ++ks) {
            const bf16x8 pb = pack8(S[s], ks);
#pragma unroll
            for (int dh = 0; dh < 2; ++dh) { const LAS unsigned char* a = vb + dh * DA_VHL + (32 * s + 16 * ks) * 64; O[dh] = MFMA32(cat44(vtr(a), vtr(a + 512)), pb, O[dh]); }
        }
    store_ot(O, 1.0f / l, OP + ((size_t)p * NTOK + tokq) * GW + h * 64, hi);
    if (hi == 0) LSE[((size_t)p * NTOK + tokq) * NH + h] = mx + __builtin_amdgcn_logf(l);
}

constexpr int SB_ROWS = 448, SB_KPL = (SB_ROWS + 1) * 16, SB_VHL = SB_ROWS * 64 + 64, SB_VOFF = 8 * SB_KPL, SB_LDS = SB_VOFF + 2 * SB_VHL, SB_FLAGS = SB_LDS;
static_assert(SB_LDS + 64 <= 131072, "stick-breaking chunk image fits the phase scratch region");
__device__ __forceinline__ void sb_unit(LAS unsigned char* lds, const bf16_t* __restrict__ QS, const bf16_t* __restrict__ KS, const bf16_t* __restrict__ VS, bf16_t* __restrict__ OSB,
                                        int b, int h, int qb, int tid) {
    const int lane = tid & 63, wid = __builtin_amdgcn_readfirstlane(tid >> 6), r32 = lane & 31, hi = lane >> 5;
    const int t0w = 256 * qb + 32 * wid, tq = t0w + r32, tokq = b * SEQ + tq;
    bf16x8 qf[4];
#pragma unroll
    for (int d0 = 0; d0 < 4; ++d0) qf[d0] = *(const bf16x8*)(QS + (size_t)tokq * GW + h * 64 + 16 * d0 + 8 * hi);
    f32x16 O[2]; O[0] = (f32x16){}; O[1] = (f32x16){};
    float C = 0.f;
    bool done = false;
    const int vlane = (4 * hi + ((lane & 15) >> 2)) * 64 + ((lane >> 4) & 1) * 32 + (lane & 3) * 8;
    LAS int* s_need = (LAS int*)(lds + SB_FLAGS);
    int khi = 256 * qb + 255;
    for (;;) {
        const int klo = (khi - (SB_ROWS - 1)) > 0 ? (khi - (SB_ROWS - 1)) : 0, nrows = khi - klo + 1;
        {
            u32x4 kr[7], vr[7];
#pragma unroll
            for (int t = 0; t < 7; ++t) { const int idx = tid + 512 * t, j = idx >> 3, c = idx & 7;
                kr[t] = (u32x4){0u, 0u, 0u, 0u}; vr[t] = (u32x4){0u, 0u, 0u, 0u};
                if (j < nrows) { const size_t go = (size_t)(b * SEQ + klo + j) * GW + h * 64 + c * 8; kr[t] = *(const u32x4*)(KS + go); vr[t] = *(const u32x4*)(VS + go); } }
#pragma unroll
            for (int t = 0; t < 7; ++t) { const int idx = tid + 512 * t, j = idx >> 3, c = idx & 7;
                *(LAS u32x4*)(lds + c * SB_KPL + j * 16) = kr[t]; *(LAS u32x4*)(lds + SB_VOFF + (c >> 2) * SB_VHL + j * 64 + (c & 3) * 16) = vr[t]; }
        }
        __syncthreads();
        if (!done) {
            for (int kt = khi >> 6; kt >= (klo >> 6); --kt) {
                if (64 * kt > t0w + 30) continue;
                const bool diag = (64 * kt + 63 >= t0w);
                const LAS unsigned char* kb = lds + (64 * kt - klo) * 16; const LAS unsigned char* vb = lds + SB_VOFF + (64 * kt - klo) * 64 + vlane;
#pragma unroll
                for (int sub = 1; sub >= 0; --sub) {
                    const int keyb = 64 * kt + 32 * sub;
                    if (keyb > t0w + 30) continue;
                    f32x16 Z = (f32x16){};
#pragma unroll
                    for (int d0 = 0; d0 < 4; ++d0) { const bf16x8 kf = *(const LAS bf16x8*)(kb + (2 * d0 + hi) * SB_KPL + (32 * sub + r32) * 16); Z = MFMA32(kf, qf[d0], Z); }
                    const int kl = keyb + 4 * hi;
                    float sp[16];
#pragma unroll
                    for (int r = 0; r < 16; ++r) { const float e = __builtin_amdgcn_exp2f(Z[r]); float v = __builtin_amdgcn_logf(1.0f + e); if (diag) { const bool ok = (kl + (r & 3) + 8 * (r >> 2)) < tq; v = ok ? v : 0.f; } sp[r] = v; }
                    float own[4], oth[4];
#pragma unroll
                    for (int g = 0; g < 4; ++g) { sp[4 * g + 2] += sp[4 * g + 3]; sp[4 * g + 1] += sp[4 * g + 2]; sp[4 * g] += sp[4 * g + 1]; own[g] = sp[4 * g]; oth[g] = xhalf(own[g]); }
                    float off[4]; float run = C;
#pragma unroll
                    for (int g = 3; g >= 0; --g) { off[g] = run + (hi == 0 ? oth[g] : 0.f); run += own[g] + oth[g]; }
                    C = run;
#pragma unroll
                    for (int r = 0; r < 16; ++r) { float a = __builtin_amdgcn_exp2f(Z[r] - (off[r >> 2] + sp[r])); if (diag) { const bool ok = (kl + (r & 3) + 8 * (r >> 2)) < tq; a = ok ? a : 0.f; } Z[r] = a; }
#pragma unroll
                    for (int ks = 0; ks < 2; ++ks) {
                        const bf16x8 pb = pack8(Z, ks);
#pragma unroll
                        for (int dh = 0; dh < 2; ++dh) { const LAS unsigned char* a = vb + dh * SB_VHL + (32 * sub + 16 * ks) * 64; O[dh] = MFMA32(cat44(vtr(a), vtr(a + 512)), pb, O[dh]); }
                    }
                }
                float cm = C;
#pragma unroll
                for (int o = 1; o < 32; o <<= 1) cm = fminf(cm, __shfl_xor(cm, o));
                if (__builtin_amdgcn_readfirstlane(__float_as_int(cm)) >= __float_as_int(150.0f)) { done = true; break; }
            }
        }
        if (lane == 0) s_need[wid] = (!done && klo > 0) ? 1 : 0;
        __syncthreads();
        int any = 0;
#pragma unroll
        for (int i = 0; i < 8; ++i) any |= s_need[i];
        __syncthreads();
        if (!any) break;
        khi = klo - 1;
    }
    store_ot(O, 1.0f, OSB + (size_t)tokq * GW + h * 64, hi);
}
#undef MFMA32
}

__device__ __forceinline__ void p3_combine(const Frame& F, const Args& a) {
    unsigned char* ws = F.ws;
    const int tid_ = fresh_tid(F.wave), lane = tid_ & 63, wave_ = F.wave;
    const int gw = F.vcu * NWAVES + wave_, NGW = F.G * NWAVES;
    const bf16_t* OP = (const bf16_t*)(ws + WS_OP); const bf16_t* OSB = (const bf16_t*)(ws + WS_OSB); const float* LSE = (const float*)(ws + WS_LSE);
    bf16_t* ACAT = (bf16_t*)(ws + WS_ACAT);
    const float* gd = a.in[3]; const float* gs = a.in[4];
    const int hd = lane >> 2;
    float gdv[16], gsv[16];
#pragma unroll
    for (int j = 0; j < 16; ++j) { gdv[j] = gd[lane * 16 + j]; gsv[j] = gs[lane * 16 + j]; }
    constexpr int TB = 4;
    for (int tok0 = gw; tok0 < NTOK; tok0 += NGW * TB) {
        u32x4 ra[TB][4][2]; float ls[TB][3];
#pragma unroll
        for (int t = 0; t < TB; ++t) { const int tok = tok0 + t * NGW; if (tok < NTOK) {
#pragma unroll
            for (int p = 0; p < 3; ++p) { ls[t][p] = LSE[((size_t)p * NTOK + tok) * NH + hd]; const u32x4* pp = (const u32x4*)(OP + ((size_t)p * NTOK + tok) * GW + lane * 16); ra[t][p][0] = pp[0]; ra[t][p][1] = pp[1]; }
            const u32x4* ps = (const u32x4*)(OSB + (size_t)tok * GW + lane * 16); ra[t][3][0] = ps[0]; ra[t][3][1] = ps[1]; } }
#pragma unroll
        for (int t = 0; t < TB; ++t) { const int tok = tok0 + t * NGW; if (tok < NTOK) {
            const float mx = fmaxf(ls[t][0], fmaxf(ls[t][1], ls[t][2]));
            float w0 = __builtin_amdgcn_exp2f(ls[t][0] - mx), w1 = __builtin_amdgcn_exp2f(ls[t][1] - mx), w2 = __builtin_amdgcn_exp2f(ls[t][2] - mx);
            const float inv = 1.0f / (w0 + w1 + w2); w0 *= inv; w1 *= inv; w2 *= inv;
            float od[16], os[16];
#pragma unroll
            for (int q = 0; q < 2; ++q) { const u32x4 a0 = ra[t][0][q], a1 = ra[t][1][q], a2 = ra[t][2][q], as = ra[t][3][q];
#pragma unroll
                for (int j = 0; j < 4; ++j) {
                    od[8 * q + 2 * j] = w0 * __uint_as_float(a0[j] << 16) + w1 * __uint_as_float(a1[j] << 16) + w2 * __uint_as_float(a2[j] << 16);
                    od[8 * q + 2 * j + 1] = w0 * __uint_as_float(a0[j] & 0xffff0000u) + w1 * __uint_as_float(a1[j] & 0xffff0000u) + w2 * __uint_as_float(a2[j] & 0xffff0000u);
                    os[8 * q + 2 * j] = __uint_as_float(as[j] << 16); os[8 * q + 2 * j + 1] = __uint_as_float(as[j] & 0xffff0000u); } }
            float sd = 0.f, ss = 0.f;
#pragma unroll
            for (int j = 0; j < 16; ++j) { sd += od[j] * od[j]; ss += os[j] * os[j]; }
            const float rd = rsqrtf(wave_sum(sd) * (1.0f / GW) + EPS), rs = rsqrtf(wave_sum(ss) * (1.0f / GW) + EPS);
#pragma unroll
            for (int q = 0; q < 2; ++q) {
                u32x4 wd, wsb;
#pragma unroll
                for (int j = 0; j < 4; ++j) {
                    wd[j] = cvt_pk_bf16(od[8 * q + 2 * j] * rd * gdv[8 * q + 2 * j], od[8 * q + 2 * j + 1] * rd * gdv[8 * q + 2 * j + 1]);
                    wsb[j] = cvt_pk_bf16(os[8 * q + 2 * j] * rs * gsv[8 * q + 2 * j], os[8 * q + 2 * j + 1] * rs * gsv[8 * q + 2 * j + 1]); }
                *(u32x4*)(ACAT + (size_t)tok * D_MODEL + lane * 16 + 8 * q) = wd;
                *(u32x4*)(ACAT + (size_t)tok * D_MODEL + GW + lane * 16 + 8 * q) = wsb;
            } } }
    }
}

constexpr int ATT_NSB = BATCH * NH * 8, ATT_NDA = BATCH * NH * 3 * 8, ATT_NTOT = ATT_NSB + ATT_NDA;
__device__ __forceinline__ int att_grab(const Frame& F, int tid) {
    LAS int* s_item = (LAS int*)(F.lds + LDS_QSLOT);
    __syncthreads();
    if (tid == 0) *s_item = (int)__hip_atomic_fetch_add((unsigned*)(F.ws + WS_CTL) + CW_ATTQ, 1u, __ATOMIC_RELAXED, __HIP_MEMORY_SCOPE_AGENT);
    __syncthreads();
    return __builtin_amdgcn_readfirstlane(*s_item);
}
__device__ __forceinline__ void p2_attention(const Frame& F) {
    unsigned char* ws = F.ws; const int tid = fresh_tid(F.wave);
    const bf16_t* QKV = (const bf16_t*)(ws + WS_QKV);
    const bf16_t *QD = QKV, *KD = QKV + QKV_STRIDE, *VD = QKV + 2 * QKV_STRIDE, *QS = QKV + 3 * QKV_STRIDE, *KS = QKV + 4 * QKV_STRIDE, *VS = QKV + 5 * QKV_STRIDE;
    auto da_of = [](int id) { attn::DaUnit u; const int uid = id - ATT_NSB, pq = uid >> 3, bh = pq / 3; u.ib = uid & 7; u.p = pq % 3; u.b = bh >> 4; u.h = bh & 15; return u; };
    int cur = att_grab(F, tid);
    while (cur < ATT_NSB) {
        const int bh = cur >> 3; attn::sb_unit(F.lds, QS, KS, VS, (bf16_t*)(ws + WS_OSB), bh >> 4, bh & 15, 7 - (cur & 7), tid);
        cur = att_grab(F, tid);
    }
    if (cur < ATT_NTOT) {
        attn::DaRegs R;
        attn::da_load(R, QD, KD, VD, da_of(cur), tid);
        while (cur < ATT_NTOT) {
            const int nxt = att_grab(F, tid);
            const attn::DaUnit u = da_of(cur);
            attn::da_fill(F.lds, R, tid);
            bf16x8 qf[4]; qf[0] = R.qf[0]; qf[1] = R.qf[1]; qf[2] = R.qf[2]; qf[3] = R.qf[3];
            const int tokq = R.tokq, uq = R.uq;
            __syncthreads();
            if (nxt < ATT_NTOT) attn::da_load(R, QD, KD, VD, da_of(nxt), tid);
            attn::da_compute(F.lds, qf, tokq, uq, (bf16_t*)(ws + WS_OP), (float*)(ws + WS_LSE), u.h, u.p, tid);
            __syncthreads();
            cur = nxt;
        }
    }
}

constexpr int RT_RSTD = 0, RT_PART = 256, RT_LG = RT_PART + 8 * 32 * 32 * 4, RT_HIST = RT_LG + 32 * 32 * 4, RT_BASE = RT_HIST + 128, RT_SELE = RT_BASE + 128, RT_SELR = RT_SELE + 512, RT_SELG = RT_SELR + 512;
__device__ __forceinline__ void p5_router(const Frame& F, const Args& a) {
    unsigned char* ws = F.ws; LAS unsigned char* lds = F.lds;
    const int tid = fresh_tid(F.wave), lane = tid & 63, w = F.wave;
    const bf16_t* X1 = (const bf16_t*)(ws + WS_X1); const float* gain = a.in[6]; const float* wrT = (const float*)(ws + WS_WRT); const float* br = a.in[8];
    unsigned char* H2 = ws + WS_H2;
    int* cnt = (int*)(ws + WS_CTL) + CW_CNT; int* list = (int*)(ws + WS_LIST); int* a_exp = (int*)(ws + WS_AEXP); int* a_rank = (int*)(ws + WS_ARANK); float* a_gate = (float*)(ws + WS_AGATE);
    LAS float* s_rstd = (LAS float*)(lds + RT_RSTD); LAS float* s_part = (LAS float*)(lds + RT_PART); LAS float* s_lg = (LAS float*)(lds + RT_LG);
    LAS int* s_hist = (LAS int*)(lds + RT_HIST); LAS int* s_base = (LAS int*)(lds + RT_BASE); LAS int* s_sele = (LAS int*)(lds + RT_SELE); LAS int* s_selr = (LAS int*)(lds + RT_SELR); LAS float* s_selg = (LAS float*)(lds + RT_SELG);
    for (int it = F.vcu; it < NTOK / 32; it += F.G) {
        const int tok0 = it * 32;
        if (tid < 32) s_hist[tid] = 0;
#pragma unroll
        for (int q = 0; q < 4; ++q) {
            const u32x4* xr = (const u32x4*)(X1 + (size_t)(tok0 + 4 * w + q) * D_MODEL) + lane; float s = 0.f;
#pragma unroll
            for (int j = 0; j < 4; ++j) { const u32x4 v = xr[64 * j];
#pragma unroll
                for (int i = 0; i < 4; ++i) { const float lo = __uint_as_float(v[i] << 16), hi = __uint_as_float(v[i] & 0xffff0000u); s += lo * lo + hi * hi; } }
            s = wave_sum(s);
            if (lane == 0) s_rstd[4 * w + q] = rsqrtf(s * (1.0f / D_MODEL) + EPS);
        }
        __syncthreads();
        {
            const int tr = lane & 15, kq = lane >> 4;
            const float r0 = s_rstd[tr], r1 = s_rstd[16 + tr];
            f32x4 acc[2][2];
#pragma unroll
            for (int tt = 0; tt < 2; ++tt)
#pragma unroll
                for (int eh = 0; eh < 2; ++eh) acc[tt][eh] = (f32x4){0.f, 0.f, 0.f, 0.f};
            unsigned ha[4], hb[4];
#pragma unroll 4
            for (int ls = 0; ls < 16; ++ls) {
                const int k = 256 * w + 64 * (ls >> 2) + 16 * kq + 4 * (ls & 3);
                const f32x4 g = *(const f32x4*)(gain + k);
                f32x4 xa, xb;
                { const u32x2 ra = *(const u32x2*)(X1 + (size_t)(tok0 + tr) * D_MODEL + k), rb = *(const u32x2*)(X1 + (size_t)(tok0 + 16 + tr) * D_MODEL + k);
                  xa = (f32x4){__uint_as_float(ra.x << 16), __uint_as_float(ra.x & 0xffff0000u), __uint_as_float(ra.y << 16), __uint_as_float(ra.y & 0xffff0000u)};
                  xb = (f32x4){__uint_as_float(rb.x << 16), __uint_as_float(rb.x & 0xffff0000u), __uint_as_float(rb.y << 16), __uint_as_float(rb.y & 0xffff0000u)}; }
                const f32x4 b0 = *(const f32x4*)(wrT + (size_t)(lane & 15) * D_MODEL + k), b1 = *(const f32x4*)(wrT + (size_t)(16 + (lane & 15)) * D_MODEL + k);
                xa = xa * r0 * g; xb = xb * r1 * g;
                ha[ls & 3] = cvt_pk4_fp8(xa.x, xa.y, xa.z, xa.w); hb[ls & 3] = cvt_pk4_fp8(xb.x, xb.y, xb.z, xb.w);
                if ((ls & 3) == 3) { const int ks = k - 12;
                    *(u32x4*)(H2 + (size_t)(tok0 + tr) * D_MODEL + ks) = (u32x4){ha[0], ha[1], ha[2], ha[3]}; *(u32x4*)(H2 + (size_t)(tok0 + 16 + tr) * D_MODEL + ks) = (u32x4){hb[0], hb[1], hb[2], hb[3]}; }
#pragma unroll
                for (int j = 0; j < 4; ++j) {
                    acc[0][0] = __builtin_amdgcn_mfma_f32_16x16x4f32(xa[j], b0[j], acc[0][0], 0, 0, 0); acc[0][1] = __builtin_amdgcn_mfma_f32_16x16x4f32(xa[j], b1[j], acc[0][1], 0, 0, 0);
                    acc[1][0] = __builtin_amdgcn_mfma_f32_16x16x4f32(xb[j], b0[j], acc[1][0], 0, 0, 0); acc[1][1] = __builtin_amdgcn_mfma_f32_16x16x4f32(xb[j], b1[j], acc[1][1], 0, 0, 0);
                }
            }
#pragma unroll
            for (int tt = 0; tt < 2; ++tt)
#pragma unroll
                for (int eh = 0; eh < 2; ++eh)
#pragma unroll
                    for (int rg = 0; rg < 4; ++rg) s_part[(w * 32 + 16 * tt + 4 * kq + rg) * 32 + 16 * eh + (lane & 15)] = acc[tt][eh][rg];
        }
        __syncthreads();
        { const int t = tid >> 4, e2 = (tid & 15) * 2;
#pragma unroll
          for (int q = 0; q < 2; ++q) { float v = br[e2 + q];
#pragma unroll
              for (int ww = 0; ww < 8; ++ww) v += s_part[(ww * 32 + t) * 32 + e2 + q];
              s_lg[t * 32 + e2 + q] = v; } }
        __syncthreads();
        if (tid < 32) {
            unsigned used = 0u; float val[4]; int idx[4];
#pragma unroll
            for (int k = 0; k < 4; ++k) { int bi = 0; float bv = -INFINITY;
                for (int i = 0; i < 32; ++i) { const float v = s_lg[tid * 32 + i]; if (!((used >> i) & 1u) && v > bv) { bv = v; bi = i; } }
                used |= 1u << bi; idx[k] = bi; val[k] = bv; }
            float ex[4], sm = 0.f;
#pragma unroll
            for (int k = 0; k < 4; ++k) { ex[k] = expf(val[k] - val[0]); sm += ex[k]; }
#pragma unroll
            for (int k = 0; k < 4; ++k) { s_sele[tid * 4 + k] = idx[k]; s_selr[tid * 4 + k] = atomicAdd((int*)&s_hist[idx[k]], 1); s_selg[tid * 4 + k] = ex[k] / sm; }
        }
        __syncthreads();
        if (tid < 32) { const int hcount = s_hist[tid]; s_base[tid] = hcount ? atomicAdd(&cnt[tid], hcount) : 0; }
        __syncthreads();
        if (tid < 128) { const int e = s_sele[tid], rk = s_base[e] + s_selr[tid], aid = tok0 * 4 + tid;
            list[e * NTOK + rk] = aid; a_exp[aid] = e; a_rank[aid] = rk; a_gate[aid] = s_selg[tid]; }
        __syncthreads();
    }
}
constexpr int MOE_TAB_OFF = RING_BYTES + 1024;
__device__ __forceinline__ void moe_table(const Frame& F) {
    LAS int* tab = (LAS int*)(F.lds + MOE_TAB_OFF);
    if (fresh_tid(F.wave) == 0) {
        const int* cnt = (const int*)(F.ws + WS_CTL) + CW_CNT; int rows = 0, blocks = 0;
        for (int e = 0; e < NEXP; ++e) { const int c = __hip_atomic_load(cnt + e, __ATOMIC_RELAXED, __HIP_MEMORY_SCOPE_AGENT), nb = (c + 255) >> 8; tab[e] = c; tab[32 + e] = nb; tab[64 + e] = rows; tab[96 + e] = blocks; rows += nb * 256; blocks += nb; }
        tab[96 + 32] = blocks;
    }
    __syncthreads();
}
__device__ __forceinline__ void p8_final(const Frame& F, const Args& a) {
    unsigned char* ws = F.ws; const LAS int* tab = (const LAS int*)(F.lds + MOE_TAB_OFF);
    const int tid_ = fresh_tid(F.wave), lane = tid_ & 63, wave_ = F.wave;
    const int gw = F.vcu * NWAVES + wave_, NGW = F.G * NWAVES;
    const bf16_t* X1 = (const bf16_t*)(ws + WS_X1); const unsigned char* Y = ws + WS_Y; const float* fg = a.in[15];
    const int* a_exp = (const int*)(ws + WS_AEXP); const int* a_rank = (const int*)(ws + WS_ARANK); const float* a_gate = (const float*)(ws + WS_AGATE);
    for (int tok = gw; tok < NTOK; tok += NGW) {
        const unsigned char* yr[4]; float gt[4];
#pragma unroll
        for (int k = 0; k < 4; ++k) { const int aid = tok * 4 + k; yr[k] = Y + (size_t)(tab[64 + a_exp[aid]] + a_rank[aid]) * D_MODEL; gt[k] = a_gate[aid]; }
        f32x4 v[8]; float s = 0.f;
#pragma unroll
        for (int j = 0; j < 8; ++j) {
            const int c = (lane + 64 * j) * 4; f32x4 y; { const u32x2 rx = *(const u32x2*)(X1 + (size_t)tok * D_MODEL + c); y = (f32x4){__uint_as_float(rx.x << 16), __uint_as_float(rx.x & 0xffff0000u), __uint_as_float(rx.y << 16), __uint_as_float(rx.y & 0xffff0000u)}; }
#pragma unroll
            for (int k = 0; k < 4; ++k) { const unsigned yy = *(const unsigned*)(yr[k] + c);
                const auto lo2 = __builtin_amdgcn_cvt_pk_f32_fp8((int)yy, false), hi2 = __builtin_amdgcn_cvt_pk_f32_fp8((int)yy, true);
                y.x += gt[k] * lo2[0]; y.y += gt[k] * lo2[1]; y.z += gt[k] * hi2[0]; y.w += gt[k] * hi2[1]; }
            v[j] = y; s += (y.x * y.x + y.y * y.y) + (y.z * y.z + y.w * y.w);
        }
        const float rstd = rsqrtf(wave_sum(s) * (1.0f / D_MODEL) + EPS);
#pragma unroll
        for (int j = 0; j < 8; ++j) { const int c = (lane + 64 * j) * 4; const f32x4 g = *(const f32x4*)(fg + c); *(f32x4*)(a.out + (size_t)tok * D_MODEL + c) = v[j] * rstd * g; }
    }
}

__global__ void __launch_bounds__(NWAVES * 64, 2) mk_fwd(Args args) {
    extern __shared__ __attribute__((aligned(16))) unsigned char lds_raw[];
    Frame F;
    F.lds = (LAS unsigned char*)lds_raw; F.wave = __builtin_amdgcn_readfirstlane((int)threadIdx.x >> 6);
    F.G = gridDim.x; { const int bx = blockIdx.x; F.vcu = (F.G % 8 == 0) ? (bx % 8) * (F.G / 8) + bx / 8 : bx; }
    F.ws = args.ws;
    volatile LAS unsigned* MISC = (volatile LAS unsigned*)(F.lds + MISC_OFF);
    for (int u = fresh_tid(F.wave); u < (LDS_BYTES - RING_BYTES) / 4; u += NWAVES * 64) ((LAS unsigned*)(F.lds + RING_BYTES))[u] = 0u;
    __syncthreads();
    const int lo = args.ph_lo, hi = args.ph_hi;
    const bool multi = (hi - lo) > 1;
    XcdBarrier bar; bar.bar = (unsigned*)(F.ws + WS_CTL) + CW_BAR; bar.x = 0; bar.st = nullptr;
    if (multi) bar = xcd_barrier_post((unsigned*)(F.ws + WS_CTL) + CW_BAR, MISC + 8, fresh_tid(F.wave));
#define IN(k) (lo <= (k) && (k) < hi)
#define SEAM(k) do { if (IN(k) && IN((k) + 1)) xcd_barrier(bar, fresh_tid(F.wave)); } while (0)

    const int jx = (int)blockIdx.x >> 3, ncompj = (F.G >> 3) - NCONV / 8;
    const bool conv_role = multi && (F.G % 8 == 0) && (F.G >= 2 * NCONV) && jx >= ncompj;
    const int GC = conv_role || (multi && (F.G % 8 == 0) && (F.G >= 2 * NCONV)) ? ncompj * 8 : F.G;
    const int crank = (GC == F.G) ? (int)blockIdx.x : (jx * 8 + ((int)blockIdx.x & 7));
    unsigned* done1 = (unsigned*)(F.ws + WS_CTL) + CW_DONE1; unsigned* done2 = (unsigned*)(F.ws + WS_CTL) + CW_DONE2;
    if (IN(0)) { p0_prologue(F, args); SEAM(0); }
    if (IN(1)) {
        if (conv_role) conv_items(F, args, done1, (unsigned)GC, CV_Q1);
        else {
            pg8::StaticOrder S; S.init(NTOK, INW, D_MODEL * 2, F.ws + WS_WIN, GC, crank, 4);
            pg8::EpiQKV E{(bf16_t*)(F.ws + WS_QKV), (const float*)(F.ws + WS_ROPEC), (const float*)(F.ws + WS_ROPES)};
            pg8::gemm_phase<pg8::EpiQKV, pg8::StaticOrder>(F.lds, F.wave, F.ws + WS_XN, D_MODEL * 2, S, E);
            if (fresh_tid(F.wave) == 0) __hip_atomic_fetch_add(done1, 1u, __ATOMIC_RELAXED, __HIP_MEMORY_SCOPE_AGENT);
        }
        SEAM(1);
    }
    if (IN(2)) {
#pragma unroll 1
        for (int pass = 0; pass < 2; ++pass) {
            if ((pass == 0) == conv_role) conv_items(F, args, nullptr, 0u, CV_Q1);
            else p2_attention(F);
        }
        SEAM(2);
    }
    if (IN(3)) { p3_combine(F, args); SEAM(3); }
    if (IN(4)) {
        pg8::StaticOrder S; S.init(NTOK, D_MODEL, D_MODEL * 2, F.ws + WS_WOUT, F.G, (int)blockIdx.x);
        pg8::EpiOut E{args.in[0], (bf16_t*)(F.ws + WS_X1)};
        pg8::gemm_phase<pg8::EpiOut, pg8::StaticOrder>(F.lds, F.wave, F.ws + WS_ACAT, D_MODEL * 2, S, E);
        SEAM(4);
    }
    if (IN(5)) { p5_router(F, args); conv_items(F, args, nullptr, 0u, CV_Q1); SEAM(5); }
    if (IN(6)) {
        moe_table(F);
        pg8::GroupedOrder S; S.init((const LAS int*)(F.lds + MOE_TAB_OFF), 16, F.ws + WS_WGU, (size_t)4096 * D_MODEL, D_MODEL, (const int*)(F.ws + WS_LIST), true, F.G, (int)blockIdx.x, (const LAS int*)(F.lds + ROWTAB_OFF));
        S.fill_rowtab((LAS int*)(F.lds + ROWTAB_OFF), fresh_tid(F.wave)); __syncthreads();
        pg8::EpiGateUp E{F.ws + WS_H1, args.in[10], args.in[12]};
        const int brk = ((int)blockIdx.x >> 3) & 7;
        S.ibase = 0; S.iend = brk;
        pg8::gemm_phase<pg8::EpiGateUp, pg8::GroupedOrder, true, true>(F.lds, F.wave, F.ws + WS_H2, D_MODEL, S, E);
        conv_items(F, args, nullptr, 0u, CV_NITEMS, (CV_NITEMS - CV_Q1 + F.G - 1) / F.G, CV_Q1 + (int)blockIdx.x, F.G);
        S.ibase = brk; S.iend = 0x7fffffff;
        pg8::gemm_phase<pg8::EpiGateUp, pg8::GroupedOrder, true, true>(F.lds, F.wave, F.ws + WS_H2, D_MODEL, S, E);
        SEAM(6);
    }
    if (IN(7)) {
        if (!IN(6)) moe_table(F);
        pg8::GroupedOrder S; S.init((const LAS int*)(F.lds + MOE_TAB_OFF), 8, F.ws + WS_WD, (size_t)D_MODEL * D_MODEL, D_MODEL, nullptr, false, F.G, (int)blockIdx.x, nullptr);
        pg8::EpiDown E{F.ws + WS_Y, args.in[14]};
        pg8::gemm_phase<pg8::EpiDown, pg8::GroupedOrder, true, true>(F.lds, F.wave, F.ws + WS_H1, D_MODEL, S, E);
        SEAM(7);
    }
    if (IN(8)) { if (!IN(6) && !IN(7)) moe_table(F); p8_final(F, args); }

#undef IN
#undef SEAM
}


extern "C" void kernel_launch(void* const* d_in, const int* in_sizes, int n_in, void* d_out, int out_size, void* d_ws, size_t ws_size, hipStream_t stream) {
    static int grid = 0;
    if (grid == 0) {
        int dev = 0, cus = 0;
        if (hipGetDevice(&dev) != hipSuccess || hipDeviceGetAttribute(&cus, hipDeviceAttributeMultiprocessorCount, dev) != hipSuccess) { grid = -1; return; }
        if (hipFuncSetAttribute((const void*)mk_fwd, hipFuncAttributeMaxDynamicSharedMemorySize, LDS_BYTES) != hipSuccess) { fprintf(stderr, "hipFuncSetAttribute failed\n"); grid = -1; return; }
        int per_cu = 0;
        if (hipOccupancyMaxActiveBlocksPerMultiprocessor(&per_cu, (const void*)mk_fwd, NWAVES * 64, LDS_BYTES) != hipSuccess || per_cu < 1) fprintf(stderr, "occupancy query says %d\n", per_cu);
        (void)hipGetLastError();
        grid = cus;
    }
    if (grid < 0) return;
    const float* x = (const float*)d_in[0];
    const float* dil_norm = (const float*)d_in[3]; const float* sb_norm = (const float*)d_in[4]; const float* w_out = (const float*)d_in[5];
    const float* ffn_norm = (const float*)d_in[6]; const float* w_router = (const float*)d_in[7]; const float* b_router = (const float*)d_in[8];
    const float* w_gate = (const float*)d_in[9]; const float* b_gate = (const float*)d_in[10]; const float* w_up = (const float*)d_in[11]; const float* b_up = (const float*)d_in[12];
    const float* w_down = (const float*)d_in[13]; const float* b_down = (const float*)d_in[14]; const float* final_norm = (const float*)d_in[15];
    float* out = (float*)d_out;
    unsigned char* ws = (unsigned char*)d_ws;
    (void)hipMemsetAsync(ws + WS_CTL, 0, CTL_ZERO_BYTES, stream);
    Args a{};
    for (int i = 0; i < 16; ++i) a.in[i] = (const float*)d_in[i];
    a.out = out; a.ws = ws;
    a.ph_lo = 0; a.ph_hi = NPHASE;
    hipLaunchKernelGGL(mk_fwd, dim3(grid), dim3(NWAVES * 64), LDS_BYTES, stream, a);
}
```

```cpp
#include <hip/hip_runtime.h>
#include <cstdio>
#include <cstdint>

constexpr int D_MODEL = 2048, BATCH = 4, SEQ = 2048, NTOK = BATCH * SEQ;
constexpr int HD = 64, NH = 16, GW = 1024, INW = 6144;
constexpr int NEXP = 32, TOPK = 4, NASSIGN = NTOK * TOPK;
constexpr float EPS = 1e-5f;
constexpr float C2 = 0.125f * 1.4426950408889634f;
constexpr float LN2 = 0.6931471805599453f;

#define GAS __attribute__((address_space(1)))
#define LAS __attribute__((address_space(3)))
typedef unsigned short bf16_t;
typedef short bf16x8 __attribute__((ext_vector_type(8)));
typedef float f32x4 __attribute__((ext_vector_type(4)));
typedef unsigned u32x4 __attribute__((ext_vector_type(4)));
typedef unsigned u32x2 __attribute__((ext_vector_type(2)));
typedef GAS unsigned gu32;

constexpr size_t MiB = 1u << 20;
constexpr size_t WS_CTL = 0, CTL_ZERO_BYTES = 1 * MiB;
constexpr size_t WS_LIST = 1 * MiB;
constexpr size_t WS_AEXP = 2 * MiB, WS_ARANK = 2 * MiB + 256 * 1024, WS_AGATE = 2 * MiB + 512 * 1024;
constexpr size_t WS_ROPEC = 3 * MiB, WS_ROPES = 3 * MiB + 256 * 1024, WS_WRT = 3 * MiB + 512 * 1024;
constexpr size_t WS_LSE = 4 * MiB;
constexpr size_t WS_XN = 8 * MiB;
constexpr size_t WS_QKV = 40 * MiB;
constexpr size_t QKV_STRIDE = (size_t)NTOK * GW;
constexpr size_t WS_OP = 136 * MiB;
constexpr size_t WS_OSB = 184 * MiB;
constexpr size_t WS_ACAT = 200 * MiB;
constexpr size_t WS_X1 = 232 * MiB;
constexpr size_t WS_H2 = 296 * MiB;
constexpr size_t WS_H1 = 328 * MiB;
constexpr size_t WS_Y = 488 * MiB;
constexpr size_t WS_WIN = 648 * MiB;
constexpr size_t WS_WOUT = 672 * MiB;
constexpr size_t WS_WGU = 680 * MiB;
constexpr size_t WS_WD = 1192 * MiB;
constexpr size_t WS_END = 1448 * MiB;
constexpr int CW_TMO = 0, CW_CNT = 64  , CW_BAR = 4096;
constexpr int CW_CONVQ = 256  , CW_ATTQ = 320  , CW_DONE1 = 384, CW_DONE2 = 448  ;

__device__ __forceinline__ int lane_id() { int l; asm volatile("v_mbcnt_lo_u32_b32 %0, -1, 0\n\tv_mbcnt_hi_u32_b32 %0, -1, %0" : "=v"(l)); return l; }
__device__ __forceinline__ int fresh_tid(int wave) { int t = wave * 64 + lane_id(); asm volatile("" : "+v"(t)); return t; }
__device__ __forceinline__ float wave_sum(float v) {
#pragma unroll
    for (int o = 1; o < 64; o <<= 1) v += __shfl_xor(v, o);
    return v;
}
__device__ __forceinline__ unsigned cvt_pk_bf16(float lo, float hi) { unsigned r; asm volatile("v_cvt_pk_bf16_f32 %0, %1, %2" : "=v"(r) : "v"(lo), "v"(hi)); return r; }
__device__ __forceinline__ unsigned cvt_pk4_fp8(float a, float b, float c, float d) { int w = 0; w = __builtin_amdgcn_cvt_pk_fp8_f32(a, b, w, false); w = __builtin_amdgcn_cvt_pk_fp8_f32(c, d, w, true); return (unsigned)w; }
constexpr float W8_SCALE = 64.0f, W8_INV = 1.0f / 64.0f;
__device__ __forceinline__ float bf2f(bf16_t b) { return __uint_as_float((unsigned)b << 16); }
__device__ __forceinline__ float block_sum_256(float v, float* sh) {
    v = wave_sum(v);
    const int w = threadIdx.x >> 6;
    __syncthreads();
    if ((threadIdx.x & 63) == 0) sh[w] = v;
    __syncthreads();
    return sh[0] + sh[1] + sh[2] + sh[3];
}
__device__ __forceinline__ float log_sigmoid(float z) { return fminf(z, 0.f) - log1pf(expf(-fabsf(z))); }

#define XB_TMO      128
#define XB_XCNT(j)  (256  + 64 * (j))
#define XB_XSUB(j)  (1280 + 64 * (j))
#define XB_XGEN(j)  (2304 + 64 * (j))
#define XB_TOP      3328
#define XB_TOPGEN   3392
#define XCD_BAR_WORDS 3456
#define XB_SPIN_CAP (1u << 18)
__device__ __forceinline__ unsigned xb_ld(unsigned* p)              { return __hip_atomic_load(p, __ATOMIC_RELAXED, __HIP_MEMORY_SCOPE_AGENT); }
__device__ __forceinline__ unsigned xb_add(unsigned* p, unsigned v) { return __hip_atomic_fetch_add(p, v, __ATOMIC_RELAXED, __HIP_MEMORY_SCOPE_AGENT); }
__device__ __forceinline__ unsigned xb_xcc_id() { return (unsigned)__builtin_amdgcn_s_getreg((3 << 11) | 20) & 0xFu; }
#define XB_SPIN(cond, bar) do { unsigned _sp = 0; while (cond) { __builtin_amdgcn_s_sleep(1); \
    if ((++_sp & 255u) == 0u) { if (xb_ld(&(bar)[XB_TMO])) break; if (_sp > XB_SPIN_CAP) { atomicAdd(&(bar)[XB_TMO], 1u); break; } } } } while (0)
struct XcdBarrier { unsigned* bar; unsigned x; volatile LAS unsigned* st; };
__device__ __forceinline__ XcdBarrier xcd_barrier_post(unsigned* bar, volatile LAS unsigned* st, int tid) {
    XcdBarrier b; b.bar = bar; b.x = xb_xcc_id(); b.st = st;
    if (tid == 0) (void)xb_add(&bar[XB_XCNT(b.x)], 1u);
    return b;
}
__device__ __forceinline__ void xcd_barrier_complete(unsigned* bar, unsigned x, unsigned& nloc, unsigned& nx) {
    const unsigned G = gridDim.x * gridDim.y * gridDim.z;
    unsigned sum, cnt, mine, sp = 0u;
    for (;;) {
        sum = 0u; cnt = 0u; mine = 0u;
#pragma unroll
        for (unsigned j = 0; j < 16; ++j) { const unsigned c = xb_ld(&bar[XB_XCNT(j)]); sum += c; cnt += (c > 0u) ? 1u : 0u; mine = (j == x) ? c : mine; }
        if (sum == G) break;
        __builtin_amdgcn_s_sleep(1);
        if ((++sp & 255u) == 0u) { if (xb_ld(&bar[XB_TMO])) break; if (sp > XB_SPIN_CAP) { atomicAdd(&bar[XB_TMO], 1u); break; } }
    }
    nloc = mine > 0u ? mine : 1u; nx = cnt > 0u ? cnt : 1u;
}
__device__ __forceinline__ void xcd_barrier(const XcdBarrier& b, int tid) {
    asm volatile("s_waitcnt vmcnt(0)" ::: "memory");
    __syncthreads();
    if (tid == 0) {
        unsigned* bar = b.bar;
        __builtin_amdgcn_s_waitcnt(0);
        unsigned nloc = b.st[0], nx = b.st[1];
        if (nloc == 0u) { xcd_barrier_complete(bar, b.x, nloc, nx); b.st[0] = nloc; b.st[1] = nx; }
        const unsigned old = xb_add(&bar[XB_XSUB(b.x)], 1u);
        const unsigned gen = old / nloc;
        if (old + 1u == (gen + 1u) * nloc) {
            __builtin_amdgcn_fence(__ATOMIC_RELEASE, "agent");
            asm volatile("s_waitcnt vmcnt(0)" ::: "memory");
            const unsigned og = xb_add(&bar[XB_TOP], 1u);
            const unsigned tg = og / nx;
            if (og + 1u == (tg + 1u) * nx) xb_add(&bar[XB_TOPGEN], 1u);
            else XB_SPIN(xb_ld(&bar[XB_TOPGEN]) == tg, bar);
            __builtin_amdgcn_fence(__ATOMIC_ACQUIRE, "agent");
            xb_add(&bar[XB_XGEN(b.x)], 1u);
            asm volatile("s_waitcnt vmcnt(0)" ::: "memory");
        } else {
            XB_SPIN(xb_ld(&bar[XB_XGEN(b.x)]) == gen, bar);
            __builtin_amdgcn_fence(__ATOMIC_ACQUIRE, "agent");
            asm volatile("s_waitcnt vmcnt(0)" ::: "memory");
        }
    }
    __syncthreads();
}

__device__ __forceinline__ const char* uniform_ptr(const char* p) {
    const unsigned long long v = (unsigned long long)p;
    const unsigned lo = (unsigned)__builtin_amdgcn_readfirstlane((int)(unsigned)v), hi = (unsigned)__builtin_amdgcn_readfirstlane((int)(unsigned)(v >> 32));
    return (const char*)(((unsigned long long)hi << 32) | lo);
}
namespace pg8 {
constexpr int ROWTAB_UNITS = 10;
constexpr int BM = 256, BK = 64, HALF = 128, HTB = HALF * BK * 2, STAGE_BYTES = 8 * HTB, NXCD = 8, WGM = 8, RING_BYTES_C = 131072;
__host__ __device__ __forceinline__ int lds_byte(int r, int c) { const int st = (r >> 4) * 2 + (c >> 5), rr = r & 15, cc = c & 31, ob = rr * 64 + cc * 2; return st * 1024 + (ob ^ (((ob >> 9) & 1) << 5)); }
__host__ __device__ __forceinline__ void stage_rc(int b, int& R, int& C) { const int st = b / 1024, sb = b % 1024, swz = sb ^ (((sb >> 9) & 1) << 5); R = (st >> 1) * 16 + swz / 64; C = (st & 1) * 32 + (swz % 64) / 2; }
__host__ __device__ __forceinline__ int perm32(int rho) { const int n = rho >> 4, i = rho & 15; return 8 * (i >> 2) + 4 * n + (i & 3); }

struct Unit { int arow0; int nvalid; const char* bptr; int orow0; int pn; int e; int ui; };

struct StaticOrder {
    int nM, nN, nwg, G, c, wgm; const char* Bt; int RB;
    __device__ void init(int M, int N, int RB_, const void* Bt_, int G_, int c_, int wgm_ = WGM) { nM = M / BM; nN = N / BM; nwg = nM * nN; G = G_; c = c_; Bt = (const char*)Bt_; RB = RB_; wgm = wgm_; }
    __device__ bool next(int i, Unit& u) const {
        const int L = i * G + c; if (L >= nwg) return false;
        int wgid = L; { const int q = nwg / NXCD, r = nwg % NXCD, xcd = wgid % NXCD, off = wgid / NXCD; wgid = (xcd < r ? xcd * (q + 1) : r * (q + 1) + (xcd - r) * q) + off; }
        const int nig = wgm * nN, gid = wgid / nig, fm = gid * wgm, gsz = (nM - fm) < wgm ? (nM - fm) : wgm;
        const int pm = fm + ((wgid % nig) % gsz), pn = (wgid % nig) / gsz;
        u.arow0 = pm * BM; u.nvalid = BM; u.bptr = Bt + (size_t)pn * BM * RB; u.orow0 = pm * BM; u.pn = pn; u.e = 0; u.ui = i; return true;
    }
    __device__ __forceinline__ unsigned a_off(const Unit& u, int r) const { return (unsigned)(u.arow0 + r) * (unsigned)RB; }
};

typedef int v8i_t __attribute__((ext_vector_type(8)));
typedef int v4i_t __attribute__((ext_vector_type(4)));
template <class Epi, class Sched, bool ALIGN_EPI = true, bool FP8 = false>
__device__ __forceinline__ void gemm_phase(LAS unsigned char* lds, int wave, const void* Aptr, int RB, const Sched& S, const Epi& E) {
    const int tid = fresh_tid(wave), wid = wave, lane = tid & 63, wr = wid >> 2, wc = wid & 3, fr = lane & 15, fq = lane >> 4;
    const int nt = RB / 128;
    const char* gA = (const char*)Aptr;
    unsigned voffB[2];
#pragma unroll
    for (int i = 0; i < 2; ++i) { int R, C; stage_rc(tid * 16 + i * 8192, R, C); const int Rb = Epi::PERM ? ((R & ~31) + perm32(R & 31)) : R; voffB[i] = (unsigned)(Rb * RB + C * 2); }
    const size_t kstep = (size_t)(BK * 2);
    const size_t hstep = (size_t)HALF * RB;
    const unsigned ldsw = (unsigned)wid * 1024u;
    const int aoff = lds_byte(wr * 64 + fr, fq * 8), boff = lds_byte(wc * 32 + fr, fq * 8);
#define PG8_SA(b, h) (((b) * 2 + (h)) * HTB)
#define PG8_SB(b, h) ((4 + (b) * 2 + (h)) * HTB)
#define PG8_STAGEB(bufoff, gbase, vo) do { const char* _b = (const char*)(gbase); asm volatile("" : "+s"(_b));   _Pragma("unroll") for (int _i = 0; _i < 2; ++_i) \
        __builtin_amdgcn_global_load_lds((const unsigned*)(_b + (vo)[_i]), (LAS unsigned*)(lds + (bufoff) + ldsw + _i * 8192), 16, 0, 0); } while (0)
#define PG8_STAGEA(bufoff, kb, offs) do { const char* _b = gA + (size_t)(kb); asm volatile("" : "+s"(_b)); _Pragma("unroll") for (int _i = 0; _i < 2; ++_i) \
        __builtin_amdgcn_global_load_lds((const unsigned*)(_b + (offs)[_i]), (LAS unsigned*)(lds + (bufoff) + ldsw + _i * 8192), 16, 0, 0); } while (0)
#define PG8_LD8(p) __builtin_shufflevector(*(const LAS v4i_t*)(p), *(const LAS v4i_t*)((p) + 1024), 0, 1, 2, 3, 4, 5, 6, 7)
#define PG8_LDA(dst, b, h) do { _Pragma("unroll") for (int m = 0; m < 4; ++m) dst[m] = PG8_LD8(lds + PG8_SA(b, h) + aoff + m * 2048); } while (0)
#define PG8_LDB(dst, b, h) do { _Pragma("unroll") for (int n = 0; n < 2; ++n) dst[n] = PG8_LD8(lds + PG8_SB(b, h) + boff + n * 2048); } while (0)
#define PG8_LO(v) __builtin_bit_cast(bf16x8, __builtin_shufflevector(v, v, 0, 1, 2, 3))
#define PG8_HI(v) __builtin_bit_cast(bf16x8, __builtin_shufflevector(v, v, 4, 5, 6, 7))
#define PG8_MMA(ai, bj, At, Bt) do { __builtin_amdgcn_s_setprio(1); _Pragma("unroll") for (int m = 0; m < 4; ++m) _Pragma("unroll") for (int n = 0; n < 2; ++n) { \
        if constexpr (FP8) acc[ai][bj][m][n] = __builtin_amdgcn_mfma_scale_f32_16x16x128_f8f6f4(Bt[n], At[m], acc[ai][bj][m][n], 0, 0, 0, 0x7f7f7f7f, 0, 0x7f7f7f7f); \
        else { acc[ai][bj][m][n] = __builtin_amdgcn_mfma_f32_16x16x32_bf16(PG8_LO(Bt[n]), PG8_LO(At[m]), acc[ai][bj][m][n], 0, 0, 0); \
               acc[ai][bj][m][n] = __builtin_amdgcn_mfma_f32_16x16x32_bf16(PG8_HI(Bt[n]), PG8_HI(At[m]), acc[ai][bj][m][n], 0, 0, 0); } } \
        __builtin_amdgcn_s_setprio(0); } while (0)
#define PG8_WAIT_V(n) asm volatile("s_waitcnt vmcnt(" #n ")" ::: "memory")
#define PG8_WAIT_L(n) asm volatile("s_waitcnt lgkmcnt(" #n ")" ::: "memory")
#define PG8_BAR __builtin_amdgcn_s_barrier()
#define PG8_SCHED __builtin_amdgcn_sched_barrier(0)
#define PG8_AOFFS(dst, U) do { const int _t = fresh_tid(wave); _Pragma("unroll") for (int _i = 0; _i < 2; ++_i) { int _R, _C; stage_rc(_t * 16 + _i * 8192, _R, _C); _Pragma("unroll") for (int _h = 0; _h < 2; ++_h) dst[_h][_i] = S.a_off(U, _h * HALF + _R) + (unsigned)(_C * 2); } } while (0)
    Unit cur, nxt; int ui = 0;
    if (!S.next(0, cur)) return;
    f32x4 acc[2][2][4][2];
#pragma unroll
    for (int a = 0; a < 2; ++a)
#pragma unroll
        for (int b = 0; b < 2; ++b)
#pragma unroll
            for (int m = 0; m < 4; ++m)
#pragma unroll
                for (int n = 0; n < 2; ++n) acc[a][b][m][n] = (f32x4){0.f, 0.f, 0.f, 0.f};
    v8i_t At[4], B0[2], B1[2];
    unsigned ua[2][2];
    LAS u32x4* nslot = (LAS u32x4*)(lds + RING_BYTES_C + 4096) + tid;
    PG8_AOFFS(ua, cur);
    const char* cB = uniform_ptr(cur.bptr);
    PG8_STAGEB(PG8_SB(0, 0), cB, voffB); PG8_STAGEB(PG8_SB(0, 1), cB + hstep, voffB); PG8_STAGEA(PG8_SA(0, 0), 0, ua[0]); PG8_STAGEA(PG8_SA(0, 1), 0, ua[1]);
    if (wr == 1) PG8_BAR;
    PG8_WAIT_V(2); PG8_BAR;
    PG8_STAGEB(PG8_SB(1, 0), cB + kstep, voffB); PG8_STAGEA(PG8_SA(1, 0), kstep, ua[0]); PG8_STAGEB(PG8_SB(1, 1), cB + hstep + kstep, voffB);
    PG8_WAIT_V(6); PG8_BAR;
    for (;;) {
        const bool has_next = S.next(ui + 1, nxt);
        {
            unsigned nua[2][2];
            if (has_next) { PG8_AOFFS(nua, nxt); } else {
#pragma unroll
                for (int h = 0; h < 2; ++h)
#pragma unroll
                    for (int i = 0; i < 2; ++i) nua[h][i] = ua[h][i]; }
            *nslot = (u32x4){nua[0][0], nua[0][1], nua[1][0], nua[1][1]};
        }
        const char* nB = uniform_ptr(has_next ? nxt.bptr : cB);
        for (int t = 0; t < nt; t += 2) {
            const bool last = (t == nt - 2);
            const size_t k1 = (size_t)(t + 1) * kstep;
            const size_t k2 = last ? 0 : (size_t)(t + 2) * kstep, k3 = k2 + kstep;
            const char* b2 = last ? nB : cB + (size_t)(t + 2) * kstep; const char* b3 = b2 + kstep;
            asm volatile("" : "+v"(ua[0][0]), "+v"(ua[0][1]), "+v"(ua[1][0]), "+v"(ua[1][1]), "+v"(voffB[0]), "+v"(voffB[1]));
            unsigned a2o[2][2];
#pragma unroll
            for (int h = 0; h < 2; ++h)
#pragma unroll
                for (int i = 0; i < 2; ++i) a2o[h][i] = ua[h][i];
            if (last) { asm volatile("" ::: "memory"); const u32x4 nv = *nslot; a2o[0][0] = nv.x; a2o[0][1] = nv.y; a2o[1][0] = nv.z; a2o[1][1] = nv.w; }
            PG8_LDB(B0, 0, 0); PG8_LDB(B1, 0, 1); PG8_SCHED; PG8_LDA(At, 0, 0); PG8_STAGEA(PG8_SA(1, 1), k1, ua[1]);
            PG8_WAIT_V(8); PG8_WAIT_L(0); PG8_BAR; PG8_MMA(0, 0, At, B0); PG8_MMA(0, 1, At, B1); PG8_BAR; PG8_SCHED;
            PG8_LDA(At, 0, 1); PG8_STAGEB(PG8_SB(0, 0), b2, voffB); PG8_STAGEB(PG8_SB(0, 1), b2 + hstep, voffB); PG8_STAGEA(PG8_SA(0, 0), k2, a2o[0]);
            PG8_WAIT_V(8); PG8_WAIT_L(0); PG8_BAR; PG8_MMA(1, 0, At, B0); PG8_MMA(1, 1, At, B1); PG8_BAR; PG8_SCHED;
            PG8_LDB(B0, 1, 0); PG8_LDB(B1, 1, 1); PG8_SCHED; PG8_LDA(At, 1, 0); PG8_STAGEA(PG8_SA(0, 1), k2, a2o[1]);
            PG8_WAIT_V(8); PG8_WAIT_L(0); PG8_BAR; PG8_MMA(0, 0, At, B0); PG8_MMA(0, 1, At, B1); PG8_BAR; PG8_SCHED;
            PG8_LDA(At, 1, 1); PG8_STAGEB(PG8_SB(1, 0), b3, voffB); PG8_STAGEB(PG8_SB(1, 1), b3 + hstep, voffB); PG8_STAGEA(PG8_SA(1, 0), k3, a2o[0]);
            PG8_WAIT_V(8); PG8_WAIT_L(0); PG8_BAR; PG8_MMA(1, 0, At, B0); PG8_MMA(1, 1, At, B1); PG8_BAR; PG8_SCHED;
        }
        if constexpr (ALIGN_EPI) { if (wr == 0) PG8_BAR; }
        { const int _l = lane_id(); E(acc, cur, wr, wc, _l & 15, _l >> 4); }
        if (!has_next) break;
#pragma unroll
        for (int a = 0; a < 2; ++a)
#pragma unroll
            for (int b = 0; b < 2; ++b)
#pragma unroll
                for (int m = 0; m < 4; ++m)
#pragma unroll
                    for (int n = 0; n < 2; ++n) acc[a][b][m][n] = (f32x4){0.f, 0.f, 0.f, 0.f};
        cur = nxt; cB = nB; ++ui;
        { const u32x4 nv = *nslot; ua[0][0] = nv.x; ua[0][1] = nv.y; ua[1][0] = nv.z; ua[1][1] = nv.w; }
        if constexpr (ALIGN_EPI) { if (wr == 1) PG8_BAR; }
    }
    PG8_WAIT_V(0);
    if constexpr (!ALIGN_EPI) { if (wr == 0) PG8_BAR; }
    PG8_BAR;
#undef PG8_SA
#undef PG8_SB
#undef PG8_STAGEA
#undef PG8_STAGEB
#undef PG8_LDA
#undef PG8_LD8
#undef PG8_LO
#undef PG8_HI
#undef PG8_LDB
#undef PG8_MMA
#undef PG8_WAIT_V
#undef PG8_WAIT_L
#undef PG8_BAR
#undef PG8_SCHED
#undef PG8_AOFFS
}

struct EpiQKV {
    static constexpr bool PERM = true;
    bf16_t* O; const float* ropec; const float* ropes;
    __device__ __forceinline__ void operator()(const f32x4 (&acc)[2][2][4][2], const Unit& u, int wr, int wc, int fr, int fq) const {
        const int t = u.pn >> 2, colt = (u.pn & 3) * BM;
        bf16_t* base = O + (size_t)t * QKV_STRIDE;
        const int row0 = u.orow0 + wr * 64 + fr, col0 = colt + wc * 32 + 8 * fq;
        const float sc = (t == 0 || t == 3) ? C2 : 1.0f;
        const bool rope = t < 2;
        const int fi = 4 * (4 * (wc & 1) + fq);
        f32x4 cs[2][4], sn[2][4];
#pragma unroll
        for (int ai = 0; ai < 2; ++ai)
#pragma unroll
            for (int m = 0; m < 4; ++m) {
                cs[ai][m] = (f32x4){1.f, 1.f, 1.f, 1.f}; sn[ai][m] = (f32x4){0.f, 0.f, 0.f, 0.f};
                if (rope) { const int pos = (row0 + ai * HALF + m * 16) & (SEQ - 1); cs[ai][m] = *(const f32x4*)(ropec + pos * 32 + fi); sn[ai][m] = *(const f32x4*)(ropes + pos * 32 + fi); }
            }
#pragma unroll
        for (int ai = 0; ai < 2; ++ai)
#pragma unroll
            for (int m = 0; m < 4; ++m) {
                const int row = row0 + ai * HALF + m * 16;
                bf16_t* rowp = base + (size_t)row * GW + col0;
#pragma unroll
                for (int bj = 0; bj < 2; ++bj) {
                    const f32x4 x1 = acc[ai][bj][m][0], x2 = acc[ai][bj][m][1];
                    const f32x4 y1 = (x1 * cs[ai][m] - x2 * sn[ai][m]) * sc, y2 = (x2 * cs[ai][m] + x1 * sn[ai][m]) * sc;
                    u32x4 w; w.x = cvt_pk_bf16(y1[0], y1[1]); w.y = cvt_pk_bf16(y1[2], y1[3]); w.z = cvt_pk_bf16(y2[0], y2[1]); w.w = cvt_pk_bf16(y2[2], y2[3]);
                    *(u32x4*)(rowp + bj * HALF) = w;
                }
            }
    }
};

struct GroupedOrder {
    const LAS int* tab; int G, c, NT, total; const char* Bt; size_t bstride; int RB; const int* list; bool gather;
    const LAS int* rowtab;
    mutable int ecur;
    int ibase, iend;
    __device__ void init(const LAS int* tab_, int NT_, const void* Bt_, size_t bstride_bytes, int RB_, const int* list_, bool gather_, int G_, int c_, const LAS int* rowtab_) {
        tab = tab_; NT = NT_; Bt = (const char*)Bt_; bstride = bstride_bytes; RB = RB_; list = list_; gather = gather_; G = G_; c = c_; rowtab = rowtab_; ecur = 0; ibase = 0; iend = 0x7fffffff;
        total = __builtin_amdgcn_readfirstlane(tab_[96 + 32]) * NT_; }
    __device__ bool next(int i_, Unit& u) const {
        const int i = i_ + ibase; if (i >= iend) return false;
        const int L = i * G + c; if (L >= total) return false;
        int wgid = L; { const int q = total / NXCD, r = total % NXCD, xcd = wgid % NXCD, off = wgid / NXCD; wgid = (xcd < r ? xcd * (q + 1) : r * (q + 1) + (xcd - r) * q) + off; }
        int e = ecur;
        while (e + 1 < NEXP && wgid >= __builtin_amdgcn_readfirstlane(tab[96 + e + 1]) * NT) ++e;
        ecur = e;
        const int local = wgid - __builtin_amdgcn_readfirstlane(tab[96 + e]) * NT, nrb = __builtin_amdgcn_readfirstlane(tab[32 + e]);
        const int rb = local % nrb, pn = local / nrb, ps = __builtin_amdgcn_readfirstlane(tab[64 + e]), cn = __builtin_amdgcn_readfirstlane(tab[e]);
        u.e = __builtin_amdgcn_readfirstlane(e); u.pn = __builtin_amdgcn_readfirstlane(pn); u.orow0 = __builtin_amdgcn_readfirstlane(ps + rb * BM); u.arow0 = __builtin_amdgcn_readfirstlane(gather ? (e * NTOK + rb * BM) : (ps + rb * BM));
        u.nvalid = __builtin_amdgcn_readfirstlane(cn - rb * BM); u.bptr = uniform_ptr(Bt + (size_t)u.e * bstride + (size_t)u.pn * BM * RB); u.ui = i;
        return true;
    }
    __device__ __forceinline__ unsigned a_off(const Unit& u, int r) const {
        int row;
        if (gather) { if (u.ui < ROWTAB_UNITS) row = rowtab[u.ui * BM + r]; else { row = 0; if (r < u.nvalid) row = list[u.arow0 + r] >> 2; } } else row = u.arow0 + r;
        return (unsigned)row * (unsigned)RB;
    }
    __device__ __forceinline__ void fill_rowtab(LAS int* wtab, int tid) const {
        if (tid < BM) { Unit u; const int keep = ecur;
            for (int i = 0; i < ROWTAB_UNITS && next(i, u); ++i) wtab[i * BM + tid] = (tid < u.nvalid) ? (list[u.arow0 + tid] >> 2) : 0;
            ecur = keep; }
    }
};
struct EpiGateUp {
    static constexpr bool PERM = true;
    unsigned char* H1; const float* bg; const float* bu;
    __device__ __forceinline__ void operator()(const f32x4 (&acc)[2][2][4][2], const Unit& u, int wr, int wc, int fr, int fq) const {
        const int row0 = u.orow0 + wr * 64 + fr, col0 = u.pn * HALF + wc * 32 + 8 * fq;
        const float* bgp = bg + (size_t)u.e * D_MODEL + col0; const float* bup = bu + (size_t)u.e * D_MODEL + col0;
        f32x4 bgv[2], buv[2];
#pragma unroll
        for (int n = 0; n < 2; ++n) { bgv[n] = *(const f32x4*)(bgp + 4 * n); buv[n] = *(const f32x4*)(bup + 4 * n); }
#pragma unroll
        for (int ai = 0; ai < 2; ++ai)
#pragma unroll
            for (int m = 0; m < 4; ++m) {
                float o[8];
#pragma unroll
                for (int n = 0; n < 2; ++n)
#pragma unroll
                    for (int j = 0; j < 4; ++j) {
                        float g = acc[ai][0][m][n][j] * W8_INV + bgv[n][j], uu = acc[ai][1][m][n][j] * W8_INV + buv[n][j];
                        g = fminf(g, 7.0f); uu = fminf(fmaxf(uu, -7.0f), 7.0f);
                        const float e = __builtin_amdgcn_exp2f(g * (-1.702f * 1.4426950408889634f));
                        o[4 * n + j] = (uu + 1.0f) * (g * __builtin_amdgcn_rcpf(1.0f + e));
                    }
                u32x2 w; w.x = cvt_pk4_fp8(o[0], o[1], o[2], o[3]); w.y = cvt_pk4_fp8(o[4], o[5], o[6], o[7]);
                *(u32x2*)(H1 + (size_t)(row0 + ai * HALF + m * 16) * D_MODEL + col0) = w;
            }
    }
};
struct EpiDown {
    static constexpr bool PERM = true;
    unsigned char* Y; const float* bd;
    __device__ __forceinline__ void operator()(const f32x4 (&acc)[2][2][4][2], const Unit& u, int wr, int wc, int fr, int fq) const {
        const int row0 = u.orow0 + wr * 64 + fr, col0 = u.pn * BM + wc * 32 + 8 * fq;
        const float* bp = bd + (size_t)u.e * D_MODEL + col0;
        f32x4 bv[2][2];
#pragma unroll
        for (int bj = 0; bj < 2; ++bj)
#pragma unroll
            for (int n = 0; n < 2; ++n) bv[bj][n] = *(const f32x4*)(bp + bj * HALF + 4 * n);
#pragma unroll
        for (int ai = 0; ai < 2; ++ai)
#pragma unroll
            for (int m = 0; m < 4; ++m) { unsigned char* rowp = Y + (size_t)(row0 + ai * HALF + m * 16) * D_MODEL + col0;
#pragma unroll
                for (int bj = 0; bj < 2; ++bj) { const f32x4 v0 = acc[ai][bj][m][0] * W8_INV + bv[bj][0], v1 = acc[ai][bj][m][1] * W8_INV + bv[bj][1];
                    u32x2 w; w.x = cvt_pk4_fp8(v0[0], v0[1], v0[2], v0[3]); w.y = cvt_pk4_fp8(v1[0], v1[1], v1[2], v1[3]);
                    *(u32x2*)(rowp + bj * HALF) = w; } }
    }
};
struct EpiOut {
    static constexpr bool PERM = true;
    const float* x; bf16_t* X1;
    __device__ __forceinline__ void operator()(const f32x4 (&acc)[2][2][4][2], const Unit& u, int wr, int wc, int fr, int fq) const {
        const int row0 = u.orow0 + wr * 64 + fr, col0 = u.pn * BM + wc * 32 + 8 * fq;
#pragma unroll
        for (int ai = 0; ai < 2; ++ai) {
            f32x4 xr[4][2][2];
#pragma unroll
            for (int m = 0; m < 4; ++m)
#pragma unroll
                for (int bj = 0; bj < 2; ++bj)
#pragma unroll
                    for (int n = 0; n < 2; ++n) xr[m][bj][n] = *(const f32x4*)(x + (size_t)(row0 + ai * HALF + m * 16) * D_MODEL + col0 + bj * HALF + n * 4);
#pragma unroll
            for (int m = 0; m < 4; ++m)
#pragma unroll
                for (int bj = 0; bj < 2; ++bj) { const f32x4 v0 = xr[m][bj][0] + acc[ai][bj][m][0], v1 = xr[m][bj][1] + acc[ai][bj][m][1];
                    u32x4 w; w.x = cvt_pk_bf16(v0[0], v0[1]); w.y = cvt_pk_bf16(v0[2], v0[3]); w.z = cvt_pk_bf16(v1[0], v1[1]); w.w = cvt_pk_bf16(v1[2], v1[3]);
                    *(u32x4*)(X1 + (size_t)(row0 + ai * HALF + m * 16) * D_MODEL + col0 + bj * HALF) = w; }
        }
    }
};
}

constexpr int NWAVES = 8;
constexpr int RING_BYTES = 131072, MISC_OFF = RING_BYTES + 320, LDS_BYTES = 163840, ROWTAB_OFF = RING_BYTES + 16384;
struct Args { const float* in[16]; float* out; unsigned char* ws; int ph_lo, ph_hi; };
constexpr int NPHASE = 9;
#ifndef NCONV
#define NCONV 128
#endif

struct Frame {
    LAS unsigned char* lds; int vcu, G, wave; unsigned char* ws;
};

template <class RM>
__device__ __forceinline__ void conv_tile(const float* __restrict__ W, int N, bf16_t* __restrict__ Wt, int K, int kb, int nb, int lane, const RM& rm) {
    const int kg = lane & 7, ng = lane >> 3;
    const int k0 = kb * 64 + kg * 8, n0 = nb * 32 + ng * 4;
    f32x4 v[8];
#pragma unroll
    for (int j = 0; j < 8; ++j) v[j] = __builtin_nontemporal_load((const f32x4*)(W + (size_t)(k0 + j) * N + n0));
#pragma unroll
    for (int c = 0; c < 4; ++c) {
        u32x4 o; o.x = cvt_pk_bf16(v[0][c], v[1][c]); o.y = cvt_pk_bf16(v[2][c], v[3][c]); o.z = cvt_pk_bf16(v[4][c], v[5][c]); o.w = cvt_pk_bf16(v[6][c], v[7][c]);
        *(u32x4*)(Wt + (size_t)rm(n0 + c) * K + k0) = o;
    }
}
template <class RM>
__device__ __forceinline__ void conv_tile8(const float* __restrict__ W, int N, unsigned char* __restrict__ Wt, int K, int kb, int nb, int lane, const RM& rm) {
    const int kg = lane & 7, ng = lane >> 3;
    const int k0 = kb * 64 + kg * 8, n0 = nb * 32 + ng * 4;
    f32x4 v[8];
#pragma unroll
    for (int j = 0; j < 8; ++j) v[j] = __builtin_nontemporal_load((const f32x4*)(W + (size_t)(k0 + j) * N + n0)) * W8_SCALE;
#pragma unroll
    for (int c = 0; c < 4; ++c) {
        u32x2 o; o.x = cvt_pk4_fp8(v[0][c], v[1][c], v[2][c], v[3][c]); o.y = cvt_pk4_fp8(v[4][c], v[5][c], v[6][c], v[7][c]);
        *(u32x2*)(Wt + (size_t)rm(n0 + c) * K + k0) = o;
    }
}
struct RmIdent { __device__ __forceinline__ int operator()(int n) const { return n; } };
struct RmWin {
    __device__ __forceinline__ int operator()(int n) const { if (n >= 2048) return n; const int o = n & 63, a = (o & 31) >> 2, j = (o & 3) + ((o >> 5) << 2); return (n & ~63) + 8 * a + j; } };
struct RmGU { int up; __device__ __forceinline__ int operator()(int n) const { return 256 * (n >> 7) + 128 * up + (n & 127); } };

__device__ __forceinline__ void p0_prologue(const Frame& F, const Args& a) {
    unsigned char* ws = F.ws;
    const int tid_ = fresh_tid(F.wave), lane = tid_ & 63, wave_ = F.wave;
    const int gw = F.vcu * NWAVES + wave_, NGW = F.G * NWAVES;
    const float* x = a.in[0]; const float* attn_norm = a.in[1]; const float* w_in = a.in[2]; const float* w_out = a.in[5]; const float* w_router = a.in[7];
    {
        f32x4 gn[8];
#pragma unroll
        for (int j = 0; j < 8; ++j) gn[j] = *((const f32x4*)attn_norm + lane + 64 * j);
        for (int r0 = gw; r0 < NTOK; r0 += NGW * 4) {
            f32x4 v[4][8];
#pragma unroll
            for (int t = 0; t < 4; ++t) { const int r = (r0 + t * NGW < NTOK) ? r0 + t * NGW : r0; const f32x4* xr = (const f32x4*)(x + (size_t)r * D_MODEL) + lane;
#pragma unroll
                for (int j = 0; j < 8; ++j) v[t][j] = xr[64 * j]; }
#pragma unroll
            for (int t = 0; t < 4; ++t) { const int r = r0 + t * NGW; if (r < NTOK) {
                float s = 0.f;
#pragma unroll
                for (int j = 0; j < 8; ++j) s += (v[t][j].x * v[t][j].x + v[t][j].y * v[t][j].y) + (v[t][j].z * v[t][j].z + v[t][j].w * v[t][j].w);
                const float rstd = rsqrtf(wave_sum(s) * (1.f / D_MODEL) + EPS);
                u32x2* o = (u32x2*)((bf16_t*)(ws + WS_XN) + (size_t)r * D_MODEL) + lane;
#pragma unroll
                for (int j = 0; j < 8; ++j) { u32x2 w; w.x = cvt_pk_bf16(v[t][j].x * rstd * gn[j].x, v[t][j].y * rstd * gn[j].y); w.y = cvt_pk_bf16(v[t][j].z * rstd * gn[j].z, v[t][j].w * rstd * gn[j].w); o[64 * j] = w; } } }
        }
    }
    for (int i = gw * 64 + lane; i < SEQ * 32; i += NGW * 64) {
        const int pos = i >> 5, f = i & 31;
        const float inv_freq = 1.0f / powf(10000.0f, (float)f * 2.0f / 64.0f);
        const float ang = (float)pos * inv_freq;
        ((float*)(ws + WS_ROPEC))[i] = cosf(ang); ((float*)(ws + WS_ROPES))[i] = sinf(ang);
    }
    for (int i = gw * 64 + lane; i < NEXP * D_MODEL; i += NGW * 64) { const int e = i >> 11, k = i & 2047; ((float*)(ws + WS_WRT))[i] = w_router[(size_t)k * NEXP + e]; }
    constexpr int T_IN = 32 * 192, T_OUT = 32 * 64, T_E = 32 * 64;
    {
        const int kg = lane & 7, ng = lane >> 3;
        auto tile_of = [&](int it, const float*& W, int& N, bf16_t*& Wt, int& k0, int& n0, bool& win) {
            win = it < T_IN; const int r = win ? it : it - T_IN, nbk = win ? 192 : 64;
            W = win ? w_in : w_out; N = win ? INW : D_MODEL; Wt = (bf16_t*)(ws + (win ? WS_WIN : WS_WOUT)); k0 = (r / nbk) * 64 + kg * 8; n0 = (r % nbk) * 32 + ng * 4; };
        for (int it0 = gw; it0 < T_IN + T_OUT; it0 += NGW * 2) {
            f32x4 v[2][8];
#pragma unroll
            for (int t = 0; t < 2; ++t) { const int it = (it0 + t * NGW < T_IN + T_OUT) ? it0 + t * NGW : it0; const float* W; int N, k0, n0; bf16_t* Wt; bool win; tile_of(it, W, N, Wt, k0, n0, win);
#pragma unroll
                for (int j = 0; j < 8; ++j) v[t][j] = __builtin_nontemporal_load((const f32x4*)(W + (size_t)(k0 + j) * N + n0)); }
#pragma unroll
            for (int t = 0; t < 2; ++t) { const int it = it0 + t * NGW; if (it < T_IN + T_OUT) { const float* W; int N, k0, n0; bf16_t* Wt; bool win; tile_of(it, W, N, Wt, k0, n0, win);
#pragma unroll
                for (int c = 0; c < 4; ++c) {
                    u32x4 o; o.x = cvt_pk_bf16(v[t][0][c], v[t][1][c]); o.y = cvt_pk_bf16(v[t][2][c], v[t][3][c]); o.z = cvt_pk_bf16(v[t][4][c], v[t][5][c]); o.w = cvt_pk_bf16(v[t][6][c], v[t][7][c]);
                    const int n = n0 + c, row = win ? RmWin{}(n) : n;
                    *(u32x4*)(Wt + (size_t)row * D_MODEL + k0) = o; } } }
        }
    }
}

constexpr int CV_T_E = 32 * 64, CV_NTILES = 3 * NEXP * CV_T_E, CV_ITEM_TILES = 64, CV_NITEMS = CV_NTILES / CV_ITEM_TILES;
constexpr int CV_Q1 = 2 * NEXP * 32 + 256;
constexpr int LDS_QSLOT = RING_BYTES + 2048;
__device__ __forceinline__ void conv_items(const Frame& F, const Args& a, const unsigned* stop_word, unsigned stop_count, int limit, int nstatic = 0, int base = 0, int stride = 0) {
    unsigned char* ws = F.ws;
    const int tid = fresh_tid(F.wave), lane = tid & 63;
    const float* w_gate = a.in[9]; const float* w_up = a.in[11]; const float* w_down = a.in[13];
    unsigned* qn = (unsigned*)(ws + WS_CTL) + CW_CONVQ;
    LAS int* s_item = (LAS int*)(F.lds + LDS_QSLOT);
    for (int jj = 0;; ++jj) {
        int item;
        if (nstatic > 0) { if (jj >= nstatic) break; item = base + jj * stride; }
        else {
            if (tid == 0) {
                int it = -1;
                const bool stop = stop_word && __hip_atomic_load(stop_word, __ATOMIC_RELAXED, __HIP_MEMORY_SCOPE_AGENT) >= stop_count;
                if (!stop) it = (int)__hip_atomic_fetch_add(qn, 1u, __ATOMIC_RELAXED, __HIP_MEMORY_SCOPE_AGENT);
                *s_item = it;
            }
            __syncthreads();
            item = __builtin_amdgcn_readfirstlane(*s_item);
            __syncthreads();
        }
        if (item < 0 || item >= limit) break;
        const int mat = item / (NEXP * 32), r = item - mat * (NEXP * 32), e = r >> 5, kb = (r >> 1) & 15, nh = r & 1;
        const int kh = F.wave >> 2, wq = F.wave & 3;
        const float* W = (mat == 0 ? w_gate : mat == 1 ? w_up : w_down) + (size_t)e * D_MODEL * D_MODEL;
        const float* s = W + (size_t)(kb * 128 + kh * 64) * D_MODEL + nh * 1024 + wq * 256 + lane * 4;
        unsigned char* dst = ((mat == 2) ? (ws + WS_WD + (size_t)e * D_MODEL * D_MODEL) : (ws + WS_WGU + (size_t)e * 4096 * D_MODEL)) + kb * 128;
        LAS unsigned char* T = F.lds;
        const int nl = wq * 256 + lane * 4, fz = lane & 15;
        constexpr int CVD = 3;
        f32x4 v[CVD][8];
#pragma unroll
        for (int d = 0; d < CVD - 1; ++d)
#pragma unroll
            for (int j = 0; j < 8; ++j) v[d][j] = __builtin_nontemporal_load((const f32x4*)(s + (size_t)(d * 8 + j) * D_MODEL));
#pragma unroll
        for (int st = 0; st < 8; ++st) {
            if (st + CVD - 1 < 8) {
#pragma unroll
                for (int j = 0; j < 8; ++j) v[(st + CVD - 1) % CVD][j] = __builtin_nontemporal_load((const f32x4*)(s + (size_t)((st + CVD - 1) * 8 + j) * D_MODEL)); }
            const f32x4* vv = v[st % CVD];
#pragma unroll
            for (int c = 0; c < 4; ++c) {
                u32x2 o; o.x = cvt_pk4_fp8(vv[0][c] * W8_SCALE, vv[1][c] * W8_SCALE, vv[2][c] * W8_SCALE, vv[3][c] * W8_SCALE); o.y = cvt_pk4_fp8(vv[4][c] * W8_SCALE, vv[5][c] * W8_SCALE, vv[6][c] * W8_SCALE, vv[7][c] * W8_SCALE);
                *(LAS u32x2*)(T + (nl + c) * 128 + (((kh * 8 + st) ^ fz) * 8)) = o;
            }
        }
        __syncthreads();
#pragma unroll
        for (int i = 0; i < 16; ++i) {
            const int id = tid + 512 * i, nn = id >> 3, q = id & 7, f = (nn >> 2) & 15, n = nh * 1024 + nn;
            u32x4 d = *(const LAS u32x4*)(T + nn * 128 + (((2 * q) ^ (f & 14)) * 8));
            if (f & 1) d = (u32x4){d.z, d.w, d.x, d.y};
            const int row = (mat == 2) ? n : (256 * (n >> 7) + 128 * mat + (n & 127));
            __builtin_nontemporal_store(d, (u32x4*)(dst + (size_t)row * D_MODEL + 16 * q));
        }
        __syncthreads();
    }
}

namespace attn {
typedef float f32x16 __attribute__((ext_vector_type(16)));
typedef short s16x4 __attribute__((ext_vector_type(4)));
typedef short v4i16_t __attribute__((ext_vector_type(4)));
#define MFMA32(a, b, c) __builtin_amdgcn_mfma_f32_32x32x16_bf16(a, b, c, 0, 0, 0)
__device__ __forceinline__ int crow(int r, int hi) { return (r & 3) + 8 * (r >> 2) + 4 * hi; }
__device__ __forceinline__ s16x4 vtr(const LAS unsigned char* p) { return __builtin_bit_cast(s16x4, __builtin_amdgcn_ds_read_tr16_b64_v4i16((LAS v4i16_t*)p)); }
__device__ __forceinline__ float xhalf(float v) {
    auto rr = __builtin_amdgcn_permlane32_swap(__float_as_uint(v), __float_as_uint(v), false, false);
    return (lane_id() & 32) ? __uint_as_float(rr[0]) : __uint_as_float(rr[1]);
}
__device__ __forceinline__ bf16x8 pack8(const f32x16& p, int ks) {
    u32x4 w; w.x = cvt_pk_bf16(p[8 * ks + 0], p[8 * ks + 1]); w.y = cvt_pk_bf16(p[8 * ks + 2], p[8 * ks + 3]); w.z = cvt_pk_bf16(p[8 * ks + 4], p[8 * ks + 5]); w.w = cvt_pk_bf16(p[8 * ks + 6], p[8 * ks + 7]);
    return __builtin_bit_cast(bf16x8, w);
}
__device__ __forceinline__ bf16x8 cat44(s16x4 lo, s16x4 hi) { bf16x8 r; r[0] = lo[0]; r[1] = lo[1]; r[2] = lo[2]; r[3] = lo[3]; r[4] = hi[0]; r[5] = hi[1]; r[6] = hi[2]; r[7] = hi[3]; return r; }
__device__ __forceinline__ void store_ot(const f32x16 (&O)[2], float scale, bf16_t* orow, int hi) {
#pragma unroll
    for (int dh = 0; dh < 2; ++dh)
#pragma unroll
        for (int g = 0; g < 4; ++g) { u32x2 w; w.x = cvt_pk_bf16(O[dh][4 * g] * scale, O[dh][4 * g + 1] * scale); w.y = cvt_pk_bf16(O[dh][4 * g + 2] * scale, O[dh][4 * g + 3] * scale);
            *(u32x2*)(orow + 32 * dh + 8 * g + 4 * hi) = w; }
}

constexpr int DA_ROWS = 384, DA_KPL = (DA_ROWS + 1) * 16, DA_VHL = DA_ROWS * 64 + 64, DA_VOFF = 8 * DA_KPL, DA_LDS = DA_VOFF + 2 * DA_VHL;
struct DaUnit { int b, h, p, ib; };
struct DaRegs { u32x4 kv[6], vv[6]; bf16x8 qf[4]; int tokq, uq; };
__device__ __forceinline__ void da_load(DaRegs& R, const bf16_t* __restrict__ QD, const bf16_t* __restrict__ KD, const bf16_t* __restrict__ VD, const DaUnit& u, int tid) {
    const int lane = tid & 63, wid = __builtin_amdgcn_readfirstlane(tid >> 6), r32 = lane & 31, hi = lane >> 5;
    const int lgL = 11 - 2 * u.p, dsh = 2 * u.p, Lm1 = (1 << lgL) - 1, i0 = u.ib * 256;
#pragma unroll
    for (int t = 0; t < 6; ++t) {
        const int idx = tid + 512 * t, j = idx >> 3, c = idx & 7, ip = i0 - 128 + j;
        R.kv[t] = (u32x4){0u, 0u, 0u, 0u}; R.vv[t] = (u32x4){0u, 0u, 0u, 0u};
        if (ip >= 0) { const int pos = ((ip & Lm1) << dsh) + (ip >> lgL); const size_t go = (size_t)(u.b * SEQ + pos) * GW + u.h * 64 + c * 8; R.kv[t] = *(const u32x4*)(KD + go); R.vv[t] = *(const u32x4*)(VD + go); }
    }
    const int iq = i0 + 32 * wid + r32; R.uq = iq & Lm1; R.tokq = u.b * SEQ + (R.uq << dsh) + (iq >> lgL);
#pragma unroll
    for (int d0 = 0; d0 < 4; ++d0) R.qf[d0] = *(const bf16x8*)(QD + (size_t)R.tokq * GW + u.h * 64 + 16 * d0 + 8 * hi);
}
__device__ __forceinline__ void da_fill(LAS unsigned char* lds, const DaRegs& R, int tid) {
#pragma unroll
    for (int t = 0; t < 6; ++t) {
        const int idx = tid + 512 * t, j = idx >> 3, c = idx & 7;
        *(LAS u32x4*)(lds + c * DA_KPL + j * 16) = R.kv[t];
        *(LAS u32x4*)(lds + DA_VOFF + (c >> 2) * DA_VHL + j * 64 + (c & 3) * 16) = R.vv[t];
    }
}
__device__ __forceinline__ void da_compute(const LAS unsigned char* lds, const bf16x8 (&qf)[4], int tokq, int uq, bf16_t* __restrict__ OP, float* __restrict__ LSE, int h, int p, int tid) {
    const int lane = tid & 63, wid = __builtin_amdgcn_readfirstlane(tid >> 6), r32 = lane & 31, hi = lane >> 5;
    f32x16 S[5];
#pragma unroll
    for (int s = 0; s < 5; ++s) {
        S[s] = (f32x16){};
#pragma unroll
        for (int d0 = 0; d0 < 4; ++d0) { const bf16x8 kf = *(const LAS bf16x8*)(lds + (2 * d0 + hi) * DA_KPL + (32 * wid + 32 * s + r32) * 16); S[s] = MFMA32(kf, qf[d0], S[s]); }
    }
    const int lim = uq < 128 ? uq : 128, lv = r32 - 4 * hi;
    float mx = -INFINITY;
#pragma unroll
    for (int s = 0; s < 5; ++s)
#pragma unroll
        for (int r = 0; r < 16; ++r) { const int dist = lv + (128 - 32 * s - ((r & 3) + 8 * (r >> 2))); const bool ok = (dist >= 0) && (dist <= lim); const float v = ok ? S[s][r] : -INFINITY; S[s][r] = v; mx = fmaxf(mx, v); }
    mx = fmaxf(mx, xhalf(mx));
    float l = 0.f;
#pragma unroll
    for (int s = 0; s < 5; ++s)
#pragma unroll
        for (int r = 0; r < 16; ++r) { const float pv = __builtin_amdgcn_exp2f(S[s][r] - mx); S[s][r] = pv; l += pv; }
    l += xhalf(l);
    f32x16 O[2]; O[0] = (f32x16){}; O[1] = (f32x16){};
    const LAS unsigned char* vb = lds + DA_VOFF + (32 * wid + 4 * hi + ((lane & 15) >> 2)) * 64 + ((lane >> 4) & 1) * 32 + (lane & 3) * 8;
#pragma unroll
    for (int s = 0; s < 5; ++s)
#pragma unroll
        for (int ks = 0; ks < 2; ++ks) {
            const bf16x8 pb = pack8(S[s], ks);
#pragma unroll
            for (int dh = 0; dh < 2; ++dh) { const LAS unsigned char* a = vb + dh * DA_VHL + (32 * s + 16 * ks) * 64; O[dh] = MFMA32(cat44(vtr(a), vtr(a + 512)), pb, O[dh]); }
        }
    store_ot(O, 1.0f / l, OP + ((size_t)p * NTOK + tokq) * GW + h * 64, hi);
    if (hi == 0) LSE[((size_t)p * NTOK + tokq) * NH + h] = mx + __builtin_amdgcn_logf(l);
}

constexpr int SB_ROWS = 448, SB_KPL = (SB_ROWS + 1) * 16, SB_VHL = SB_ROWS * 64 + 64, SB_VOFF = 8 * SB_KPL, SB_LDS = SB_VOFF + 2 * SB_VHL, SB_FLAGS = SB_LDS;
static_assert(SB_LDS + 64 <= 131072, "stick-breaking chunk image fits the phase scratch region");
__device__ __forceinline__ void sb_unit(LAS unsigned char* lds, const bf16_t* __restrict__ QS, const bf16_t* __restrict__ KS, const bf16_t* __restrict__ VS, bf16_t* __restrict__ OSB,
                                        int b, int h, int qb, int tid) {
    const int lane = tid & 63, wid = __builtin_amdgcn_readfirstlane(tid >> 6), r32 = lane & 31, hi = lane >> 5;
    const int t0w = 256 * qb + 32 * wid, tq = t0w + r32, tokq = b * SEQ + tq;
    bf16x8 qf[4];
#pragma unroll
    for (int d0 = 0; d0 < 4; ++d0) qf[d0] = *(const bf16x8*)(QS + (size_t)tokq * GW + h * 64 + 16 * d0 + 8 * hi);
    f32x16 O[2]; O[0] = (f32x16){}; O[1] = (f32x16){};
    float C = 0.f;
    bool done = false;
    const int vlane = (4 * hi + ((lane & 15) >> 2)) * 64 + ((lane >> 4) & 1) * 32 + (lane & 3) * 8;
    LAS int* s_need = (LAS int*)(lds + SB_FLAGS);
    int khi = 256 * qb + 255;
    for (;;) {
        const int klo = (khi - (SB_ROWS - 1)) > 0 ? (khi - (SB_ROWS - 1)) : 0, nrows = khi - klo + 1;
        {
            u32x4 kr[7], vr[7];
#pragma unroll
            for (int t = 0; t < 7; ++t) { const int idx = tid + 512 * t, j = idx >> 3, c = idx & 7;
                kr[t] = (u32x4){0u, 0u, 0u, 0u}; vr[t] = (u32x4){0u, 0u, 0u, 0u};
                if (j < nrows) { const size_t go = (size_t)(b * SEQ + klo + j) * GW + h * 64 + c * 8; kr[t] = *(const u32x4*)(KS + go); vr[t] = *(const u32x4*)(VS + go); } }
#pragma unroll
            for (int t = 0; t < 7; ++t) { const int idx = tid + 512 * t, j = idx >> 3, c = idx & 7;
                *(LAS u32x4*)(lds + c * SB_KPL + j * 16) = kr[t]; *(LAS u32x4*)(lds + SB_VOFF + (c >> 2) * SB_VHL + j * 64 + (c & 3) * 16) = vr[t]; }
        }
        __syncthreads();
        if (!done) {
            for (int kt = khi >> 6; kt >= (klo >> 6); --kt) {
                if (64 * kt > t0w + 30) continue;
                const bool diag = (64 * kt + 63 >= t0w);
                const LAS unsigned char* kb = lds + (64 * kt - klo) * 16; const LAS unsigned char* vb = lds + SB_VOFF + (64 * kt - klo) * 64 + vlane;
#pragma unroll
                for (int sub = 1; sub >= 0; --sub) {
                    const int keyb = 64 * kt + 32 * sub;
                    if (keyb > t0w + 30) continue;
                    f32x16 Z = (f32x16){};
#pragma unroll
                    for (int d0 = 0; d0 < 4; ++d0) { const bf16x8 kf = *(const LAS bf16x8*)(kb + (2 * d0 + hi) * SB_KPL + (32 * sub + r32) * 16); Z = MFMA32(kf, qf[d0], Z); }
                    const int kl = keyb + 4 * hi;
                    float sp[16];
#pragma unroll
                    for (int r = 0; r < 16; ++r) { const float e = __builtin_amdgcn_exp2f(Z[r]); float v = __builtin_amdgcn_logf(1.0f + e); if (diag) { const bool ok = (kl + (r & 3) + 8 * (r >> 2)) < tq; v = ok ? v : 0.f; } sp[r] = v; }
                    float own[4], oth[4];
#pragma unroll
                    for (int g = 0; g < 4; ++g) { sp[4 * g + 2] += sp[4 * g + 3]; sp[4 * g + 1] += sp[4 * g + 2]; sp[4 * g] += sp[4 * g + 1]; own[g] = sp[4 * g]; oth[g] = xhalf(own[g]); }
                    float off[4]; float run = C;
#pragma unroll
                    for (int g = 3; g >= 0; --g) { off[g] = run + (hi == 0 ? oth[g] : 0.f); run += own[g] + oth[g]; }
                    C = run;
#pragma unroll
                    for (int r = 0; r < 16; ++r) { float a = __builtin_amdgcn_exp2f(Z[r] - (off[r >> 2] + sp[r])); if (diag) { const bool ok = (kl + (r & 3) + 8 * (r >> 2)) < tq; a = ok ? a : 0.f; } Z[r] = a; }
#pragma unroll
                    for (int ks = 0; ks < 2; ++ks) {
                        const bf16x8 pb = pack8(Z, ks);
#pragma unroll
                        for (int dh = 0; dh < 2; ++dh) { const LAS unsigned char* a = vb + dh * SB_VHL + (32 * sub + 16 * ks) * 64; O[dh] = MFMA32(cat44(vtr(a), vtr(a + 512)), pb, O[dh]); }
                    }
                }
                float cm = C;
#pragma unroll
                for (int o = 1; o < 32; o <<= 1) cm = fminf(cm, __shfl_xor(cm, o));
                if (__builtin_amdgcn_readfirstlane(__float_as_int(cm)) >= __float_as_int(150.0f)) { done = true; break; }
            }
        }
        if (lane == 0) s_need[wid] = (!done && klo > 0) ? 1 : 0;
        __syncthreads();
        int any = 0;
#pragma unroll
        for (int i = 0; i < 8; ++i) any |= s_need[i];
        __syncthreads();
        if (!any) break;
        khi = klo - 1;
    }
    store_ot(O, 1.0f, OSB + (size_t)tokq * GW + h * 64, hi);
}
#undef MFMA32
}

__device__ __forceinline__ void p3_combine(const Frame& F, const Args& a) {
    unsigned char* ws = F.ws;
    const int tid_ = fresh_tid(F.wave), lane = tid_ & 63, wave_ = F.wave;
    const int gw = F.vcu * NWAVES + wave_, NGW = F.G * NWAVES;
    const bf16_t* OP = (const bf16_t*)(ws + WS_OP); const bf16_t* OSB = (const bf16_t*)(ws + WS_OSB); const float* LSE = (const float*)(ws + WS_LSE);
    bf16_t* ACAT = (bf16_t*)(ws + WS_ACAT);
    const float* gd = a.in[3]; const float* gs = a.in[4];
    const int hd = lane >> 2;
    float gdv[16], gsv[16];
#pragma unroll
    for (int j = 0; j < 16; ++j) { gdv[j] = gd[lane * 16 + j]; gsv[j] = gs[lane * 16 + j]; }
    constexpr int TB = 4;
    for (int tok0 = gw; tok0 < NTOK; tok0 += NGW * TB) {
        u32x4 ra[TB][4][2]; float ls[TB][3];
#pragma unroll
        for (int t = 0; t < TB; ++t) { const int tok = tok0 + t * NGW; if (tok < NTOK) {
#pragma unroll
            for (int p = 0; p < 3; ++p) { ls[t][p] = LSE[((size_t)p * NTOK + tok) * NH + hd]; const u32x4* pp = (const u32x4*)(OP + ((size_t)p * NTOK + tok) * GW + lane * 16); ra[t][p][0] = pp[0]; ra[t][p][1] = pp[1]; }
            const u32x4* ps = (const u32x4*)(OSB + (size_t)tok * GW + lane * 16); ra[t][3][0] = ps[0]; ra[t][3][1] = ps[1]; } }
#pragma unroll
        for (int t = 0; t < TB; ++t) { const int tok = tok0 + t * NGW; if (tok < NTOK) {
            const float mx = fmaxf(ls[t][0], fmaxf(ls[t][1], ls[t][2]));
            float w0 = __builtin_amdgcn_exp2f(ls[t][0] - mx), w1 = __builtin_amdgcn_exp2f(ls[t][1] - mx), w2 = __builtin_amdgcn_exp2f(ls[t][2] - mx);
            const float inv = 1.0f / (w0 + w1 + w2); w0 *= inv; w1 *= inv; w2 *= inv;
            float od[16], os[16];
#pragma unroll
            for (int q = 0; q < 2; ++q) { const u32x4 a0 = ra[t][0][q], a1 = ra[t][1][q], a2 = ra[t][2][q], as = ra[t][3][q];
#pragma unroll
                for (int j = 0; j < 4; ++j) {
                    od[8 * q + 2 * j] = w0 * __uint_as_float(a0[j] << 16) + w1 * __uint_as_float(a1[j] << 16) + w2 * __uint_as_float(a2[j] << 16);
                    od[8 * q + 2 * j + 1] = w0 * __uint_as_float(a0[j] & 0xffff0000u) + w1 * __uint_as_float(a1[j] & 0xffff0000u) + w2 * __uint_as_float(a2[j] & 0xffff0000u);
                    os[8 * q + 2 * j] = __uint_as_float(as[j] << 16); os[8 * q + 2 * j + 1] = __uint_as_float(as[j] & 0xffff0000u); } }
            float sd = 0.f, ss = 0.f;
#pragma unroll
            for (int j = 0; j < 16; ++j) { sd += od[j] * od[j]; ss += os[j] * os[j]; }
            const float rd = rsqrtf(wave_sum(sd) * (1.0f / GW) + EPS), rs = rsqrtf(wave_sum(ss) * (1.0f / GW) + EPS);
#pragma unroll
            for (int q = 0; q < 2; ++q) {
                u32x4 wd, wsb;
#pragma unroll
                for (int j = 0; j < 4; ++j) {
                    wd[j] = cvt_pk_bf16(od[8 * q + 2 * j] * rd * gdv[8 * q + 2 * j], od[8 * q + 2 * j + 1] * rd * gdv[8 * q + 2 * j + 1]);
                    wsb[j] = cvt_pk_bf16(os[8 * q + 2 * j] * rs * gsv[8 * q + 2 * j], os[8 * q + 2 * j + 1] * rs * gsv[8 * q + 2 * j + 1]); }
                *(u32x4*)(ACAT + (size_t)tok * D_MODEL + lane * 16 + 8 * q) = wd;
                *(u32x4*)(ACAT + (size_t)tok * D_MODEL + GW + lane * 16 + 8 * q) = wsb;
            } } }
    }
}

constexpr int ATT_NSB = BATCH * NH * 8, ATT_NDA = BATCH * NH * 3 * 8, ATT_NTOT = ATT_NSB + ATT_NDA;
__device__ __forceinline__ int att_grab(const Frame& F, int tid) {
    LAS int* s_item = (LAS int*)(F.lds + LDS_QSLOT);
    __syncthreads();
    if (tid == 0) *s_item = (int)__hip_atomic_fetch_add((unsigned*)(F.ws + WS_CTL) + CW_ATTQ, 1u, __ATOMIC_RELAXED, __HIP_MEMORY_SCOPE_AGENT);
    __syncthreads();
    return __builtin_amdgcn_readfirstlane(*s_item);
}
__device__ __forceinline__ void p2_attention(const Frame& F) {
    unsigned char* ws = F.ws; const int tid = fresh_tid(F.wave);
    const bf16_t* QKV = (const bf16_t*)(ws + WS_QKV);
    const bf16_t *QD = QKV, *KD = QKV + QKV_STRIDE, *VD = QKV + 2 * QKV_STRIDE, *QS = QKV + 3 * QKV_STRIDE, *KS = QKV + 4 * QKV_STRIDE, *VS = QKV + 5 * QKV_STRIDE;
    auto da_of = [](int id) { attn::DaUnit u; const int uid = id - ATT_NSB, pq = uid >> 3, bh = pq / 3; u.ib = uid & 7; u.p = pq % 3; u.b = bh >> 4; u.h = bh & 15; return u; };
    int cur = att_grab(F, tid);
    while (cur < ATT_NSB) {
        const int bh = cur >> 3; attn::sb_unit(F.lds, QS, KS, VS, (bf16_t*)(ws + WS_OSB), bh >> 4, bh & 15, 7 - (cur & 7), tid);
        cur = att_grab(F, tid);
    }
    if (cur < ATT_NTOT) {
        attn::DaRegs R;
        attn::da_load(R, QD, KD, VD, da_of(cur), tid);
        while (cur < ATT_NTOT) {
            const int nxt = att_grab(F, tid);
            const attn::DaUnit u = da_of(cur);
            attn::da_fill(F.lds, R, tid);
            bf16x8 qf[4]; qf[0] = R.qf[0]; qf[1] = R.qf[1]; qf[2] = R.qf[2]; qf[3] = R.qf[3];
            const int tokq = R.tokq, uq = R.uq;
            __syncthreads();
            if (nxt < ATT_NTOT) attn::da_load(R, QD, KD, VD, da_of(nxt), tid);
            attn::da_compute(F.lds, qf, tokq, uq, (bf16_t*)(ws + WS_OP), (float*)(ws + WS_LSE), u.h, u.p, tid);
            __syncthreads();
            cur = nxt;
        }
    }
}

constexpr int RT_RSTD = 0, RT_PART = 256, RT_LG = RT_PART + 8 * 32 * 32 * 4, RT_HIST = RT_LG + 32 * 32 * 4, RT_BASE = RT_HIST + 128, RT_SELE = RT_BASE + 128, RT_SELR = RT_SELE + 512, RT_SELG = RT_SELR + 512;
__device__ __forceinline__ void p5_router(const Frame& F, const Args& a) {
    unsigned char* ws = F.ws; LAS unsigned char* lds = F.lds;
    const int tid = fresh_tid(F.wave), lane = tid & 63, w = F.wave;
    const bf16_t* X1 = (const bf16_t*)(ws + WS_X1); const float* gain = a.in[6]; const float* wrT = (const float*)(ws + WS_WRT); const float* br = a.in[8];
    unsigned char* H2 = ws + WS_H2;
    int* cnt = (int*)(ws + WS_CTL) + CW_CNT; int* list = (int*)(ws + WS_LIST); int* a_exp = (int*)(ws + WS_AEXP); int* a_rank = (int*)(ws + WS_ARANK); float* a_gate = (float*)(ws + WS_AGATE);
    LAS float* s_rstd = (LAS float*)(lds + RT_RSTD); LAS float* s_part = (LAS float*)(lds + RT_PART); LAS float* s_lg = (LAS float*)(lds + RT_LG);
    LAS int* s_hist = (LAS int*)(lds + RT_HIST); LAS int* s_base = (LAS int*)(lds + RT_BASE); LAS int* s_sele = (LAS int*)(lds + RT_SELE); LAS int* s_selr = (LAS int*)(lds + RT_SELR); LAS float* s_selg = (LAS float*)(lds + RT_SELG);
    for (int it = F.vcu; it < NTOK / 32; it += F.G) {
        const int tok0 = it * 32;
        if (tid < 32) s_hist[tid] = 0;
#pragma unroll
        for (int q = 0; q < 4; ++q) {
            const u32x4* xr = (const u32x4*)(X1 + (size_t)(tok0 + 4 * w + q) * D_MODEL) + lane; float s = 0.f;
#pragma unroll
            for (int j = 0; j < 4; ++j) { const u32x4 v = xr[64 * j];
#pragma unroll
                for (int i = 0; i < 4; ++i) { const float lo = __uint_as_float(v[i] << 16), hi = __uint_as_float(v[i] & 0xffff0000u); s += lo * lo + hi * hi; } }
            s = wave_sum(s);
            if (lane == 0) s_rstd[4 * w + q] = rsqrtf(s * (1.0f / D_MODEL) + EPS);
        }
        __syncthreads();
        {
            const int tr = lane & 15, kq = lane >> 4;
            const float r0 = s_rstd[tr], r1 = s_rstd[16 + tr];
            f32x4 acc[2][2];
#pragma unroll
            for (int tt = 0; tt < 2; ++tt)
#pragma unroll
                for (int eh = 0; eh < 2; ++eh) acc[tt][eh] = (f32x4){0.f, 0.f, 0.f, 0.f};
            unsigned ha[4], hb[4];
#pragma unroll 4
            for (int ls = 0; ls < 16; ++ls) {
                const int k = 256 * w + 64 * (ls >> 2) + 16 * kq + 4 * (ls & 3);
                const f32x4 g = *(const f32x4*)(gain + k);
                f32x4 xa, xb;
                { const u32x2 ra = *(const u32x2*)(X1 + (size_t)(tok0 + tr) * D_MODEL + k), rb = *(const u32x2*)(X1 + (size_t)(tok0 + 16 + tr) * D_MODEL + k);
                  xa = (f32x4){__uint_as_float(ra.x << 16), __uint_as_float(ra.x & 0xffff0000u), __uint_as_float(ra.y << 16), __uint_as_float(ra.y & 0xffff0000u)};
                  xb = (f32x4){__uint_as_float(rb.x << 16), __uint_as_float(rb.x & 0xffff0000u), __uint_as_float(rb.y << 16), __uint_as_float(rb.y & 0xffff0000u)}; }
                const f32x4 b0 = *(const f32x4*)(wrT + (size_t)(lane & 15) * D_MODEL + k), b1 = *(const f32x4*)(wrT + (size_t)(16 + (lane & 15)) * D_MODEL + k);
                xa = xa * r0 * g; xb = xb * r1 * g;
                ha[ls & 3] = cvt_pk4_fp8(xa.x, xa.y, xa.z, xa.w); hb[ls & 3] = cvt_pk4_fp8(xb.x, xb.y, xb.z, xb.w);
                if ((ls & 3) == 3) { const int ks = k - 12;
                    *(u32x4*)(H2 + (size_t)(tok0 + tr) * D_MODEL + ks) = (u32x4){ha[0], ha[1], ha[2], ha[3]}; *(u32x4*)(H2 + (size_t)(tok0 + 16 + tr) * D_MODEL + ks) = (u32x4){hb[0], hb[1], hb[2], hb[3]}; }
#pragma unroll
                for (int j = 0; j < 4; ++j) {
                    acc[0][0] = __builtin_amdgcn_mfma_f32_16x16x4f32(xa[j], b0[j], acc[0][0], 0, 0, 0); acc[0][1] = __builtin_amdgcn_mfma_f32_16x16x4f32(xa[j], b1[j], acc[0][1], 0, 0, 0);
                    acc[1][0] = __builtin_amdgcn_mfma_f32_16x16x4f32(xb[j], b0[j], acc[1][0], 0, 0, 0); acc[1][1] = __builtin_amdgcn_mfma_f32_16x16x4f32(xb[j], b1[j], acc[1][1], 0, 0, 0);
                }
            }
#pragma unroll
            for (int tt = 0; tt < 2; ++tt)
#pragma unroll
                for (int eh = 0; eh < 2; ++eh)
#pragma unroll
                    for (int rg = 0; rg < 4; ++rg) s_part[(w * 32 + 16 * tt + 4 * kq + rg) * 32 + 16 * eh + (lane & 15)] = acc[tt][eh][rg];
        }
        __syncthreads();
        { const int t = tid >> 4, e2 = (tid & 15) * 2;
#pragma unroll
          for (int q = 0; q < 2; ++q) { float v = br[e2 + q];
#pragma unroll
              for (int ww = 0; ww < 8; ++ww) v += s_part[(ww * 32 + t) * 32 + e2 + q];
              s_lg[t * 32 + e2 + q] = v; } }
        __syncthreads();
        if (tid < 32) {
            unsigned used = 0u; float val[4]; int idx[4];
#pragma unroll
            for (int k = 0; k < 4; ++k) { int bi = 0; float bv = -INFINITY;
                for (int i = 0; i < 32; ++i) { const float v = s_lg[tid * 32 + i]; if (!((used >> i) & 1u) && v > bv) { bv = v; bi = i; } }
                used |= 1u << bi; idx[k] = bi; val[k] = bv; }
            float ex[4], sm = 0.f;
#pragma unroll
            for (int k = 0; k < 4; ++k) { ex[k] = expf(val[k] - val[0]); sm += ex[k]; }
#pragma unroll
            for (int k = 0; k < 4; ++k) { s_sele[tid * 4 + k] = idx[k]; s_selr[tid * 4 + k] = atomicAdd((int*)&s_hist[idx[k]], 1); s_selg[tid * 4 + k] = ex[k] / sm; }
        }
        __syncthreads();
        if (tid < 32) { const int hcount = s_hist[tid]; s_base[tid] = hcount ? atomicAdd(&cnt[tid], hcount) : 0; }
        __syncthreads();
        if (tid < 128) { const int e = s_sele[tid], rk = s_base[e] + s_selr[tid], aid = tok0 * 4 + tid;
            list[e * NTOK + rk] = aid; a_exp[aid] = e; a_rank[aid] = rk; a_gate[aid] = s_selg[tid]; }
        __syncthreads();
    }
}
constexpr int MOE_TAB_OFF = RING_BYTES + 1024;
__device__ __forceinline__ void moe_table(const Frame& F) {
    LAS int* tab = (LAS int*)(F.lds + MOE_TAB_OFF);
    if (fresh_tid(F.wave) == 0) {
        const int* cnt = (const int*)(F.ws + WS_CTL) + CW_CNT; int rows = 0, blocks = 0;
        for (int e = 0; e < NEXP; ++e) { const int c = __hip_atomic_load(cnt + e, __ATOMIC_RELAXED, __HIP_MEMORY_SCOPE_AGENT), nb = (c + 255) >> 8; tab[e] = c; tab[32 + e] = nb; tab[64 + e] = rows; tab[96 + e] = blocks; rows += nb * 256; blocks += nb; }
        tab[96 + 32] = blocks;
    }
    __syncthreads();
}
__device__ __forceinline__ void p8_final(const Frame& F, const Args& a) {
    unsigned char* ws = F.ws; const LAS int* tab = (const LAS int*)(F.lds + MOE_TAB_OFF);
    const int tid_ = fresh_tid(F.wave), lane = tid_ & 63, wave_ = F.wave;
    const int gw = F.vcu * NWAVES + wave_, NGW = F.G * NWAVES;
    const bf16_t* X1 = (const bf16_t*)(ws + WS_X1); const unsigned char* Y = ws + WS_Y; const float* fg = a.in[15];
    const int* a_exp = (const int*)(ws + WS_AEXP); const int* a_rank = (const int*)(ws + WS_ARANK); const float* a_gate = (const float*)(ws + WS_AGATE);
    for (int tok = gw; tok < NTOK; tok += NGW) {
        const unsigned char* yr[4]; float gt[4];
#pragma unroll
        for (int k = 0; k < 4; ++k) { const int aid = tok * 4 + k; yr[k] = Y + (size_t)(tab[64 + a_exp[aid]] + a_rank[aid]) * D_MODEL; gt[k] = a_gate[aid]; }
        f32x4 v[8]; float s = 0.f;
#pragma unroll
        for (int j = 0; j < 8; ++j) {
            const int c = (lane + 64 * j) * 4; f32x4 y; { const u32x2 rx = *(const u32x2*)(X1 + (size_t)tok * D_MODEL + c); y = (f32x4){__uint_as_float(rx.x << 16), __uint_as_float(rx.x & 0xffff0000u), __uint_as_float(rx.y << 16), __uint_as_float(rx.y & 0xffff0000u)}; }
#pragma unroll
            for (int k = 0; k < 4; ++k) { const unsigned yy = *(const unsigned*)(yr[k] + c);
                const auto lo2 = __builtin_amdgcn_cvt_pk_f32_fp8((int)yy, false), hi2 = __builtin_amdgcn_cvt_pk_f32_fp8((int)yy, true);
                y.x += gt[k] * lo2[0]; y.y += gt[k] * lo2[1]; y.z += gt[k] * hi2[0]; y.w += gt[k] * hi2[1]; }
            v[j] = y; s += (y.x * y.x + y.y * y.y) + (y.z * y.z + y.w * y.w);
        }
        const float rstd = rsqrtf(wave_sum(s) * (1.0f / D_MODEL) + EPS);
#pragma unroll
        for (int j = 0; j < 8; ++j) { const int c = (lane + 64 * j) * 4; const f32x4 g = *(const f32x4*)(fg + c); *(f32x4*)(a.out + (size_t)tok * D_MODEL + c) = v[j] * rstd * g; }
    }
}

__global__ void __launch_bounds__(NWAVES * 64, 2) mk_fwd(Args args) {
    extern __shared__ __attribute__((aligned(16))) unsigned char lds_raw[];
    Frame F;
    F.lds = (LAS unsigned char*)lds_raw; F.wave = __builtin_amdgcn_readfirstlane((int)threadIdx.x >> 6);
    F.G = gridDim.x; { const int bx = blockIdx.x; F.vcu = (F.G % 8 == 0) ? (bx % 8) * (F.G / 8) + bx / 8 : bx; }
    F.ws = args.ws;
    volatile LAS unsigned* MISC = (volatile LAS unsigned*)(F.lds + MISC_OFF);
    for (int u = fresh_tid(F.wave); u < (LDS_BYTES - RING_BYTES) / 4; u += NWAVES * 64) ((LAS unsigned*)(F.lds + RING_BYTES))[u] = 0u;
    __syncthreads();
    const int lo = args.ph_lo, hi = args.ph_hi;
    const bool multi = (hi - lo) > 1;
    XcdBarrier bar; bar.bar = (unsigned*)(F.ws + WS_CTL) + CW_BAR; bar.x = 0; bar.st = nullptr;
    if (multi) bar = xcd_barrier_post((unsigned*)(F.ws + WS_CTL) + CW_BAR, MISC + 8, fresh_tid(F.wave));
#define IN(k) (lo <= (k) && (k) < hi)
#define SEAM(k) do { if (IN(k) && IN((k) + 1)) xcd_barrier(bar, fresh_tid(F.wave)); } while (0)

    const int jx = (int)blockIdx.x >> 3, ncompj = (F.G >> 3) - NCONV / 8;
    const bool conv_role = multi && (F.G % 8 == 0) && (F.G >= 2 * NCONV) && jx >= ncompj;
    const int GC = conv_role || (multi && (F.G % 8 == 0) && (F.G >= 2 * NCONV)) ? ncompj * 8 : F.G;
    const int crank = (GC == F.G) ? (int)blockIdx.x : (jx * 8 + ((int)blockIdx.x & 7));
    unsigned* done1 = (unsigned*)(F.ws + WS_CTL) + CW_DONE1; unsigned* done2 = (unsigned*)(F.ws + WS_CTL) + CW_DONE2;
    if (IN(0)) { p0_prologue(F, args); SEAM(0); }
    if (IN(1)) {
        if (conv_role) conv_items(F, args, done1, (unsigned)GC, CV_Q1);
        else {
            pg8::StaticOrder S; S.init(NTOK, INW, D_MODEL * 2, F.ws + WS_WIN, GC, crank, 4);
            pg8::EpiQKV E{(bf16_t*)(F.ws + WS_QKV), (const float*)(F.ws + WS_ROPEC), (const float*)(F.ws + WS_ROPES)};
            pg8::gemm_phase<pg8::EpiQKV, pg8::StaticOrder>(F.lds, F.wave, F.ws + WS_XN, D_MODEL * 2, S, E);
            if (fresh_tid(F.wave) == 0) __hip_atomic_fetch_add(done1, 1u, __ATOMIC_RELAXED, __HIP_MEMORY_SCOPE_AGENT);
        }
        SEAM(1);
    }
    if (IN(2)) {
#pragma unroll 1
        for (int pass = 0; pass < 2; ++pass) {
            if ((pass == 0) == conv_role) conv_items(F, args, nullptr, 0u, CV_Q1);
            else p2_attention(F);
        }
        SEAM(2);
    }
    if (IN(3)) { p3_combine(F, args); SEAM(3); }
    if (IN(4)) {
        pg8::StaticOrder S; S.init(NTOK, D_MODEL, D_MODEL * 2, F.ws + WS_WOUT, F.G, (int)blockIdx.x);
        pg8::EpiOut E{args.in[0], (bf16_t*)(F.ws + WS_X1)};
        pg8::gemm_phase<pg8::EpiOut, pg8::StaticOrder>(F.lds, F.wave, F.ws + WS_ACAT, D_MODEL * 2, S, E);
        SEAM(4);
    }
    if (IN(5)) { p5_router(F, args); conv_items(F, args, nullptr, 0u, CV_Q1); SEAM(5); }
    if (IN(6)) {
        moe_table(F);
        pg8::GroupedOrder S; S.init((const LAS int*)(F.lds + MOE_TAB_OFF), 16, F.ws + WS_WGU, (size_t)4096 * D_MODEL, D_MODEL, (const int*)(F.ws + WS_LIST), true, F.G, (int)blockIdx.x, (const LAS int*)(F.lds + ROWTAB_OFF));
        S.fill_rowtab((LAS int*)(F.lds + ROWTAB_OFF), fresh_tid(F.wave)); __syncthreads();
        pg8::EpiGateUp E{F.ws + WS_H1, args.in[10], args.in[12]};
        const int brk = ((int)blockIdx.x >> 3) & 7;
        S.ibase = 0; S.iend = brk;
        pg8::gemm_phase<pg8::EpiGateUp, pg8::GroupedOrder, true, true>(F.lds, F.wave, F.ws + WS_H2, D_MODEL, S, E);
        conv_items(F, args, nullptr, 0u, CV_NITEMS, (CV_NITEMS - CV_Q1 + F.G - 1) / F.G, CV_Q1 + (int)blockIdx.x, F.G);
        S.ibase = brk; S.iend = 0x7fffffff;
        pg8::gemm_phase<pg8::EpiGateUp, pg8::GroupedOrder, true, true>(F.lds, F.wave, F.ws + WS_H2, D_MODEL, S, E);
        SEAM(6);
    }
    if (IN(7)) {
        if (!IN(6)) moe_table(F);
        pg8::GroupedOrder S; S.init((const LAS int*)(F.lds + MOE_TAB_OFF), 8, F.ws + WS_WD, (size_t)D_MODEL * D_MODEL, D_MODEL, nullptr, false, F.G, (int)blockIdx.x, nullptr);
        pg8::EpiDown E{F.ws + WS_Y, args.in[14]};
        pg8::gemm_phase<pg8::EpiDown, pg8::GroupedOrder, true, true>(F.lds, F.wave, F.ws + WS_H1, D_MODEL, S, E);
        SEAM(7);
    }
    if (IN(8)) { if (!IN(6) && !IN(7)) moe_table(F); p8_final(F, args); }

#undef IN
#undef SEAM
}


extern "C" void kernel_launch(void* const* d_in, const int* in_sizes, int n_in, void* d_out, int out_size, void* d_ws, size_t ws_size, hipStream_t stream) {
    static int grid = 0;
    if (grid == 0) {
        int dev = 0, cus = 0;
        if (hipGetDevice(&dev) != hipSuccess || hipDeviceGetAttribute(&cus, hipDeviceAttributeMultiprocessorCount, dev) != hipSuccess) { grid = -1; return; }
        if (hipFuncSetAttribute((const void*)mk_fwd, hipFuncAttributeMaxDynamicSharedMemorySize, LDS_BYTES) != hipSuccess) { fprintf(stderr, "hipFuncSetAttribute failed\n"); grid = -1; return; }
        int per_cu = 0;
        if (hipOccupancyMaxActiveBlocksPerMultiprocessor(&per_cu, (const void*)mk_fwd, NWAVES * 64, LDS_BYTES) != hipSuccess || per_cu < 1) fprintf(stderr, "occupancy query says %d\n", per_cu);
        (void)hipGetLastError();
        grid = cus;
    }
    if (grid < 0) return;
    const float* x = (const float*)d_in[0];
    const float* dil_norm = (const float*)d_in[3]; const float* sb_norm = (const float*)d_in[4]; const float* w_out = (const float*)d_in[5];
    const float* ffn_norm = (const float*)d_in[6]; const float* w_router = (const float*)d_in[7]; const float* b_router = (const float*)d_in[8];
    const float* w_gate = (const float*)d_in[9]; const float* b_gate = (const float*)d_in[10]; const float* w_up = (const float*)d_in[11]; const float* b_up = (const float*)d_in[12];
    const float* w_down = (const float*)d_in[13]; const float* b_down = (const float*)d_in[14]; const float* final_norm = (const float*)d_in[15];
    float* out = (float*)d_out;
    unsigned char* ws = (unsigned char*)d_ws;
    (void)hipMemsetAsync(ws + WS_CTL, 0, CTL_ZERO_BYTES, stream);
    Args a{};
    for (int i = 0; i < 16; ++i) a.in[i] = (const float*)d_in[i];
    a.out = out; a.ws = ws;
    a.ph_lo = 0; a.ph_hi = NPHASE;
    hipLaunchKernelGGL(mk_fwd, dim3(grid), dim3(NWAVES * 64), LDS_BYTES, stream, a);
}
```

```cpp
#include <hip/hip_runtime.h>
#include <cstdio>
#include <cstdint>

constexpr int D_MODEL = 2048, BATCH = 4, SEQ = 2048, NTOK = BATCH * SEQ;
constexpr int HD = 64, NH = 16, GW = 1024, INW = 6144;
constexpr int NEXP = 32, TOPK = 4, NASSIGN = NTOK * TOPK;
constexpr float EPS = 1e-5f;
constexpr float C2 = 0.125f * 1.4426950408889634f;
constexpr float LN2 = 0.6931471805599453f;

#define GAS __attribute__((address_space(1)))
#define LAS __attribute__((address_space(3)))
typedef unsigned short bf16_t;
typedef short bf16x8 __attribute__((ext_vector_type(8)));
typedef float f32x4 __attribute__((ext_vector_type(4)));
typedef unsigned u32x4 __attribute__((ext_vector_type(4)));
typedef unsigned u32x2 __attribute__((ext_vector_type(2)));
typedef GAS unsigned gu32;

constexpr size_t MiB = 1u << 20;
constexpr size_t WS_CTL = 0, CTL_ZERO_BYTES = 1 * MiB;
constexpr size_t WS_LIST = 1 * MiB;
constexpr size_t WS_AEXP = 2 * MiB, WS_ARANK = 2 * MiB + 256 * 1024, WS_AGATE = 2 * MiB + 512 * 1024;
constexpr size_t WS_ROPEC = 3 * MiB, WS_ROPES = 3 * MiB + 256 * 1024, WS_WRT = 3 * MiB + 512 * 1024;
constexpr size_t WS_LSE = 4 * MiB;
constexpr size_t WS_XN = 8 * MiB;
constexpr size_t WS_QKV = 40 * MiB;
constexpr size_t QKV_STRIDE = (size_t)NTOK * GW;
constexpr size_t WS_OP = 136 * MiB;
constexpr size_t WS_OSB = 184 * MiB;
constexpr size_t WS_ACAT = 200 * MiB;
constexpr size_t WS_X1 = 232 * MiB;
constexpr size_t WS_H2 = 296 * MiB;
constexpr size_t WS_H1 = 328 * MiB;
constexpr size_t WS_Y = 488 * MiB;
constexpr size_t WS_WIN = 648 * MiB;
constexpr size_t WS_WOUT = 672 * MiB;
constexpr size_t WS_WGU = 680 * MiB;
constexpr size_t WS_WD = 1192 * MiB;
constexpr size_t WS_END = 1448 * MiB;
constexpr int CW_TMO = 0, CW_CNT = 64  , CW_BAR = 4096;
constexpr int CW_CONVQ = 256  , CW_ATTQ = 320  , CW_DONE1 = 384, CW_DONE2 = 448  ;

__device__ __forceinline__ int lane_id() { int l; asm volatile("v_mbcnt_lo_u32_b32 %0, -1, 0\n\tv_mbcnt_hi_u32_b32 %0, -1, %0" : "=v"(l)); return l; }
__device__ __forceinline__ int fresh_tid(int wave) { int t = wave * 64 + lane_id(); asm volatile("" : "+v"(t)); return t; }
__device__ __forceinline__ float wave_sum(float v) {
#pragma unroll
    for (int o = 1; o < 64; o <<= 1) v += __shfl_xor(v, o);
    return v;
}
__device__ __forceinline__ unsigned cvt_pk_bf16(float lo, float hi) { unsigned r; asm volatile("v_cvt_pk_bf16_f32 %0, %1, %2" : "=v"(r) : "v"(lo), "v"(hi)); return r; }
__device__ __forceinline__ unsigned cvt_pk4_fp8(float a, float b, float c, float d) { int w = 0; w = __builtin_amdgcn_cvt_pk_fp8_f32(a, b, w, false); w = __builtin_amdgcn_cvt_pk_fp8_f32(c, d, w, true); return (unsigned)w; }
constexpr float W8_SCALE = 64.0f, W8_INV = 1.0f / 64.0f;
__device__ __forceinline__ float bf2f(bf16_t b) { return __uint_as_float((unsigned)b << 16); }
__device__ __forceinline__ float block_sum_256(float v, float* sh) {
    v = wave_sum(v);
    const int w = threadIdx.x >> 6;
    __syncthreads();
    if ((threadIdx.x & 63) == 0) sh[w] = v;
    __syncthreads();
    return sh[0] + sh[1] + sh[2] + sh[3];
}
__device__ __forceinline__ float log_sigmoid(float z) { return fminf(z, 0.f) - log1pf(expf(-fabsf(z))); }

#define XB_TMO      128
#define XB_XCNT(j)  (256  + 64 * (j))
#define XB_XSUB(j)  (1280 + 64 * (j))
#define XB_XGEN(j)  (2304 + 64 * (j))
#define XB_TOP      3328
#define XB_TOPGEN   3392
#define XCD_BAR_WORDS 3456
#define XB_SPIN_CAP (1u << 18)
__device__ __forceinline__ unsigned xb_ld(unsigned* p)              { return __hip_atomic_load(p, __ATOMIC_RELAXED, __HIP_MEMORY_SCOPE_AGENT); }
__device__ __forceinline__ unsigned xb_add(unsigned* p, unsigned v) { return __hip_atomic_fetch_add(p, v, __ATOMIC_RELAXED, __HIP_MEMORY_SCOPE_AGENT); }
__device__ __forceinline__ unsigned xb_xcc_id() { return (unsigned)__builtin_amdgcn_s_getreg((3 << 11) | 20) & 0xFu; }
#define XB_SPIN(cond, bar) do { unsigned _sp = 0; while (cond) { __builtin_amdgcn_s_sleep(1); \
    if ((++_sp & 255u) == 0u) { if (xb_ld(&(bar)[XB_TMO])) break; if (_sp > XB_SPIN_CAP) { atomicAdd(&(bar)[XB_TMO], 1u); break; } } } } while (0)
struct XcdBarrier { unsigned* bar; unsigned x; volatile LAS unsigned* st; };
__device__ __forceinline__ XcdBarrier xcd_barrier_post(unsigned* bar, volatile LAS unsigned* st, int tid) {
    XcdBarrier b; b.bar = bar; b.x = xb_xcc_id(); b.st = st;
    if (tid == 0) (void)xb_add(&bar[XB_XCNT(b.x)], 1u);
    return b;
}
__device__ __forceinline__ void xcd_barrier_complete(unsigned* bar, unsigned x, unsigned& nloc, unsigned& nx) {
    const unsigned G = gridDim.x * gridDim.y * gridDim.z;
    unsigned sum, cnt, mine, sp = 0u;
    for (;;) {
        sum = 0u; cnt = 0u; mine = 0u;
#pragma unroll
        for (unsigned j = 0; j < 16; ++j) { const unsigned c = xb_ld(&bar[XB_XCNT(j)]); sum += c; cnt += (c > 0u) ? 1u : 0u; mine = (j == x) ? c : mine; }
        if (sum == G) break;
        __builtin_amdgcn_s_sleep(1);
        if ((++sp & 255u) == 0u) { if (xb_ld(&bar[XB_TMO])) break; if (sp > XB_SPIN_CAP) { atomicAdd(&bar[XB_TMO], 1u); break; } }
    }
    nloc = mine > 0u ? mine : 1u; nx = cnt > 0u ? cnt : 1u;
}
__device__ __forceinline__ void xcd_barrier_arrive(const XcdBarrier& b, int tid) {
    asm volatile("s_waitcnt vmcnt(0)" ::: "memory");
    __syncthreads();
    if (tid == 0) {
        unsigned* bar = b.bar;
        __builtin_amdgcn_s_waitcnt(0);
        unsigned nloc = b.st[0], nx = b.st[1];
        if (nloc == 0u) { xcd_barrier_complete(bar, b.x, nloc, nx); b.st[0] = nloc; b.st[1] = nx; }
        const unsigned old = xb_add(&bar[XB_XSUB(b.x)], 1u);
        const unsigned gen = old / nloc;
        if (old + 1u == (gen + 1u) * nloc) {
            __builtin_amdgcn_fence(__ATOMIC_RELEASE, "agent");
            asm volatile("s_waitcnt vmcnt(0)" ::: "memory");
            const unsigned og = xb_add(&bar[XB_TOP], 1u);
            const unsigned tg = og / nx;
            if (og + 1u == (tg + 1u) * nx) xb_add(&bar[XB_TOPGEN], 1u);
            else XB_SPIN(xb_ld(&bar[XB_TOPGEN]) == tg, bar);
            __builtin_amdgcn_fence(__ATOMIC_ACQUIRE, "agent");
            xb_add(&bar[XB_XGEN(b.x)], 1u);
            asm volatile("s_waitcnt vmcnt(0)" ::: "memory");
            b.st[2] = 0xffffffffu;
        } else b.st[2] = gen;
    }
    __syncthreads();
}
__device__ __forceinline__ void xcd_barrier_wait(const XcdBarrier& b, int tid) {
    asm volatile("s_waitcnt vmcnt(0)" ::: "memory");
    __syncthreads();
    if (tid == 0) {
        const unsigned gen = b.st[2];
        if (gen != 0xffffffffu) XB_SPIN(xb_ld(&b.bar[XB_XGEN(b.x)]) == gen, b.bar);
        __builtin_amdgcn_fence(__ATOMIC_ACQUIRE, "agent");
        asm volatile("s_waitcnt vmcnt(0)" ::: "memory");
    }
    __syncthreads();
}
__device__ __forceinline__ void xcd_barrier(const XcdBarrier& b, int tid) { xcd_barrier_arrive(b, tid); xcd_barrier_wait(b, tid); }

__device__ __forceinline__ const char* uniform_ptr(const char* p) {
    const unsigned long long v = (unsigned long long)p;
    const unsigned lo = (unsigned)__builtin_amdgcn_readfirstlane((int)(unsigned)v), hi = (unsigned)__builtin_amdgcn_readfirstlane((int)(unsigned)(v >> 32));
    return (const char*)(((unsigned long long)hi << 32) | lo);
}
namespace pg8 {
constexpr int ROWTAB_UNITS = 10;
constexpr int BM = 256, BK = 64, HALF = 128, HTB = HALF * BK * 2, STAGE_BYTES = 8 * HTB, NXCD = 8, WGM = 8, RING_BYTES_C = 131072;
__host__ __device__ __forceinline__ int lds_byte(int r, int c) { const int st = (r >> 4) * 2 + (c >> 5), rr = r & 15, cc = c & 31, ob = rr * 64 + cc * 2; return st * 1024 + (ob ^ (((ob >> 9) & 1) << 5)); }
__host__ __device__ __forceinline__ void stage_rc(int b, int& R, int& C) { const int st = b / 1024, sb = b % 1024, swz = sb ^ (((sb >> 9) & 1) << 5); R = (st >> 1) * 16 + swz / 64; C = (st & 1) * 32 + (swz % 64) / 2; }
__host__ __device__ __forceinline__ int perm32(int rho) { const int n = rho >> 4, i = rho & 15; return 8 * (i >> 2) + 4 * n + (i & 3); }

struct Unit { int arow0; int nvalid; const char* bptr; int orow0; int pn; int e; int ui; };

struct StaticOrder {
    int nM, nN, nwg, G, c, wgm; const char* Bt; int RB;
    __device__ void init(int M, int N, int RB_, const void* Bt_, int G_, int c_, int wgm_ = WGM) { nM = M / BM; nN = N / BM; nwg = nM * nN; G = G_; c = c_; Bt = (const char*)Bt_; RB = RB_; wgm = wgm_; }
    __device__ bool next(int i, Unit& u) const {
        const int L = i * G + c; if (L >= nwg) return false;
        int wgid = L; { const int q = nwg / NXCD, r = nwg % NXCD, xcd = wgid % NXCD, off = wgid / NXCD; wgid = (xcd < r ? xcd * (q + 1) : r * (q + 1) + (xcd - r) * q) + off; }
        const int nig = wgm * nN, gid = wgid / nig, fm = gid * wgm, gsz = (nM - fm) < wgm ? (nM - fm) : wgm;
        const int pm = fm + ((wgid % nig) % gsz), pn = (wgid % nig) / gsz;
        u.arow0 = pm * BM; u.nvalid = BM; u.bptr = Bt + (size_t)pn * BM * RB; u.orow0 = pm * BM; u.pn = pn; u.e = 0; u.ui = i; return true;
    }
    __device__ __forceinline__ unsigned a_off(const Unit& u, int r) const { return (unsigned)(u.arow0 + r) * (unsigned)RB; }
};

typedef int v8i_t __attribute__((ext_vector_type(8)));
typedef int v4i_t __attribute__((ext_vector_type(4)));
template <class Epi, class Sched, bool ALIGN_EPI = true, bool FP8 = false>
__device__ __forceinline__ void gemm_phase(LAS unsigned char* lds, int wave, const void* Aptr, int RB, const Sched& S, const Epi& E) {
    const int tid = fresh_tid(wave), wid = wave, lane = tid & 63, wr = wid >> 2, wc = wid & 3, fr = lane & 15, fq = lane >> 4;
    const int nt = RB / 128;
    const char* gA = (const char*)Aptr;
    unsigned voffB[2];
#pragma unroll
    for (int i = 0; i < 2; ++i) { int R, C; stage_rc(tid * 16 + i * 8192, R, C); const int Rb = Epi::PERM ? ((R & ~31) + perm32(R & 31)) : R; voffB[i] = (unsigned)(Rb * RB + C * 2); }
    const size_t kstep = (size_t)(BK * 2);
    const size_t hstep = (size_t)HALF * RB;
    const unsigned ldsw = (unsigned)wid * 1024u;
    const int aoff = lds_byte(wr * 64 + fr, fq * 8), boff = lds_byte(wc * 32 + fr, fq * 8);
#define PG8_SA(b, h) (((b) * 2 + (h)) * HTB)
#define PG8_SB(b, h) ((4 + (b) * 2 + (h)) * HTB)
#define PG8_STAGEB(bufoff, gbase, vo) do { const char* _b = (const char*)(gbase); asm volatile("" : "+s"(_b));   _Pragma("unroll") for (int _i = 0; _i < 2; ++_i) \
        __builtin_amdgcn_global_load_lds((const unsigned*)(_b + (vo)[_i]), (LAS unsigned*)(lds + (bufoff) + ldsw + _i * 8192), 16, 0, 0); } while (0)
#define PG8_STAGEA(bufoff, kb, offs) do { const char* _b = gA + (size_t)(kb); asm volatile("" : "+s"(_b)); _Pragma("unroll") for (int _i = 0; _i < 2; ++_i) \
        __builtin_amdgcn_global_load_lds((const unsigned*)(_b + (offs)[_i]), (LAS unsigned*)(lds + (bufoff) + ldsw + _i * 8192), 16, 0, 0); } while (0)
#define PG8_LD8(p) __builtin_shufflevector(*(const LAS v4i_t*)(p), *(const LAS v4i_t*)((p) + 1024), 0, 1, 2, 3, 4, 5, 6, 7)
#define PG8_LDA(dst, b, h) do { _Pragma("unroll") for (int m = 0; m < 4; ++m) dst[m] = PG8_LD8(lds + PG8_SA(b, h) + aoff + m * 2048); } while (0)
#define PG8_LDB(dst, b, h) do { _Pragma("unroll") for (int n = 0; n < 2; ++n) dst[n] = PG8_LD8(lds + PG8_SB(b, h) + boff + n * 2048); } while (0)
#define PG8_LO(v) __builtin_bit_cast(bf16x8, __builtin_shufflevector(v, v, 0, 1, 2, 3))
#define PG8_HI(v) __builtin_bit_cast(bf16x8, __builtin_shufflevector(v, v, 4, 5, 6, 7))
#define PG8_MMA(ai, bj, At, Bt) do { __builtin_amdgcn_s_setprio(1); _Pragma("unroll") for (int m = 0; m < 4; ++m) _Pragma("unroll") for (int n = 0; n < 2; ++n) { \
        if constexpr (FP8) acc[ai][bj][m][n] = __builtin_amdgcn_mfma_scale_f32_16x16x128_f8f6f4(Bt[n], At[m], acc[ai][bj][m][n], 0, 0, 0, 0x7f7f7f7f, 0, 0x7f7f7f7f); \
        else { acc[ai][bj][m][n] = __builtin_amdgcn_mfma_f32_16x16x32_bf16(PG8_LO(Bt[n]), PG8_LO(At[m]), acc[ai][bj][m][n], 0, 0, 0); \
               acc[ai][bj][m][n] = __builtin_amdgcn_mfma_f32_16x16x32_bf16(PG8_HI(Bt[n]), PG8_HI(At[m]), acc[ai][bj][m][n], 0, 0, 0); } } \
        __builtin_amdgcn_s_setprio(0); } while (0)
#define PG8_WAIT_V(n) asm volatile("s_waitcnt vmcnt(" #n ")" ::: "memory")
#define PG8_WAIT_L(n) asm volatile("s_waitcnt lgkmcnt(" #n ")" ::: "memory")
#define PG8_BAR __builtin_amdgcn_s_barrier()
#define PG8_SCHED __builtin_amdgcn_sched_barrier(0)
#define PG8_AOFFS(dst, U) do { const int _t = fresh_tid(wave); _Pragma("unroll") for (int _i = 0; _i < 2; ++_i) { int _R, _C; stage_rc(_t * 16 + _i * 8192, _R, _C); _Pragma("unroll") for (int _h = 0; _h < 2; ++_h) dst[_h][_i] = S.a_off(U, _h * HALF + _R) + (unsigned)(_C * 2); } } while (0)
    Unit cur, nxt; int ui = 0;
    if (!S.next(0, cur)) return;
    f32x4 acc[2][2][4][2];
#pragma unroll
    for (int a = 0; a < 2; ++a)
#pragma unroll
        for (int b = 0; b < 2; ++b)
#pragma unroll
            for (int m = 0; m < 4; ++m)
#pragma unroll
                for (int n = 0; n < 2; ++n) acc[a][b][m][n] = (f32x4){0.f, 0.f, 0.f, 0.f};
    v8i_t At[4], B0[2], B1[2];
    unsigned ua[2][2];
    LAS u32x4* nslot = (LAS u32x4*)(lds + RING_BYTES_C + 4096) + tid;
    PG8_AOFFS(ua, cur);
    const char* cB = uniform_ptr(cur.bptr);
    PG8_STAGEB(PG8_SB(0, 0), cB, voffB); PG8_STAGEB(PG8_SB(0, 1), cB + hstep, voffB); PG8_STAGEA(PG8_SA(0, 0), 0, ua[0]); PG8_STAGEA(PG8_SA(0, 1), 0, ua[1]);
    if (wr == 1) PG8_BAR;
    PG8_WAIT_V(2); PG8_BAR;
    PG8_STAGEB(PG8_SB(1, 0), cB + kstep, voffB); PG8_STAGEA(PG8_SA(1, 0), kstep, ua[0]); PG8_STAGEB(PG8_SB(1, 1), cB + hstep + kstep, voffB);
    PG8_WAIT_V(6); PG8_BAR;
    for (;;) {
        const bool has_next = S.next(ui + 1, nxt);
        {
            unsigned nua[2][2];
            if (has_next) { PG8_AOFFS(nua, nxt); } else {
#pragma unroll
                for (int h = 0; h < 2; ++h)
#pragma unroll
                    for (int i = 0; i < 2; ++i) nua[h][i] = ua[h][i]; }
            *nslot = (u32x4){nua[0][0], nua[0][1], nua[1][0], nua[1][1]};
        }
        const char* nB = uniform_ptr(has_next ? nxt.bptr : cB + (size_t)(nt - 2) * kstep);
        for (int t = 0; t < nt; t += 2) {
            const bool last = (t == nt - 2);
            const size_t k1 = (size_t)(t + 1) * kstep;
            const size_t k2 = last ? (has_next ? 0 : (size_t)(nt - 2) * kstep) : (size_t)(t + 2) * kstep, k3 = k2 + kstep;
            const char* b2 = last ? nB : cB + (size_t)(t + 2) * kstep; const char* b3 = b2 + kstep;
            asm volatile("" : "+v"(ua[0][0]), "+v"(ua[0][1]), "+v"(ua[1][0]), "+v"(ua[1][1]), "+v"(voffB[0]), "+v"(voffB[1]));
            unsigned a2o[2][2];
#pragma unroll
            for (int h = 0; h < 2; ++h)
#pragma unroll
                for (int i = 0; i < 2; ++i) a2o[h][i] = ua[h][i];
            if (last) { asm volatile("" ::: "memory"); const u32x4 nv = *nslot; a2o[0][0] = nv.x; a2o[0][1] = nv.y; a2o[1][0] = nv.z; a2o[1][1] = nv.w; }
            PG8_LDB(B0, 0, 0); PG8_LDB(B1, 0, 1); PG8_SCHED; PG8_LDA(At, 0, 0); PG8_STAGEA(PG8_SA(1, 1), k1, ua[1]);
            PG8_WAIT_V(8); PG8_WAIT_L(0); PG8_BAR; PG8_MMA(0, 0, At, B0); PG8_MMA(0, 1, At, B1); PG8_BAR; PG8_SCHED;
            PG8_LDA(At, 0, 1); PG8_STAGEB(PG8_SB(0, 0), b2, voffB); PG8_STAGEB(PG8_SB(0, 1), b2 + hstep, voffB); PG8_STAGEA(PG8_SA(0, 0), k2, a2o[0]);
            PG8_WAIT_V(8); PG8_WAIT_L(0); PG8_BAR; PG8_MMA(1, 0, At, B0); PG8_MMA(1, 1, At, B1); PG8_BAR; PG8_SCHED;
            PG8_LDB(B0, 1, 0); PG8_LDB(B1, 1, 1); PG8_SCHED; PG8_LDA(At, 1, 0); PG8_STAGEA(PG8_SA(0, 1), k2, a2o[1]);
            PG8_WAIT_V(8); PG8_WAIT_L(0); PG8_BAR; PG8_MMA(0, 0, At, B0); PG8_MMA(0, 1, At, B1); PG8_BAR; PG8_SCHED;
            PG8_LDA(At, 1, 1); PG8_STAGEB(PG8_SB(1, 0), b3, voffB); PG8_STAGEB(PG8_SB(1, 1), b3 + hstep, voffB); PG8_STAGEA(PG8_SA(1, 0), k3, a2o[0]);
            PG8_WAIT_V(8); PG8_WAIT_L(0); PG8_BAR; PG8_MMA(1, 0, At, B0); PG8_MMA(1, 1, At, B1); PG8_BAR; PG8_SCHED;
        }
        if constexpr (ALIGN_EPI) { if (wr == 0) PG8_BAR; }
        { const int _l = lane_id(); E(acc, cur, wr, wc, _l & 15, _l >> 4); }
        if (!has_next) break;
#pragma unroll
        for (int a = 0; a < 2; ++a)
#pragma unroll
            for (int b = 0; b < 2; ++b)
#pragma unroll
                for (int m = 0; m < 4; ++m)
#pragma unroll
                    for (int n = 0; n < 2; ++n) acc[a][b][m][n] = (f32x4){0.f, 0.f, 0.f, 0.f};
        cur = nxt; cB = nB; ++ui;
        { const u32x4 nv = *nslot; ua[0][0] = nv.x; ua[0][1] = nv.y; ua[1][0] = nv.z; ua[1][1] = nv.w; }
        if constexpr (ALIGN_EPI) { if (wr == 1) PG8_BAR; }
    }
    PG8_WAIT_V(0);
    if constexpr (!ALIGN_EPI) { if (wr == 0) PG8_BAR; }
    PG8_BAR;
#undef PG8_SA
#undef PG8_SB
#undef PG8_STAGEA
#undef PG8_STAGEB
#undef PG8_LDA
#undef PG8_LD8
#undef PG8_LO
#undef PG8_HI
#undef PG8_LDB
#undef PG8_MMA
#undef PG8_WAIT_V
#undef PG8_WAIT_L
#undef PG8_BAR
#undef PG8_SCHED
#undef PG8_AOFFS
}

struct EpiQKV {
    static constexpr bool PERM = true;
    bf16_t* O; const float* ropec; const float* ropes;
    __device__ __forceinline__ void operator()(const f32x4 (&acc)[2][2][4][2], const Unit& u, int wr, int wc, int fr, int fq) const {
        const int t = u.pn >> 2, colt = (u.pn & 3) * BM;
        bf16_t* base = O + (size_t)t * QKV_STRIDE;
        const int row0 = u.orow0 + wr * 64 + fr, col0 = colt + wc * 32 + 8 * fq;
        const float sc = (t == 0 || t == 3) ? C2 : 1.0f;
        const bool rope = t < 2;
        const int fi = 4 * (4 * (wc & 1) + fq);
        f32x4 cs[2][4], sn[2][4];
#pragma unroll
        for (int ai = 0; ai < 2; ++ai)
#pragma unroll
            for (int m = 0; m < 4; ++m) {
                cs[ai][m] = (f32x4){1.f, 1.f, 1.f, 1.f}; sn[ai][m] = (f32x4){0.f, 0.f, 0.f, 0.f};
                if (rope) { const int pos = (row0 + ai * HALF + m * 16) & (SEQ - 1); cs[ai][m] = *(const f32x4*)(ropec + pos * 32 + fi); sn[ai][m] = *(const f32x4*)(ropes + pos * 32 + fi); }
            }
#pragma unroll
        for (int ai = 0; ai < 2; ++ai)
#pragma unroll
            for (int m = 0; m < 4; ++m) {
                const int row = row0 + ai * HALF + m * 16;
                bf16_t* rowp = base + (size_t)row * GW + col0;
#pragma unroll
                for (int bj = 0; bj < 2; ++bj) {
                    const f32x4 x1 = acc[ai][bj][m][0], x2 = acc[ai][bj][m][1];
                    const f32x4 y1 = (x1 * cs[ai][m] - x2 * sn[ai][m]) * sc, y2 = (x2 * cs[ai][m] + x1 * sn[ai][m]) * sc;
                    u32x4 w; w.x = cvt_pk_bf16(y1[0], y1[1]); w.y = cvt_pk_bf16(y1[2], y1[3]); w.z = cvt_pk_bf16(y2[0], y2[1]); w.w = cvt_pk_bf16(y2[2], y2[3]);
                    *(u32x4*)(rowp + bj * HALF) = w;
                }
            }
    }
};

struct GroupedOrder {
    const LAS int* tab; int G, c, NT, total; const char* Bt; size_t bstride; int RB; const int* list; bool gather;
    const LAS int* rowtab;
    mutable int ecur;
    int ibase, iend;
    __device__ void init(const LAS int* tab_, int NT_, const void* Bt_, size_t bstride_bytes, int RB_, const int* list_, bool gather_, int G_, int c_, const LAS int* rowtab_) {
        tab = tab_; NT = NT_; Bt = (const char*)Bt_; bstride = bstride_bytes; RB = RB_; list = list_; gather = gather_; G = G_; c = c_; rowtab = rowtab_; ecur = 0; ibase = 0; iend = 0x7fffffff;
        total = __builtin_amdgcn_readfirstlane(tab_[96 + 32]) * NT_; }
    __device__ bool next(int i_, Unit& u) const {
        const int i = i_ + ibase; if (i >= iend) return false;
        const int L = i * G + c; if (L >= total) return false;
        int wgid = L; { const int q = total / NXCD, r = total % NXCD, xcd = wgid % NXCD, off = wgid / NXCD; wgid = (xcd < r ? xcd * (q + 1) : r * (q + 1) + (xcd - r) * q) + off; }
        int e = ecur;
        while (e + 1 < NEXP && wgid >= __builtin_amdgcn_readfirstlane(tab[96 + e + 1]) * NT) ++e;
        ecur = e;
        const int local = wgid - __builtin_amdgcn_readfirstlane(tab[96 + e]) * NT, nrb = __builtin_amdgcn_readfirstlane(tab[32 + e]);
        const int rb = local % nrb, pn = local / nrb, ps = __builtin_amdgcn_readfirstlane(tab[64 + e]), cn = __builtin_amdgcn_readfirstlane(tab[e]);
        u.e = __builtin_amdgcn_readfirstlane(e); u.pn = __builtin_amdgcn_readfirstlane(pn); u.orow0 = __builtin_amdgcn_readfirstlane(ps + rb * BM); u.arow0 = __builtin_amdgcn_readfirstlane(gather ? (e * NTOK + rb * BM) : (ps + rb * BM));
        u.nvalid = __builtin_amdgcn_readfirstlane(cn - rb * BM); u.bptr = uniform_ptr(Bt + (size_t)u.e * bstride + (size_t)u.pn * BM * RB); u.ui = i;
        return true;
    }
    __device__ __forceinline__ unsigned a_off(const Unit& u, int r) const {
        int row;
        if (gather) { if (u.ui < ROWTAB_UNITS) row = rowtab[u.ui * BM + r]; else { row = 0; if (r < u.nvalid) row = list[u.arow0 + r] >> 2; } } else row = u.arow0 + r;
        return (unsigned)row * (unsigned)RB;
    }
    __device__ __forceinline__ void fill_rowtab(LAS int* wtab, int tid) const {
        if (tid < BM) { Unit u; const int keep = ecur;
            for (int i = 0; i < ROWTAB_UNITS && next(i, u); ++i) wtab[i * BM + tid] = (tid < u.nvalid) ? (list[u.arow0 + tid] >> 2) : 0;
            ecur = keep; }
    }
};
struct EpiGateUp {
    static constexpr bool PERM = true;
    unsigned char* H1; const float* bg; const float* bu;
    __device__ __forceinline__ u32x2 row8(const f32x4 (&acc)[2][2][4][2], int ai, int m, const f32x4 (&bgv)[2], const f32x4 (&buv)[2]) const {
        f32x4 o[2];
#pragma unroll
        for (int n = 0; n < 2; ++n) {
            f32x4 g = acc[ai][0][m][n] * W8_INV + bgv[n], u1 = acc[ai][1][m][n] * W8_INV + buv[n];
#pragma unroll
            for (int j = 0; j < 4; ++j) { g[j] = fminf(g[j], 7.0f); u1[j] = fminf(fmaxf(u1[j], -6.0f), 8.0f); }
            const f32x4 t = g * (-1.702f * 1.4426950408889634f);
            f32x4 d;
#pragma unroll
            for (int j = 0; j < 4; ++j) d[j] = __builtin_amdgcn_exp2f(t[j]);
            d = d + 1.0f;
#pragma unroll
            for (int j = 0; j < 4; ++j) d[j] = __builtin_amdgcn_rcpf(d[j]);
            o[n] = (g * d) * u1;
        }
        u32x2 w; w.x = cvt_pk4_fp8(o[0][0], o[0][1], o[0][2], o[0][3]); w.y = cvt_pk4_fp8(o[1][0], o[1][1], o[1][2], o[1][3]); return w;
    }
    __device__ __forceinline__ void operator()(const f32x4 (&acc)[2][2][4][2], const Unit& u, int wr, int wc, int fr, int fq) const {
        const int row0 = u.orow0 + wr * 64 + fr, col0 = u.pn * HALF + wc * 32 + 8 * fq;
        const float* bgp = bg + (size_t)u.e * D_MODEL + col0; const float* bup = bu + (size_t)u.e * D_MODEL + col0;
        f32x4 bgv[2], buv[2];
#pragma unroll
        for (int n = 0; n < 2; ++n) { bgv[n] = *(const f32x4*)(bgp + 4 * n); buv[n] = *(const f32x4*)(bup + 4 * n) + 1.0f; }
        const int odd = fq & 1;
        unsigned char* lp = H1 + (size_t)(row0 + 16 * odd) * D_MODEL + col0 - 8 * odd;
#pragma unroll
        for (int ai = 0; ai < 2; ++ai)
#pragma unroll
            for (int m = 0; m < 4; m += 2) {
                const u32x2 a = row8(acc, ai, m, bgv, buv), b = row8(acc, ai, m + 1, bgv, buv);
                const auto rx = __builtin_amdgcn_permlane16_swap(a.x, b.x, false, false); const auto ry = __builtin_amdgcn_permlane16_swap(a.y, b.y, false, false);
                *(u32x4*)(lp + (size_t)(ai * HALF + m * 16) * D_MODEL) = (u32x4){rx[0], ry[0], rx[1], ry[1]};
            }
    }
};
struct EpiDown {
    static constexpr bool PERM = true;
    unsigned char* Y; const float* bd;
    __device__ __forceinline__ void operator()(const f32x4 (&acc)[2][2][4][2], const Unit& u, int wr, int wc, int fr, int fq) const {
        const int row0 = u.orow0 + wr * 64 + fr, col0 = u.pn * BM + wc * 32 + 8 * fq;
        const float* bp = bd + (size_t)u.e * D_MODEL + col0;
        f32x4 bv[2][2];
#pragma unroll
        for (int bj = 0; bj < 2; ++bj)
#pragma unroll
            for (int n = 0; n < 2; ++n) bv[bj][n] = *(const f32x4*)(bp + bj * HALF + 4 * n);
        const int odd = fq & 1;
        unsigned char* lp = Y + (size_t)(row0 + 16 * odd) * D_MODEL + col0 - 8 * odd;
#pragma unroll
        for (int ai = 0; ai < 2; ++ai)
#pragma unroll
            for (int m = 0; m < 4; m += 2)
#pragma unroll
                for (int bj = 0; bj < 2; ++bj) {
                    const f32x4 a0 = acc[ai][bj][m][0] * W8_INV + bv[bj][0], a1 = acc[ai][bj][m][1] * W8_INV + bv[bj][1];
                    const f32x4 b0 = acc[ai][bj][m + 1][0] * W8_INV + bv[bj][0], b1 = acc[ai][bj][m + 1][1] * W8_INV + bv[bj][1];
                    const unsigned ax = cvt_pk4_fp8(a0[0], a0[1], a0[2], a0[3]), ay = cvt_pk4_fp8(a1[0], a1[1], a1[2], a1[3]);
                    const unsigned bx = cvt_pk4_fp8(b0[0], b0[1], b0[2], b0[3]), by = cvt_pk4_fp8(b1[0], b1[1], b1[2], b1[3]);
                    const auto rx = __builtin_amdgcn_permlane16_swap(ax, bx, false, false); const auto ry = __builtin_amdgcn_permlane16_swap(ay, by, false, false);
                    *(u32x4*)(lp + (size_t)(ai * HALF + m * 16) * D_MODEL + bj * HALF) = (u32x4){rx[0], ry[0], rx[1], ry[1]};
                }
    }
};
struct EpiOut {
    static constexpr bool PERM = true;
    const float* x; bf16_t* X1;
    __device__ __forceinline__ void operator()(const f32x4 (&acc)[2][2][4][2], const Unit& u, int wr, int wc, int fr, int fq) const {
        const int row0 = u.orow0 + wr * 64 + fr, col0 = u.pn * BM + wc * 32 + 8 * fq;
#pragma unroll
        for (int ai = 0; ai < 2; ++ai) {
            f32x4 xr[4][2][2];
#pragma unroll
            for (int m = 0; m < 4; ++m)
#pragma unroll
                for (int bj = 0; bj < 2; ++bj)
#pragma unroll
                    for (int n = 0; n < 2; ++n) xr[m][bj][n] = *(const f32x4*)(x + (size_t)(row0 + ai * HALF + m * 16) * D_MODEL + col0 + bj * HALF + n * 4);
#pragma unroll
            for (int m = 0; m < 4; ++m)
#pragma unroll
                for (int bj = 0; bj < 2; ++bj) { const f32x4 v0 = xr[m][bj][0] + acc[ai][bj][m][0], v1 = xr[m][bj][1] + acc[ai][bj][m][1];
                    u32x4 w; w.x = cvt_pk_bf16(v0[0], v0[1]); w.y = cvt_pk_bf16(v0[2], v0[3]); w.z = cvt_pk_bf16(v1[0], v1[1]); w.w = cvt_pk_bf16(v1[2], v1[3]);
                    *(u32x4*)(X1 + (size_t)(row0 + ai * HALF + m * 16) * D_MODEL + col0 + bj * HALF) = w; }
        }
    }
};
}

constexpr int NWAVES = 8;
constexpr int RING_BYTES = 131072, MISC_OFF = RING_BYTES + 320, LDS_BYTES = 163840, ROWTAB_OFF = RING_BYTES + 16384;
struct Args { const float* in[16]; float* out; unsigned char* ws; int ph_lo, ph_hi; };
constexpr int NPHASE = 9;
#ifndef NCONV
#define NCONV 128
#endif

struct Frame {
    LAS unsigned char* lds; int vcu, G, wave; unsigned char* ws;
};

template <class RM>
__device__ __forceinline__ void conv_tile(const float* __restrict__ W, int N, bf16_t* __restrict__ Wt, int K, int kb, int nb, int lane, const RM& rm) {
    const int kg = lane & 7, ng = lane >> 3;
    const int k0 = kb * 64 + kg * 8, n0 = nb * 32 + ng * 4;
    f32x4 v[8];
#pragma unroll
    for (int j = 0; j < 8; ++j) v[j] = __builtin_nontemporal_load((const f32x4*)(W + (size_t)(k0 + j) * N + n0));
#pragma unroll
    for (int c = 0; c < 4; ++c) {
        u32x4 o; o.x = cvt_pk_bf16(v[0][c], v[1][c]); o.y = cvt_pk_bf16(v[2][c], v[3][c]); o.z = cvt_pk_bf16(v[4][c], v[5][c]); o.w = cvt_pk_bf16(v[6][c], v[7][c]);
        *(u32x4*)(Wt + (size_t)rm(n0 + c) * K + k0) = o;
    }
}
template <class RM>
__device__ __forceinline__ void conv_tile8(const float* __restrict__ W, int N, unsigned char* __restrict__ Wt, int K, int kb, int nb, int lane, const RM& rm) {
    const int kg = lane & 7, ng = lane >> 3;
    const int k0 = kb * 64 + kg * 8, n0 = nb * 32 + ng * 4;
    f32x4 v[8];
#pragma unroll
    for (int j = 0; j < 8; ++j) v[j] = __builtin_nontemporal_load((const f32x4*)(W + (size_t)(k0 + j) * N + n0)) * W8_SCALE;
#pragma unroll
    for (int c = 0; c < 4; ++c) {
        u32x2 o; o.x = cvt_pk4_fp8(v[0][c], v[1][c], v[2][c], v[3][c]); o.y = cvt_pk4_fp8(v[4][c], v[5][c], v[6][c], v[7][c]);
        *(u32x2*)(Wt + (size_t)rm(n0 + c) * K + k0) = o;
    }
}
struct RmIdent { __device__ __forceinline__ int operator()(int n) const { return n; } };
struct RmWin {
    __device__ __forceinline__ int operator()(int n) const { if (n >= 2048) return n; const int o = n & 63, a = (o & 31) >> 2, j = (o & 3) + ((o >> 5) << 2); return (n & ~63) + 8 * a + j; } };
struct RmGU { int up; __device__ __forceinline__ int operator()(int n) const { return 256 * (n >> 7) + 128 * up + (n & 127); } };

__device__ __forceinline__ void p0_prologue(const Frame& F, const Args& a) {
    unsigned char* ws = F.ws;
    const int tid_ = fresh_tid(F.wave), lane = tid_ & 63, wave_ = F.wave;
    const int gw = F.vcu * NWAVES + wave_, NGW = F.G * NWAVES;
    const float* x = a.in[0]; const float* attn_norm = a.in[1]; const float* w_in = a.in[2]; const float* w_out = a.in[5]; const float* w_router = a.in[7];
    {
        f32x4 gn[8];
#pragma unroll
        for (int j = 0; j < 8; ++j) gn[j] = *((const f32x4*)attn_norm + lane + 64 * j);
        for (int r0 = gw; r0 < NTOK; r0 += NGW * 4) {
            f32x4 v[4][8];
#pragma unroll
            for (int t = 0; t < 4; ++t) { const int r = (r0 + t * NGW < NTOK) ? r0 + t * NGW : r0; const f32x4* xr = (const f32x4*)(x + (size_t)r * D_MODEL) + lane;
#pragma unroll
                for (int j = 0; j < 8; ++j) v[t][j] = xr[64 * j]; }
#pragma unroll
            for (int t = 0; t < 4; ++t) { const int r = r0 + t * NGW; if (r < NTOK) {
                float s = 0.f;
#pragma unroll
                for (int j = 0; j < 8; ++j) s += (v[t][j].x * v[t][j].x + v[t][j].y * v[t][j].y) + (v[t][j].z * v[t][j].z + v[t][j].w * v[t][j].w);
                const float rstd = rsqrtf(wave_sum(s) * (1.f / D_MODEL) + EPS);
                u32x2* o = (u32x2*)((bf16_t*)(ws + WS_XN) + (size_t)r * D_MODEL) + lane;
#pragma unroll
                for (int j = 0; j < 8; ++j) { u32x2 w; w.x = cvt_pk_bf16(v[t][j].x * rstd * gn[j].x, v[t][j].y * rstd * gn[j].y); w.y = cvt_pk_bf16(v[t][j].z * rstd * gn[j].z, v[t][j].w * rstd * gn[j].w); o[64 * j] = w; } } }
        }
    }
    for (int i = gw * 64 + lane; i < SEQ * 32; i += NGW * 64) {
        const int pos = i >> 5, f = i & 31;
        const float inv_freq = 1.0f / powf(10000.0f, (float)f * 2.0f / 64.0f);
        const float ang = (float)pos * inv_freq;
        ((float*)(ws + WS_ROPEC))[i] = cosf(ang); ((float*)(ws + WS_ROPES))[i] = sinf(ang);
    }
    for (int i = gw * 64 + lane; i < NEXP * D_MODEL; i += NGW * 64) { const int e = i >> 11, k = i & 2047; ((float*)(ws + WS_WRT))[i] = w_router[(size_t)k * NEXP + e]; }
    constexpr int T_IN = 32 * 192, T_OUT = 32 * 64, T_E = 32 * 64;
    {
        const int kg = lane & 7, ng = lane >> 3;
        auto tile_of = [&](int it, const float*& W, int& N, bf16_t*& Wt, int& k0, int& n0, bool& win) {
            win = it < T_IN; const int r = win ? it : it - T_IN, nbk = win ? 192 : 64;
            W = win ? w_in : w_out; N = win ? INW : D_MODEL; Wt = (bf16_t*)(ws + (win ? WS_WIN : WS_WOUT)); k0 = (r / nbk) * 64 + kg * 8; n0 = (r % nbk) * 32 + ng * 4; };
        for (int it0 = gw; it0 < T_IN + T_OUT; it0 += NGW * 2) {
            f32x4 v[2][8];
#pragma unroll
            for (int t = 0; t < 2; ++t) { const int it = (it0 + t * NGW < T_IN + T_OUT) ? it0 + t * NGW : it0; const float* W; int N, k0, n0; bf16_t* Wt; bool win; tile_of(it, W, N, Wt, k0, n0, win);
#pragma unroll
                for (int j = 0; j < 8; ++j) v[t][j] = __builtin_nontemporal_load((const f32x4*)(W + (size_t)(k0 + j) * N + n0)); }
#pragma unroll
            for (int t = 0; t < 2; ++t) { const int it = it0 + t * NGW; if (it < T_IN + T_OUT) { const float* W; int N, k0, n0; bf16_t* Wt; bool win; tile_of(it, W, N, Wt, k0, n0, win);
#pragma unroll
                for (int c = 0; c < 4; ++c) {
                    u32x4 o; o.x = cvt_pk_bf16(v[t][0][c], v[t][1][c]); o.y = cvt_pk_bf16(v[t][2][c], v[t][3][c]); o.z = cvt_pk_bf16(v[t][4][c], v[t][5][c]); o.w = cvt_pk_bf16(v[t][6][c], v[t][7][c]);
                    const int n = n0 + c, row = win ? RmWin{}(n) : n;
                    *(u32x4*)(Wt + (size_t)row * D_MODEL + k0) = o; } } }
        }
    }
}

constexpr int CV_T_E = 32 * 64, CV_NTILES = 3 * NEXP * CV_T_E, CV_ITEM_TILES = 64, CV_NITEMS = CV_NTILES / CV_ITEM_TILES;
constexpr int CV_Q1 = 2 * NEXP * 32 + 256;
constexpr int LDS_QSLOT = RING_BYTES + 2048;
#define CV_BAR() do { asm volatile("s_waitcnt lgkmcnt(0)" ::: "memory"); __builtin_amdgcn_s_barrier(); asm volatile("" ::: "memory"); } while (0)
__device__ __forceinline__ void conv_items(const Frame& F, const Args& a, const unsigned* stop_word, unsigned stop_count, int limit, int nstatic = 0, int base = 0, int stride = 0, int extra = -1) {
    unsigned char* ws = F.ws;
    const int tid = fresh_tid(F.wave), lane = tid & 63;
    const float* w_gate = a.in[9]; const float* w_up = a.in[11]; const float* w_down = a.in[13];
    unsigned* qn = (unsigned*)(ws + WS_CTL) + CW_CONVQ;
    LAS int* s_item = (LAS int*)(F.lds + LDS_QSLOT);
    for (int jj = 0;; ++jj) {
        int item;
        if (nstatic > 0) { if (jj >= nstatic) break; item = (extra >= 0 && jj == nstatic - 1) ? extra : base + jj * stride; }
        else {
            if (tid == 0) {
                int it = -1;
                const bool stop = stop_word && __hip_atomic_load(stop_word, __ATOMIC_RELAXED, __HIP_MEMORY_SCOPE_AGENT) >= stop_count;
                if (!stop) it = (int)__hip_atomic_fetch_add(qn, 1u, __ATOMIC_RELAXED, __HIP_MEMORY_SCOPE_AGENT);
                *s_item = it;
            }
            CV_BAR();
            item = __builtin_amdgcn_readfirstlane(*s_item);
            CV_BAR();
        }
        if (item < 0 || item >= limit) break;
        const int mat = item / (NEXP * 32), r = item - mat * (NEXP * 32), e = r >> 5, kb = (r >> 1) & 15, nh = r & 1;
        const int kh = F.wave >> 2, wq = F.wave & 3;
        const float* W = (mat == 0 ? w_gate : mat == 1 ? w_up : w_down) + (size_t)e * D_MODEL * D_MODEL;
        const float* s = W + (size_t)(kb * 128 + kh * 64) * D_MODEL + nh * 1024 + wq * 256 + lane * 4;
        unsigned char* dst = ((mat == 2) ? (ws + WS_WD + (size_t)e * D_MODEL * D_MODEL) : (ws + WS_WGU + (size_t)e * 4096 * D_MODEL)) + kb * 128;
        LAS unsigned char* T = F.lds;
        const int nl = wq * 256 + lane * 4, fz = lane & 15;
        constexpr int CVD = 3;
        f32x4 v[CVD][8];
#pragma unroll
        for (int d = 0; d < CVD - 1; ++d)
#pragma unroll
            for (int j = 0; j < 8; ++j) v[d][j] = __builtin_nontemporal_load((const f32x4*)(s + (size_t)(d * 8 + j) * D_MODEL));
#pragma unroll
        for (int st = 0; st < 8; ++st) {
            if (st + CVD - 1 < 8) {
#pragma unroll
                for (int j = 0; j < 8; ++j) v[(st + CVD - 1) % CVD][j] = __builtin_nontemporal_load((const f32x4*)(s + (size_t)((st + CVD - 1) * 8 + j) * D_MODEL)); }
            __builtin_amdgcn_sched_barrier(0);
            const f32x4* vv = v[st % CVD];
#pragma unroll
            for (int c = 0; c < 4; ++c) {
                u32x2 o; o.x = cvt_pk4_fp8(vv[0][c] * W8_SCALE, vv[1][c] * W8_SCALE, vv[2][c] * W8_SCALE, vv[3][c] * W8_SCALE); o.y = cvt_pk4_fp8(vv[4][c] * W8_SCALE, vv[5][c] * W8_SCALE, vv[6][c] * W8_SCALE, vv[7][c] * W8_SCALE);
                *(LAS u32x2*)(T + (nl + c) * 128 + (((kh * 8 + st) ^ fz) * 8)) = o;
            }
            __builtin_amdgcn_sched_barrier(0);
        }
        CV_BAR();
#pragma unroll
        for (int i = 0; i < 16; ++i) {
            const int id = tid + 512 * i, nn = id >> 3, q = id & 7, f = (nn >> 2) & 15, n = nh * 1024 + nn;
            u32x4 d = *(const LAS u32x4*)(T + nn * 128 + (((2 * q) ^ (f & 14)) * 8));
            if (f & 1) d = (u32x4){d.z, d.w, d.x, d.y};
            const int row = (mat == 2) ? n : (256 * (n >> 7) + 128 * mat + (n & 127));
            __builtin_nontemporal_store(d, (u32x4*)(dst + (size_t)row * D_MODEL + 16 * q));
        }
        CV_BAR();
    }
}

#undef CV_BAR
namespace attn {
typedef float f32x16 __attribute__((ext_vector_type(16)));
typedef short s16x4 __attribute__((ext_vector_type(4)));
typedef short v4i16_t __attribute__((ext_vector_type(4)));
#define MFMA32(a, b, c) __builtin_amdgcn_mfma_f32_32x32x16_bf16(a, b, c, 0, 0, 0)
__device__ __forceinline__ int crow(int r, int hi) { return (r & 3) + 8 * (r >> 2) + 4 * hi; }
__device__ __forceinline__ s16x4 vtr(const LAS unsigned char* p) { return __builtin_bit_cast(s16x4, __builtin_amdgcn_ds_read_tr16_b64_v4i16((LAS v4i16_t*)p)); }
__device__ __forceinline__ float xhalf(float v) {
    auto rr = __builtin_amdgcn_permlane32_swap(__float_as_uint(v), __float_as_uint(v), false, false);
    return (lane_id() & 32) ? __uint_as_float(rr[0]) : __uint_as_float(rr[1]);
}
__device__ __forceinline__ bf16x8 pack8(const f32x16& p, int ks) {
    u32x4 w; w.x = cvt_pk_bf16(p[8 * ks + 0], p[8 * ks + 1]); w.y = cvt_pk_bf16(p[8 * ks + 2], p[8 * ks + 3]); w.z = cvt_pk_bf16(p[8 * ks + 4], p[8 * ks + 5]); w.w = cvt_pk_bf16(p[8 * ks + 6], p[8 * ks + 7]);
    return __builtin_bit_cast(bf16x8, w);
}
__device__ __forceinline__ bf16x8 cat44(s16x4 lo, s16x4 hi) { bf16x8 r; r[0] = lo[0]; r[1] = lo[1]; r[2] = lo[2]; r[3] = lo[3]; r[4] = hi[0]; r[5] = hi[1]; r[6] = hi[2]; r[7] = hi[3]; return r; }
__device__ __forceinline__ void store_ot(const f32x16 (&O)[2], float scale, bf16_t* orow, int hi) {
#pragma unroll
    for (int dh = 0; dh < 2; ++dh)
#pragma unroll
        for (int g = 0; g < 4; g += 2) {
            unsigned ax = cvt_pk_bf16(O[dh][4 * g] * scale, O[dh][4 * g + 1] * scale), ay = cvt_pk_bf16(O[dh][4 * g + 2] * scale, O[dh][4 * g + 3] * scale);
            unsigned bx = cvt_pk_bf16(O[dh][4 * g + 4] * scale, O[dh][4 * g + 5] * scale), by = cvt_pk_bf16(O[dh][4 * g + 6] * scale, O[dh][4 * g + 7] * scale);
            const auto rx = __builtin_amdgcn_permlane32_swap(ax, bx, false, false); const auto ry = __builtin_amdgcn_permlane32_swap(ay, by, false, false);
            *(u32x4*)(orow + 32 * dh + 8 * g + 8 * hi) = (u32x4){rx[0], ry[0], rx[1], ry[1]};
        }
}

constexpr int DA_ROWS = 384, DA_KPL = (DA_ROWS + 1) * 16, DA_VHL = DA_ROWS * 64 + 64, DA_VOFF = 8 * DA_KPL, DA_LDS = DA_VOFF + 2 * DA_VHL;
struct DaUnit { int b, h, p, ib; };
struct DaRegs { u32x4 kv[6], vv[6]; bf16x8 qf[4]; int tokq, uq; };
__device__ __forceinline__ void da_load(DaRegs& R, const bf16_t* __restrict__ QD, const bf16_t* __restrict__ KD, const bf16_t* __restrict__ VD, const DaUnit& u, int tid) {
    const int lane = tid & 63, wid = __builtin_amdgcn_readfirstlane(tid >> 6), r32 = lane & 31, hi = lane >> 5;
    const int lgL = 11 - 2 * u.p, dsh = 2 * u.p, Lm1 = (1 << lgL) - 1, i0 = u.ib * 256;
#pragma unroll
    for (int t = 0; t < 6; ++t) {
        const int idx = tid + 512 * t, j = idx >> 3, c = idx & 7, ip = i0 - 128 + j;
        R.kv[t] = (u32x4){0u, 0u, 0u, 0u}; R.vv[t] = (u32x4){0u, 0u, 0u, 0u};
        if (ip >= 0) { const int pos = ((ip & Lm1) << dsh) + (ip >> lgL); const size_t go = (size_t)(u.b * SEQ + pos) * GW + u.h * 64 + c * 8; R.kv[t] = *(const u32x4*)(KD + go); R.vv[t] = *(const u32x4*)(VD + go); }
    }
    const int iq = i0 + 32 * wid + r32; R.uq = iq & Lm1; R.tokq = u.b * SEQ + (R.uq << dsh) + (iq >> lgL);
#pragma unroll
    for (int d0 = 0; d0 < 4; ++d0) R.qf[d0] = *(const bf16x8*)(QD + (size_t)R.tokq * GW + u.h * 64 + 16 * d0 + 8 * hi);
}
__device__ __forceinline__ void da_fill(LAS unsigned char* lds, const DaRegs& R, int tid) {
#pragma unroll
    for (int t = 0; t < 6; ++t) {
        const int idx = tid + 512 * t, j = idx >> 3, c = idx & 7;
        *(LAS u32x4*)(lds + c * DA_KPL + j * 16) = R.kv[t];
        *(LAS u32x4*)(lds + DA_VOFF + (c >> 2) * DA_VHL + j * 64 + (c & 3) * 16) = R.vv[t];
    }
}
__device__ __forceinline__ void da_compute(const LAS unsigned char* lds, const bf16x8 (&qf)[4], int tokq, int uq, bf16_t* __restrict__ OP, float* __restrict__ LSE, int h, int p, int tid) {
    const int lane = tid & 63, wid = __builtin_amdgcn_readfirstlane(tid >> 6), r32 = lane & 31, hi = lane >> 5;
    f32x16 S[5];
#pragma unroll
    for (int s = 0; s < 5; ++s) {
        S[s] = (f32x16){};
#pragma unroll
        for (int d0 = 0; d0 < 4; ++d0) { const bf16x8 kf = *(const LAS bf16x8*)(lds + (2 * d0 + hi) * DA_KPL + (32 * wid + 32 * s + r32) * 16); S[s] = MFMA32(kf, qf[d0], S[s]); }
    }
    const int lim = uq < 128 ? uq : 128, lv = r32 - 4 * hi;
    float mx = -INFINITY;
#pragma unroll
    for (int s = 0; s < 5; ++s)
#pragma unroll
        for (int r = 0; r < 16; ++r) { const int dist = lv + (128 - 32 * s - ((r & 3) + 8 * (r >> 2))); const bool ok = (dist >= 0) && (dist <= lim); const float v = ok ? S[s][r] : -INFINITY; S[s][r] = v; mx = fmaxf(mx, v); }
    mx = fmaxf(mx, xhalf(mx));
    float l = 0.f;
#pragma unroll
    for (int s = 0; s < 5; ++s)
#pragma unroll
        for (int r = 0; r < 16; ++r) { const float pv = __builtin_amdgcn_exp2f(S[s][r] - mx); S[s][r] = pv; l += pv; }
    l += xhalf(l);
    f32x16 O[2]; O[0] = (f32x16){}; O[1] = (f32x16){};
    const LAS unsigned char* vb = lds + DA_VOFF + (32 * wid + 4 * hi + ((lane & 15) >> 2)) * 64 + ((lane >> 4) & 1) * 32 + (lane & 3) * 8;
#pragma unroll
    for (int s = 0; s < 5; ++s)
#pragma unroll
        for (int ks = 0; ks < 2; ++ks) {
            const bf16x8 pb = pack8(S[s], ks);
#pragma unroll
            for (int dh = 0; dh < 2; ++dh) { const LAS unsigned char* a = vb + dh * DA_VHL + (32 * s + 16 * ks) * 64; O[dh] = MFMA32(cat44(vtr(a), vtr(a + 512)), pb, O[dh]); }
        }
    store_ot(O, 1.0f / l, OP + ((size_t)p * NTOK + tokq) * GW + h * 64, hi);
    if (hi == 0) LSE[((size_t)p * NTOK + tokq) * NH + h] = mx + __builtin_amdgcn_logf(l);
}

constexpr int SB_ROWS = 448, SB_KPL = (SB_ROWS + 1) * 16, SB_VHL = SB_ROWS * 64 + 64, SB_VOFF = 8 * SB_KPL, SB_LDS = SB_VOFF + 2 * SB_VHL, SB_FLAGS = SB_LDS;
static_assert(SB_LDS + 64 <= 131072, "stick-breaking chunk image fits the phase scratch region");
__device__ __forceinline__ void sb_unit(LAS unsigned char* lds, const bf16_t* __restrict__ QS, const bf16_t* __restrict__ KS, const bf16_t* __restrict__ VS, bf16_t* __restrict__ OSB,
                                        int b, int h, int qb, int tid) {
    const int lane = tid & 63, wid = __builtin_amdgcn_readfirstlane(tid >> 6), r32 = lane & 31, hi = lane >> 5;
    const int t0w = 256 * qb + 32 * wid, tq = t0w + r32, tokq = b * SEQ + tq;
    bf16x8 qf[4];
#pragma unroll
    for (int d0 = 0; d0 < 4; ++d0) qf[d0] = *(const bf16x8*)(QS + (size_t)tokq * GW + h * 64 + 16 * d0 + 8 * hi);
    f32x16 O[2]; O[0] = (f32x16){}; O[1] = (f32x16){};
    float C = 0.f;
    bool done = false;
    const int vlane = (4 * hi + ((lane & 15) >> 2)) * 64 + ((lane >> 4) & 1) * 32 + (lane & 3) * 8;
    LAS int* s_need = (LAS int*)(lds + SB_FLAGS);
    int khi = 256 * qb + 255;
    for (;;) {
        const int klo = (khi - (SB_ROWS - 1)) > 0 ? (khi - (SB_ROWS - 1)) : 0, nrows = khi - klo + 1;
        {
            u32x4 kr[7], vr[7];
#pragma unroll
            for (int t = 0; t < 7; ++t) { const int idx = tid + 512 * t, j = idx >> 3, c = idx & 7;
                kr[t] = (u32x4){0u, 0u, 0u, 0u}; vr[t] = (u32x4){0u, 0u, 0u, 0u};
                if (j < nrows) { const size_t go = (size_t)(b * SEQ + klo + j) * GW + h * 64 + c * 8; kr[t] = *(const u32x4*)(KS + go); vr[t] = *(const u32x4*)(VS + go); } }
#pragma unroll
            for (int t = 0; t < 7; ++t) { const int idx = tid + 512 * t, j = idx >> 3, c = idx & 7;
                *(LAS u32x4*)(lds + c * SB_KPL + j * 16) = kr[t]; *(LAS u32x4*)(lds + SB_VOFF + (c >> 2) * SB_VHL + j * 64 + (c & 3) * 16) = vr[t]; }
        }
        __syncthreads();
        if (!done) {
            for (int kt = khi >> 6; kt >= (klo >> 6); --kt) {
                if (64 * kt > t0w + 30) continue;
                const bool diag = (64 * kt + 63 >= t0w);
                const LAS unsigned char* kb = lds + (64 * kt - klo) * 16; const LAS unsigned char* vb = lds + SB_VOFF + (64 * kt - klo) * 64 + vlane;
#pragma unroll
                for (int sub = 1; sub >= 0; --sub) {
                    const int keyb = 64 * kt + 32 * sub;
                    if (keyb > t0w + 30) continue;
                    f32x16 Z = (f32x16){};
#pragma unroll
                    for (int d0 = 0; d0 < 4; ++d0) { const bf16x8 kf = *(const LAS bf16x8*)(kb + (2 * d0 + hi) * SB_KPL + (32 * sub + r32) * 16); Z = MFMA32(kf, qf[d0], Z); }
                    const int kl = keyb + 4 * hi;
                    float sp[16];
#pragma unroll
                    for (int r = 0; r < 16; ++r) { const float e = __builtin_amdgcn_exp2f(Z[r]); float v = __builtin_amdgcn_logf(1.0f + e); if (diag) { const bool ok = (kl + (r & 3) + 8 * (r >> 2)) < tq; v = ok ? v : 0.f; } sp[r] = v; }
                    float own[4], oth[4];
#pragma unroll
                    for (int g = 0; g < 4; ++g) { sp[4 * g + 2] += sp[4 * g + 3]; sp[4 * g + 1] += sp[4 * g + 2]; sp[4 * g] += sp[4 * g + 1]; own[g] = sp[4 * g]; oth[g] = xhalf(own[g]); }
                    float off[4]; float run = C;
#pragma unroll
                    for (int g = 3; g >= 0; --g) { off[g] = run + (hi == 0 ? oth[g] : 0.f); run += own[g] + oth[g]; }
                    C = run;
#pragma unroll
                    for (int r = 0; r < 16; ++r) { float a = __builtin_amdgcn_exp2f(Z[r] - (off[r >> 2] + sp[r])); if (diag) { const bool ok = (kl + (r & 3) + 8 * (r >> 2)) < tq; a = ok ? a : 0.f; } Z[r] = a; }
#pragma unroll
                    for (int ks = 0; ks < 2; ++ks) {
                        const bf16x8 pb = pack8(Z, ks);
#pragma unroll
                        for (int dh = 0; dh < 2; ++dh) { const LAS unsigned char* a = vb + dh * SB_VHL + (32 * sub + 16 * ks) * 64; O[dh] = MFMA32(cat44(vtr(a), vtr(a + 512)), pb, O[dh]); }
                    }
                }
                float cm = C;
#pragma unroll
                for (int o = 1; o < 32; o <<= 1) cm = fminf(cm, __shfl_xor(cm, o));
                if (__builtin_amdgcn_readfirstlane(__float_as_int(cm)) >= __float_as_int(150.0f)) { done = true; break; }
            }
        }
        if (lane == 0) s_need[wid] = (!done && klo > 0) ? 1 : 0;
        __syncthreads();
        int any = 0;
#pragma unroll
        for (int i = 0; i < 8; ++i) any |= s_need[i];
        __syncthreads();
        if (!any) break;
        khi = klo - 1;
    }
    store_ot(O, 1.0f, OSB + (size_t)tokq * GW + h * 64, hi);
}
#undef MFMA32
}

__device__ __forceinline__ void p3_combine(const Frame& F, const Args& a) {
    unsigned char* ws = F.ws;
    const int tid_ = fresh_tid(F.wave), lane = tid_ & 63, wave_ = F.wave;
    const int gw = F.vcu * NWAVES + wave_, NGW = F.G * NWAVES;
    const bf16_t* OP = (const bf16_t*)(ws + WS_OP); const bf16_t* OSB = (const bf16_t*)(ws + WS_OSB); const float* LSE = (const float*)(ws + WS_LSE);
    bf16_t* ACAT = (bf16_t*)(ws + WS_ACAT);
    const float* gd = a.in[3]; const float* gs = a.in[4];
    const int hq[2] = {lane >> 3, 8 + (lane >> 3)};
    float gdv[16], gsv[16];
#pragma unroll
    for (int q = 0; q < 2; ++q)
#pragma unroll
        for (int j = 0; j < 8; ++j) { gdv[8 * q + j] = gd[512 * q + lane * 8 + j]; gsv[8 * q + j] = gs[512 * q + lane * 8 + j]; }
    constexpr int TB = 4;
    for (int tok0 = gw; tok0 < NTOK; tok0 += NGW * TB) {
        u32x4 ra[TB][4][2]; float ls[TB][3][2];
#pragma unroll
        for (int t = 0; t < TB; ++t) { const int tok = tok0 + t * NGW; if (tok < NTOK) {
#pragma unroll
            for (int p = 0; p < 3; ++p) { const float* lp = LSE + ((size_t)p * NTOK + tok) * NH; ls[t][p][0] = lp[hq[0]]; ls[t][p][1] = lp[hq[1]];
                const u32x4* pp = (const u32x4*)(OP + ((size_t)p * NTOK + tok) * GW); ra[t][p][0] = pp[lane]; ra[t][p][1] = pp[64 + lane]; }
            const u32x4* ps = (const u32x4*)(OSB + (size_t)tok * GW); ra[t][3][0] = ps[lane]; ra[t][3][1] = ps[64 + lane]; } }
#pragma unroll
        for (int t = 0; t < TB; ++t) { const int tok = tok0 + t * NGW; if (tok < NTOK) {
            float od[16], os[16];
#pragma unroll
            for (int q = 0; q < 2; ++q) {
                const float mx = fmaxf(ls[t][0][q], fmaxf(ls[t][1][q], ls[t][2][q]));
                float w0 = __builtin_amdgcn_exp2f(ls[t][0][q] - mx), w1 = __builtin_amdgcn_exp2f(ls[t][1][q] - mx), w2 = __builtin_amdgcn_exp2f(ls[t][2][q] - mx);
                const float inv = 1.0f / (w0 + w1 + w2); w0 *= inv; w1 *= inv; w2 *= inv;
                const u32x4 a0 = ra[t][0][q], a1 = ra[t][1][q], a2 = ra[t][2][q], as = ra[t][3][q];
#pragma unroll
                for (int j = 0; j < 4; ++j) {
                    od[8 * q + 2 * j] = w0 * __uint_as_float(a0[j] << 16) + w1 * __uint_as_float(a1[j] << 16) + w2 * __uint_as_float(a2[j] << 16);
                    od[8 * q + 2 * j + 1] = w0 * __uint_as_float(a0[j] & 0xffff0000u) + w1 * __uint_as_float(a1[j] & 0xffff0000u) + w2 * __uint_as_float(a2[j] & 0xffff0000u);
                    os[8 * q + 2 * j] = __uint_as_float(as[j] << 16); os[8 * q + 2 * j + 1] = __uint_as_float(as[j] & 0xffff0000u); } }
            float sd = 0.f, ss = 0.f;
#pragma unroll
            for (int j = 0; j < 16; ++j) { sd += od[j] * od[j]; ss += os[j] * os[j]; }
            const float rd = rsqrtf(wave_sum(sd) * (1.0f / GW) + EPS), rs = rsqrtf(wave_sum(ss) * (1.0f / GW) + EPS);
#pragma unroll
            for (int q = 0; q < 2; ++q) {
                u32x4 wd, wsb;
#pragma unroll
                for (int j = 0; j < 4; ++j) {
                    wd[j] = cvt_pk_bf16(od[8 * q + 2 * j] * rd * gdv[8 * q + 2 * j], od[8 * q + 2 * j + 1] * rd * gdv[8 * q + 2 * j + 1]);
                    wsb[j] = cvt_pk_bf16(os[8 * q + 2 * j] * rs * gsv[8 * q + 2 * j], os[8 * q + 2 * j + 1] * rs * gsv[8 * q + 2 * j + 1]); }
                *(u32x4*)(ACAT + (size_t)tok * D_MODEL + 512 * q + lane * 8) = wd;
                *(u32x4*)(ACAT + (size_t)tok * D_MODEL + GW + 512 * q + lane * 8) = wsb;
            } } }
    }
}

constexpr int ATT_NSB = BATCH * NH * 8, ATT_NDA = BATCH * NH * 3 * 8, ATT_NTOT = ATT_NSB + ATT_NDA;
__device__ __forceinline__ int att_grab(const Frame& F, int tid) {
    LAS int* s_item = (LAS int*)(F.lds + LDS_QSLOT);
    __syncthreads();
    if (tid == 0) *s_item = (int)__hip_atomic_fetch_add((unsigned*)(F.ws + WS_CTL) + CW_ATTQ, 1u, __ATOMIC_RELAXED, __HIP_MEMORY_SCOPE_AGENT);
    __syncthreads();
    return __builtin_amdgcn_readfirstlane(*s_item);
}
__device__ __forceinline__ void p2_attention(const Frame& F) {
    unsigned char* ws = F.ws; const int tid = fresh_tid(F.wave);
    const bf16_t* QKV = (const bf16_t*)(ws + WS_QKV);
    const bf16_t *QD = QKV, *KD = QKV + QKV_STRIDE, *VD = QKV + 2 * QKV_STRIDE, *QS = QKV + 3 * QKV_STRIDE, *KS = QKV + 4 * QKV_STRIDE, *VS = QKV + 5 * QKV_STRIDE;
    auto da_of = [](int id) { attn::DaUnit u; const int uid = id - ATT_NSB, pq = uid >> 3, bh = pq / 3; u.ib = uid & 7; u.p = pq % 3; u.b = bh >> 4; u.h = bh & 15; return u; };
    int cur = att_grab(F, tid);
    while (cur < ATT_NSB) {
        const int bh = cur >> 3; attn::sb_unit(F.lds, QS, KS, VS, (bf16_t*)(ws + WS_OSB), bh >> 4, bh & 15, 7 - (cur & 7), tid);
        cur = att_grab(F, tid);
    }
    if (cur < ATT_NTOT) {
        attn::DaRegs R;
        attn::da_load(R, QD, KD, VD, da_of(cur), tid);
        while (cur < ATT_NTOT) {
            const int nxt = att_grab(F, tid);
            const attn::DaUnit u = da_of(cur);
            attn::da_fill(F.lds, R, tid);
            bf16x8 qf[4]; qf[0] = R.qf[0]; qf[1] = R.qf[1]; qf[2] = R.qf[2]; qf[3] = R.qf[3];
            const int tokq = R.tokq, uq = R.uq;
            __syncthreads();
            if (nxt < ATT_NTOT) attn::da_load(R, QD, KD, VD, da_of(nxt), tid);
            attn::da_compute(F.lds, qf, tokq, uq, (bf16_t*)(ws + WS_OP), (float*)(ws + WS_LSE), u.h, u.p, tid);
            __syncthreads();
            cur = nxt;
        }
    }
}

constexpr int RT_RSTD = 0, RT_PART = 256, RT_LG = RT_PART + 8 * 32 * 32 * 4, RT_HIST = RT_LG + 32 * 33 * 4 + 4, RT_BASE = RT_HIST + 128, RT_SELE = RT_BASE + 128, RT_SELR = RT_SELE + 512, RT_SELG = RT_SELR + 512;
__device__ __forceinline__ void p5_router(const Frame& F, const Args& a) {
    unsigned char* ws = F.ws; LAS unsigned char* lds = F.lds;
    const int tid = fresh_tid(F.wave), lane = tid & 63, w = F.wave;
    const bf16_t* X1 = (const bf16_t*)(ws + WS_X1); const float* gain = a.in[6]; const float* wrT = (const float*)(ws + WS_WRT); const float* br = a.in[8];
    unsigned char* H2 = ws + WS_H2;
    int* cnt = (int*)(ws + WS_CTL) + CW_CNT; int* list = (int*)(ws + WS_LIST); int* a_exp = (int*)(ws + WS_AEXP); int* a_rank = (int*)(ws + WS_ARANK); float* a_gate = (float*)(ws + WS_AGATE);
    LAS float* s_rstd = (LAS float*)(lds + RT_RSTD); LAS float* s_part = (LAS float*)(lds + RT_PART); LAS float* s_lg = (LAS float*)(lds + RT_LG);
    LAS int* s_hist = (LAS int*)(lds + RT_HIST); LAS int* s_base = (LAS int*)(lds + RT_BASE); LAS int* s_sele = (LAS int*)(lds + RT_SELE); LAS int* s_selr = (LAS int*)(lds + RT_SELR); LAS float* s_selg = (LAS float*)(lds + RT_SELG);
    for (int it = F.vcu; it < NTOK / 32; it += F.G) {
        const int tok0 = it * 32;
        if (tid < 32) s_hist[tid] = 0;
#pragma unroll
        for (int q = 0; q < 4; ++q) {
            const u32x4* xr = (const u32x4*)(X1 + (size_t)(tok0 + 4 * w + q) * D_MODEL) + lane; float s = 0.f;
#pragma unroll
            for (int j = 0; j < 4; ++j) { const u32x4 v = xr[64 * j];
#pragma unroll
                for (int i = 0; i < 4; ++i) { const float lo = __uint_as_float(v[i] << 16), hi = __uint_as_float(v[i] & 0xffff0000u); s += lo * lo + hi * hi; } }
            s = wave_sum(s);
            if (lane == 0) s_rstd[4 * w + q] = rsqrtf(s * (1.0f / D_MODEL) + EPS);
        }
        __syncthreads();
        {
            const int tr = lane & 15, kq = lane >> 4;
            const float r0 = s_rstd[tr], r1 = s_rstd[16 + tr];
            f32x4 acc[2][2];
#pragma unroll
            for (int tt = 0; tt < 2; ++tt)
#pragma unroll
                for (int eh = 0; eh < 2; ++eh) acc[tt][eh] = (f32x4){0.f, 0.f, 0.f, 0.f};
            unsigned ha[4], hb[4];
#pragma unroll 4
            for (int ls = 0; ls < 16; ++ls) {
                const int k = 256 * w + 64 * (ls >> 2) + 16 * kq + 4 * (ls & 3);
                const f32x4 g = *(const f32x4*)(gain + k);
                f32x4 xa, xb;
                { const u32x2 ra = *(const u32x2*)(X1 + (size_t)(tok0 + tr) * D_MODEL + k), rb = *(const u32x2*)(X1 + (size_t)(tok0 + 16 + tr) * D_MODEL + k);
                  xa = (f32x4){__uint_as_float(ra.x << 16), __uint_as_float(ra.x & 0xffff0000u), __uint_as_float(ra.y << 16), __uint_as_float(ra.y & 0xffff0000u)};
                  xb = (f32x4){__uint_as_float(rb.x << 16), __uint_as_float(rb.x & 0xffff0000u), __uint_as_float(rb.y << 16), __uint_as_float(rb.y & 0xffff0000u)}; }
                const f32x4 b0 = *(const f32x4*)(wrT + (size_t)(lane & 15) * D_MODEL + k), b1 = *(const f32x4*)(wrT + (size_t)(16 + (lane & 15)) * D_MODEL + k);
                xa = xa * r0 * g; xb = xb * r1 * g;
                ha[ls & 3] = cvt_pk4_fp8(xa.x, xa.y, xa.z, xa.w); hb[ls & 3] = cvt_pk4_fp8(xb.x, xb.y, xb.z, xb.w);
                if ((ls & 3) == 3) { const int ks = k - 12;
                    *(u32x4*)(H2 + (size_t)(tok0 + tr) * D_MODEL + ks) = (u32x4){ha[0], ha[1], ha[2], ha[3]}; *(u32x4*)(H2 + (size_t)(tok0 + 16 + tr) * D_MODEL + ks) = (u32x4){hb[0], hb[1], hb[2], hb[3]}; }
#pragma unroll
                for (int j = 0; j < 4; ++j) {
                    acc[0][0] = __builtin_amdgcn_mfma_f32_16x16x4f32(xa[j], b0[j], acc[0][0], 0, 0, 0); acc[0][1] = __builtin_amdgcn_mfma_f32_16x16x4f32(xa[j], b1[j], acc[0][1], 0, 0, 0);
                    acc[1][0] = __builtin_amdgcn_mfma_f32_16x16x4f32(xb[j], b0[j], acc[1][0], 0, 0, 0); acc[1][1] = __builtin_amdgcn_mfma_f32_16x16x4f32(xb[j], b1[j], acc[1][1], 0, 0, 0);
                }
            }
#pragma unroll
            for (int tt = 0; tt < 2; ++tt)
#pragma unroll
                for (int eh = 0; eh < 2; ++eh)
#pragma unroll
                    for (int rg = 0; rg < 4; ++rg) s_part[(w * 32 + 16 * tt + 4 * kq + rg) * 32 + 16 * eh + (lane & 15)] = acc[tt][eh][rg];
        }
        __syncthreads();
        { const int t = tid >> 4, e2 = (tid & 15) * 2;
#pragma unroll
          for (int q = 0; q < 2; ++q) { float v = br[e2 + q];
#pragma unroll
              for (int ww = 0; ww < 8; ++ww) v += s_part[(ww * 32 + t) * 32 + e2 + q];
              s_lg[t * 33 + e2 + q] = v; } }
        __syncthreads();
        if (tid < 32) {
            unsigned used = 0u; float val[4]; int idx[4];
#pragma unroll
            for (int k = 0; k < 4; ++k) { int bi = 0; float bv = -INFINITY;
                for (int i = 0; i < 32; ++i) { const float v = s_lg[tid * 33 + i]; if (!((used >> i) & 1u) && v > bv) { bv = v; bi = i; } }
                used |= 1u << bi; idx[k] = bi; val[k] = bv; }
            float ex[4], sm = 0.f;
#pragma unroll
            for (int k = 0; k < 4; ++k) { ex[k] = expf(val[k] - val[0]); sm += ex[k]; }
#pragma unroll
            for (int k = 0; k < 4; ++k) { s_sele[tid * 4 + k] = idx[k]; s_selr[tid * 4 + k] = atomicAdd((int*)&s_hist[idx[k]], 1); s_selg[tid * 4 + k] = ex[k] / sm; }
        }
        __syncthreads();
        if (tid < 32) { const int hcount = s_hist[tid]; s_base[tid] = hcount ? atomicAdd(&cnt[tid], hcount) : 0; }
        __syncthreads();
        if (tid < 128) { const int e = s_sele[tid], rk = s_base[e] + s_selr[tid], aid = tok0 * 4 + tid;
            list[e * NTOK + rk] = aid; a_exp[aid] = e; a_rank[aid] = rk; a_gate[aid] = s_selg[tid]; }
        __syncthreads();
    }
}
constexpr int MOE_TAB_OFF = RING_BYTES + 1024;
__device__ __forceinline__ void moe_table(const Frame& F) {
    LAS int* tab = (LAS int*)(F.lds + MOE_TAB_OFF);
    const int t_ = fresh_tid(F.wave);
    if (t_ < 64) {
        const int* cnt = (const int*)(F.ws + WS_CTL) + CW_CNT;
        const int c = (t_ < NEXP) ? __hip_atomic_load(cnt + t_, __ATOMIC_RELAXED, __HIP_MEMORY_SCOPE_AGENT) : 0, nb = (c + 255) >> 8;
        int incl = nb;
#pragma unroll
        for (int o = 1; o < 32; o <<= 1) { const int up = __shfl_up(incl, o); if (t_ >= o) incl += up; }
        const int excl = incl - nb;
        if (t_ < NEXP) { tab[t_] = c; tab[32 + t_] = nb; tab[64 + t_] = excl * 256; tab[96 + t_] = excl; }
        if (t_ == NEXP - 1) tab[96 + 32] = incl;
    }
    __syncthreads();
}
__device__ __forceinline__ void p8_final(const Frame& F, const Args& a) {
    unsigned char* ws = F.ws; const LAS int* tab = (const LAS int*)(F.lds + MOE_TAB_OFF);
    const int tid_ = fresh_tid(F.wave), lane = tid_ & 63, wave_ = F.wave;
    const int gw = F.vcu * NWAVES + wave_, NGW = F.G * NWAVES;
    const bf16_t* X1 = (const bf16_t*)(ws + WS_X1); const unsigned char* Y = ws + WS_Y; const float* fg = a.in[15];
    const int* a_exp = (const int*)(ws + WS_AEXP); const int* a_rank = (const int*)(ws + WS_ARANK); const float* a_gate = (const float*)(ws + WS_AGATE);
    f32x4 fgv[8];
#pragma unroll
    for (int j = 0; j < 8; ++j) fgv[j] = *(const f32x4*)(fg + (lane + 64 * j) * 4);
    for (int tok = gw; tok < NTOK; tok += NGW) {
        const unsigned char* yr[4]; float gt[4];
#pragma unroll
        for (int k = 0; k < 4; ++k) { const int aid = tok * 4 + k; yr[k] = Y + (size_t)(tab[64 + a_exp[aid]] + a_rank[aid]) * D_MODEL; gt[k] = a_gate[aid]; }
        f32x4 v[8]; float s = 0.f;
#pragma unroll
        for (int j = 0; j < 8; ++j) {
            const int c = (lane + 64 * j) * 4; f32x4 y; { const u32x2 rx = *(const u32x2*)(X1 + (size_t)tok * D_MODEL + c); y = (f32x4){__uint_as_float(rx.x << 16), __uint_as_float(rx.x & 0xffff0000u), __uint_as_float(rx.y << 16), __uint_as_float(rx.y & 0xffff0000u)}; }
#pragma unroll
            for (int k = 0; k < 4; ++k) { const unsigned yy = *(const unsigned*)(yr[k] + c);
                const auto lo2 = __builtin_amdgcn_cvt_pk_f32_fp8((int)yy, false), hi2 = __builtin_amdgcn_cvt_pk_f32_fp8((int)yy, true);
                y.x += gt[k] * lo2[0]; y.y += gt[k] * lo2[1]; y.z += gt[k] * hi2[0]; y.w += gt[k] * hi2[1]; }
            v[j] = y; s += (y.x * y.x + y.y * y.y) + (y.z * y.z + y.w * y.w);
        }
        const float rstd = rsqrtf(wave_sum(s) * (1.0f / D_MODEL) + EPS);
#pragma unroll
        for (int j = 0; j < 8; ++j) { const int c = (lane + 64 * j) * 4; *(f32x4*)(a.out + (size_t)tok * D_MODEL + c) = v[j] * rstd * fgv[j]; }
    }
}

__global__ void __launch_bounds__(NWAVES * 64, 2) mk_fwd(Args args) {
    extern __shared__ __attribute__((aligned(16))) unsigned char lds_raw[];
    Frame F;
    F.lds = (LAS unsigned char*)lds_raw; F.wave = __builtin_amdgcn_readfirstlane((int)threadIdx.x >> 6);
    F.G = gridDim.x; { const int bx = blockIdx.x; F.vcu = (F.G % 8 == 0) ? (bx % 8) * (F.G / 8) + bx / 8 : bx; }
    F.ws = args.ws;
    volatile LAS unsigned* MISC = (volatile LAS unsigned*)(F.lds + MISC_OFF);
    for (int u = fresh_tid(F.wave); u < (LDS_BYTES - RING_BYTES) / 4; u += NWAVES * 64) ((LAS unsigned*)(F.lds + RING_BYTES))[u] = 0u;
    __syncthreads();
    const int lo = args.ph_lo, hi = args.ph_hi;
    const bool multi = (hi - lo) > 1;
    XcdBarrier bar; bar.bar = (unsigned*)(F.ws + WS_CTL) + CW_BAR; bar.x = 0; bar.st = nullptr;
    if (multi) bar = xcd_barrier_post((unsigned*)(F.ws + WS_CTL) + CW_BAR, MISC + 8, fresh_tid(F.wave));
#define IN(k) (lo <= (k) && (k) < hi)
#define SEAM(k) do { if (IN(k) && IN((k) + 1)) xcd_barrier(bar, fresh_tid(F.wave)); } while (0)

    const int jx = (int)blockIdx.x >> 3, ncompj = (F.G >> 3) - NCONV / 8;
    const bool conv_role = multi && (F.G % 8 == 0) && (F.G >= 2 * NCONV) && jx >= ncompj;
    const int GC = conv_role || (multi && (F.G % 8 == 0) && (F.G >= 2 * NCONV)) ? ncompj * 8 : F.G;
    const int crank = (GC == F.G) ? (int)blockIdx.x : (jx * 8 + ((int)blockIdx.x & 7));
    unsigned* done1 = (unsigned*)(F.ws + WS_CTL) + CW_DONE1; unsigned* done2 = (unsigned*)(F.ws + WS_CTL) + CW_DONE2;
    if (IN(0)) { p0_prologue(F, args); SEAM(0); }
    if (IN(1)) {
        if (conv_role && IN(2)) {
            xcd_barrier_arrive(bar, fresh_tid(F.wave));
            conv_items(F, args, nullptr, 0u, CV_Q1);
            xcd_barrier_wait(bar, fresh_tid(F.wave));
        }
        else if (conv_role) conv_items(F, args, done1, (unsigned)GC, CV_Q1);
        else {
            pg8::StaticOrder S; S.init(NTOK, INW, D_MODEL * 2, F.ws + WS_WIN, GC, crank, 4);
            pg8::EpiQKV E{(bf16_t*)(F.ws + WS_QKV), (const float*)(F.ws + WS_ROPEC), (const float*)(F.ws + WS_ROPES)};
            pg8::gemm_phase<pg8::EpiQKV, pg8::StaticOrder>(F.lds, F.wave, F.ws + WS_XN, D_MODEL * 2, S, E);
            if (fresh_tid(F.wave) == 0) __hip_atomic_fetch_add(done1, 1u, __ATOMIC_RELAXED, __HIP_MEMORY_SCOPE_AGENT);
        }
        if (!(conv_role && IN(2))) SEAM(1);
    }
    if (IN(2)) {
#pragma unroll 1
        for (int pass = 0; pass < 2; ++pass) {
            if ((pass == 0) == conv_role) conv_items(F, args, nullptr, 0u, CV_Q1);
            else p2_attention(F);
        }
        SEAM(2);
    }
    if (IN(3)) { p3_combine(F, args); SEAM(3); }
    if (IN(4)) {
        pg8::StaticOrder S; S.init(NTOK, D_MODEL, D_MODEL * 2, F.ws + WS_WOUT, F.G, (int)blockIdx.x);
        pg8::EpiOut E{args.in[0], (bf16_t*)(F.ws + WS_X1)};
        pg8::gemm_phase<pg8::EpiOut, pg8::StaticOrder>(F.lds, F.wave, F.ws + WS_ACAT, D_MODEL * 2, S, E);
        SEAM(4);
    }
    if (IN(5)) {
        unsigned qv = 0u;
        if (fresh_tid(F.wave) == 0) qv = __hip_atomic_load((unsigned*)(F.ws + WS_CTL) + CW_CONVQ, __ATOMIC_RELAXED, __HIP_MEMORY_SCOPE_AGENT);
        p5_router(F, args);
        LAS int* s_q = (LAS int*)(F.lds + LDS_QSLOT);
        if (fresh_tid(F.wave) == 0) *s_q = (qv < (unsigned)CV_Q1) ? 1 : 0;
        __syncthreads();
        const bool left = __builtin_amdgcn_readfirstlane(*s_q) != 0;
        __syncthreads();
        if (left) conv_items(F, args, nullptr, 0u, CV_Q1);
        SEAM(5);
    }
    if (IN(6)) {
        moe_table(F);
        pg8::GroupedOrder S; S.init((const LAS int*)(F.lds + MOE_TAB_OFF), 16, F.ws + WS_WGU, (size_t)4096 * D_MODEL, D_MODEL, (const int*)(F.ws + WS_LIST), true, F.G, (int)blockIdx.x, (const LAS int*)(F.lds + ROWTAB_OFF));
        S.fill_rowtab((LAS int*)(F.lds + ROWTAB_OFF), fresh_tid(F.wave)); __syncthreads();
        pg8::EpiGateUp E{F.ws + WS_H1, args.in[10], args.in[12]};
        const int brk = ((int)blockIdx.x >> 3) % 9;
        S.ibase = 0; S.iend = brk;
        pg8::gemm_phase<pg8::EpiGateUp, pg8::GroupedOrder, true, true>(F.lds, F.wave, F.ws + WS_H2, D_MODEL, S, E);
        {
            const int nit = CV_NITEMS - CV_Q1, tot6 = S.total, R6 = (tot6 + F.G - 1) / F.G, h6 = (tot6 % F.G) ? tot6 - (R6 - 1) * F.G : 0, L6 = F.G - h6, c6 = (int)blockIdx.x;
            if (nit == 3 * F.G && h6 > 0 && 2 * h6 <= L6) {
                if (c6 < h6) conv_items(F, args, nullptr, 0u, CV_NITEMS, 1, 0, 0, CV_Q1 + 3 * L6 + c6);
                else { const int r6 = c6 - h6; const bool four = r6 < 2 * h6;
                    conv_items(F, args, nullptr, 0u, CV_NITEMS, four ? 4 : 3, CV_Q1 + r6, L6, four ? CV_Q1 + 3 * L6 + h6 + r6 : -1); }
            } else conv_items(F, args, nullptr, 0u, CV_NITEMS, (nit + F.G - 1) / F.G, CV_Q1 + (int)blockIdx.x, F.G);
        }
        S.ibase = brk; S.iend = 0x7fffffff;
        pg8::gemm_phase<pg8::EpiGateUp, pg8::GroupedOrder, true, true>(F.lds, F.wave, F.ws + WS_H2, D_MODEL, S, E);
        SEAM(6);
    }
    if (IN(7)) {
        if (!IN(6)) moe_table(F);
        pg8::GroupedOrder S; S.init((const LAS int*)(F.lds + MOE_TAB_OFF), 8, F.ws + WS_WD, (size_t)D_MODEL * D_MODEL, D_MODEL, nullptr, false, F.G, (int)blockIdx.x, nullptr);
        pg8::EpiDown E{F.ws + WS_Y, args.in[14]};
        pg8::gemm_phase<pg8::EpiDown, pg8::GroupedOrder, true, true>(F.lds, F.wave, F.ws + WS_H1, D_MODEL, S, E);
        SEAM(7);
    }
    if (IN(8)) { if (!IN(6) && !IN(7)) moe_table(F); p8_final(F, args); }

#undef IN
#undef SEAM
}


extern "C" void kernel_launch(void* const* d_in, const int* in_sizes, int n_in, void* d_out, int out_size, void* d_ws, size_t ws_size, hipStream_t stream) {
    static int grid = 0;
    if (grid == 0) {
        int dev = 0, cus = 0;
        if (hipGetDevice(&dev) != hipSuccess || hipDeviceGetAttribute(&cus, hipDeviceAttributeMultiprocessorCount, dev) != hipSuccess) { grid = -1; return; }
        if (hipFuncSetAttribute((const void*)mk_fwd, hipFuncAttributeMaxDynamicSharedMemorySize, LDS_BYTES) != hipSuccess) { fprintf(stderr, "hipFuncSetAttribute failed\n"); grid = -1; return; }
        int per_cu = 0;
        if (hipOccupancyMaxActiveBlocksPerMultiprocessor(&per_cu, (const void*)mk_fwd, NWAVES * 64, LDS_BYTES) != hipSuccess || per_cu < 1) fprintf(stderr, "occupancy query says %d\n", per_cu);
        (void)hipGetLastError();
        grid = cus;
    }
    if (grid < 0) return;
    const float* x = (const float*)d_in[0];
    const float* dil_norm = (const float*)d_in[3]; const float* sb_norm = (const float*)d_in[4]; const float* w_out = (const float*)d_in[5];
    const float* ffn_norm = (const float*)d_in[6]; const float* w_router = (const float*)d_in[7]; const float* b_router = (const float*)d_in[8];
    const float* w_gate = (const float*)d_in[9]; const float* b_gate = (const float*)d_in[10]; const float* w_up = (const float*)d_in[11]; const float* b_up = (const float*)d_in[12];
    const float* w_down = (const float*)d_in[13]; const float* b_down = (const float*)d_in[14]; const float* final_norm = (const float*)d_in[15];
    float* out = (float*)d_out;
    unsigned char* ws = (unsigned char*)d_ws;
    (void)hipMemsetAsync(ws + WS_CTL, 0, CTL_ZERO_BYTES, stream);
    Args a{};
    for (int i = 0; i < 16; ++i) a.in[i] = (const float*)d_in[i];
    a.out = out; a.ws = ws;
    a.ph_lo = 0; a.ph_hi = NPHASE;
    hipLaunchKernelGGL(mk_fwd, dim3(grid), dim3(NWAVES * 64), LDS_BYTES, stream, a);
}
```
